# Optimizing an MI355X kernel written in HIP

```python
import jax, jax.numpy as jnp
from jax import lax
import numpy as np

D_MODEL = 1024
BATCH = 8
SEQ = 8192
DEPTH = 4

GRID_W = 64
CTX_LEN = 256
N_MIXERS = 3
N_A_LAYERS = (DEPTH + 2) // 3
N_B_LAYERS = (DEPTH + 1) // 3
N_C_LAYERS = DEPTH // 3

D_FF = 4 * D_MODEL
N_MOD = 6
EPS = 1e-6
ROPE_BASE = 10000.0
Q_BLOCK = 128
NEG_INF = -1e30

MLA_HEADS = 16
MLA_Q_RANK = 256
MLA_KV_RANK = 128
MLA_NOPE = 64
MLA_ROPE = 32
MLA_V = 64

SWA_Q_HEADS = 16
SWA_KV_HEADS = 4
SWA_HEAD_DIM = 64
SWA_WINDOW = 128
SWA_BLOCK = 128

NA_HEADS = 16
NA_HEAD_DIM = 64
NA_ROWS = 8
NA_COLS = 16

kernel_name = "hybrid_interleaved_mla_swa_na_dit"


def rmsnorm(x, g):
    x32 = x.astype(jnp.float32)
    y = x32 * lax.rsqrt(jnp.mean(x32 * x32, axis=-1, keepdims=True) + EPS)
    return (y * g.astype(jnp.float32)).astype(x.dtype)


def modulate(h, shift, scale):
    return h * (1 + scale) + shift


def axial_rope_angles(n_tokens, rot_dim):
    t = jnp.arange(n_tokens, dtype=jnp.int32)
    row = (t // GRID_W).astype(jnp.float32)
    col = (t % GRID_W).astype(jnp.float32)
    n_freq = rot_dim // 4
    inv_freq = ROPE_BASE ** (-jnp.arange(n_freq, dtype=jnp.float32) / n_freq)
    ang = jnp.concatenate([row[:, None] * inv_freq, col[:, None] * inv_freq], axis=-1)
    return jnp.cos(ang), jnp.sin(ang)


def apply_rope(x, cos, sin):
    x32 = x.astype(jnp.float32).reshape(x.shape[:-1] + (x.shape[-1] // 2, 2))
    x1, x2 = x32[..., 0], x32[..., 1]
    c = cos[None, :, None, :]
    s = sin[None, :, None, :]
    out = jnp.stack([x1 * c - x2 * s, x1 * s + x2 * c], axis=-1)
    return out.reshape(x.shape).astype(x.dtype)


def ctx_attention(q, k, v, scale):
    s = jnp.einsum('bqhd,bkhd->bhqk', q, k, preferred_element_type=jnp.float32) * scale
    p = jax.nn.softmax(s, axis=-1).astype(v.dtype)
    return jnp.einsum('bhqk,bkhd->bqhd', p, v)


def mla_queries(q_lat, qa_g, w_qb, rope):
    b, n, _ = q_lat.shape
    q = (rmsnorm(q_lat, qa_g) @ w_qb).reshape(b, n, MLA_HEADS, MLA_NOPE + MLA_ROPE)
    q_nope, q_pe = q[..., :MLA_NOPE], q[..., MLA_NOPE:]
    if rope is not None:
        q_pe = apply_rope(q_pe, rope[0], rope[1])
    return jnp.concatenate([q_nope, q_pe], axis=-1)


def mla_keys_values(kv_lat, k_pe, kva_g, w_kvb, rope):
    b, n, _ = kv_lat.shape
    kv = (rmsnorm(kv_lat, kva_g) @ w_kvb).reshape(b, n, MLA_HEADS, MLA_NOPE + MLA_V)
    k_nope, v = kv[..., :MLA_NOPE], kv[..., MLA_NOPE:]
    k_pe = k_pe[:, :, None, :]
    if rope is not None:
        k_pe = apply_rope(k_pe, rope[0], rope[1])
    k = jnp.concatenate([k_nope, jnp.broadcast_to(k_pe, k_nope.shape[:-1] + (MLA_ROPE,))], axis=-1)
    return k, v


def mixer_mla(h, hc, w_in, qa_g, w_qb, kva_g, w_kvb, w_o, need_ctx):
    b, n, _ = h.shape
    L = hc.shape[1]
    scale = (MLA_NOPE + MLA_ROPE) ** -0.5
    rope = axial_rope_angles(n, MLA_ROPE)
    q_lat, kv_lat, k_pe = jnp.split(h @ w_in, [MLA_Q_RANK, MLA_Q_RANK + MLA_KV_RANK], axis=-1)
    q = mla_queries(q_lat, qa_g, w_qb, rope)
    k, v = mla_keys_values(kv_lat, k_pe, kva_g, w_kvb, rope)
    if need_ctx:
        qc_lat, kvc_lat, kc_pe = jnp.split(hc @ w_in, [MLA_Q_RANK, MLA_Q_RANK + MLA_KV_RANK], axis=-1)
    else:
        kvc_lat, kc_pe = jnp.split(hc @ w_in[:, MLA_Q_RANK:], [MLA_KV_RANK], axis=-1)
    kc, vc = mla_keys_values(kvc_lat, kc_pe, kva_g, w_kvb, None)
    k_all = jnp.concatenate([kc, k], axis=1)
    v_all = jnp.concatenate([vc, v], axis=1)
    nb = n // Q_BLOCK
    qb = q.reshape(b, nb, Q_BLOCK, MLA_HEADS, MLA_NOPE + MLA_ROPE).transpose(1, 0, 2, 3, 4)

    def block(qi):
        s = jnp.einsum('bqhd,bkhd->bhqk', qi, k_all, preferred_element_type=jnp.float32) * scale
        p = jax.nn.softmax(s, axis=-1).astype(v_all.dtype)
        return jnp.einsum('bhqk,bkhd->bqhd', p, v_all)

    o = lax.map(block, qb)
    y = o.transpose(1, 0, 2, 3, 4).reshape(b, n, MLA_HEADS * MLA_V) @ w_o
    yc = None
    if need_ctx:
        qc = mla_queries(qc_lat, qa_g, w_qb, None)
        yc = ctx_attention(qc, kc, vc, scale).reshape(b, L, MLA_HEADS * MLA_V) @ w_o
    return y, yc


def mixer_swa(h, hc, w_qkv, sink, w_o, need_ctx):
    b, n, _ = h.shape
    L = hc.shape[1]
    grp = SWA_Q_HEADS // SWA_KV_HEADS
    dq = SWA_Q_HEADS * SWA_HEAD_DIM
    dkv = SWA_KV_HEADS * SWA_HEAD_DIM
    scale = SWA_HEAD_DIM ** -0.5
    cos, sin = axial_rope_angles(n, SWA_HEAD_DIM)
    q, k, v = jnp.split(h @ w_qkv, [dq, dq + dkv], axis=-1)
    q = apply_rope(q.reshape(b, n, SWA_Q_HEADS, SWA_HEAD_DIM), cos, sin)
    q = q.reshape(b, n, SWA_KV_HEADS, grp, SWA_HEAD_DIM)
    k = apply_rope(k.reshape(b, n, SWA_KV_HEADS, SWA_HEAD_DIM), cos, sin)
    v = v.reshape(b, n, SWA_KV_HEADS, SWA_HEAD_DIM)
    kc, vc = jnp.split(hc @ w_qkv[:, dq:], [dkv], axis=-1)
    kc = kc.reshape(b, L, SWA_KV_HEADS, SWA_HEAD_DIM)
    vc = vc.reshape(b, L, SWA_KV_HEADS, SWA_HEAD_DIM)
    sink_g = sink.astype(jnp.float32).reshape(SWA_KV_HEADS, grp)
    pad = ((0, 0), (SWA_BLOCK, SWA_BLOCK), (0, 0), (0, 0))
    kp = jnp.pad(k, pad)
    vp = jnp.pad(v, pad)
    n_band = 3 * SWA_BLOCK

    def block(bi):
        start = bi * SWA_BLOCK
        qi = lax.dynamic_slice_in_dim(q, start, SWA_BLOCK, axis=1)
        ki = lax.dynamic_slice_in_dim(kp, start, n_band, axis=1)
        vi = lax.dynamic_slice_in_dim(vp, start, n_band, axis=1)
        qpos = start + jnp.arange(SWA_BLOCK)
        kpos = start - SWA_BLOCK + jnp.arange(n_band)
        valid = (kpos >= 0)[None, :] & (kpos < n)[None, :] & (jnp.abs(qpos[:, None] - kpos[None, :]) <= SWA_WINDOW)
        s_loc = jnp.einsum('bqhgd,bkhd->bhgqk', qi, ki, preferred_element_type=jnp.float32) * scale
        s_loc = jnp.where(valid, s_loc, NEG_INF)
        s_ctx = jnp.einsum('bqhgd,bkhd->bhgqk', qi, kc, preferred_element_type=jnp.float32) * scale
        s_sink = jnp.broadcast_to(sink_g[None, :, :, None, None], s_loc.shape[:-1] + (1,))
        p = jax.nn.softmax(jnp.concatenate([s_loc, s_ctx, s_sink], axis=-1), axis=-1)
        p_loc = p[..., :n_band].astype(v.dtype)
        p_ctx = p[..., n_band:n_band + L].astype(v.dtype)
        return (jnp.einsum('bhgqk,bkhd->bqhgd', p_loc, vi)
                + jnp.einsum('bhgqk,bkhd->bqhgd', p_ctx, vc))

    o = lax.map(block, jnp.arange(n // SWA_BLOCK))
    y = o.transpose(1, 0, 2, 3, 4, 5).reshape(b, n, dq) @ w_o
    yc = None
    if need_ctx:
        qc = (hc @ w_qkv[:, :dq]).reshape(b, L, SWA_KV_HEADS, grp, SWA_HEAD_DIM)
        s = jnp.einsum('bqhgd,bkhd->bhgqk', qc, kc, preferred_element_type=jnp.float32) * scale
        s_sink = jnp.broadcast_to(sink_g[None, :, :, None, None], s.shape[:-1] + (1,))
        p = jax.nn.softmax(jnp.concatenate([s, s_sink], axis=-1), axis=-1)[..., :L].astype(vc.dtype)
        yc = jnp.einsum('bhgqk,bkhd->bqhgd', p, vc).reshape(b, L, dq) @ w_o
    return y, yc


def mixer_na(h, hc, w_qkv, rel_bias, w_o, need_ctx):
    b, n, _ = h.shape
    L = hc.shape[1]
    rows = n // GRID_W
    kh = min(NA_ROWS, rows)
    dm = NA_HEADS * NA_HEAD_DIM
    scale = NA_HEAD_DIM ** -0.5
    q, k, v = jnp.split(h @ w_qkv, [dm, 2 * dm], axis=-1)
    grid = (b, rows, GRID_W, NA_HEADS, NA_HEAD_DIM)
    q, k, v = q.reshape(grid), k.reshape(grid), v.reshape(grid)
    kc, vc = jnp.split(hc @ w_qkv[:, dm:], [dm], axis=-1)
    kc = kc.reshape(b, L, NA_HEADS, NA_HEAD_DIM)
    vc = vc.reshape(b, L, NA_HEADS, NA_HEAD_DIM)
    col = jnp.arange(GRID_W)
    col_start = jnp.clip(col - NA_COLS // 2, 0, GRID_W - NA_COLS)
    col_valid = (col[None, :] >= col_start[:, None]) & (col[None, :] < col_start[:, None] + NA_COLS)
    dc_idx = jnp.clip(col[None, :] - col[:, None] + NA_COLS - 1, 0, 2 * NA_COLS - 2)
    bias_cols = rel_bias.astype(jnp.float32)[:, :, dc_idx]
    bias_cols = jnp.where(col_valid, bias_cols, NEG_INF)

    def row_block(r):
        rs = jnp.clip(r - kh // 2, 0, rows - kh)
        qi = lax.dynamic_index_in_dim(q, r, axis=1, keepdims=False)
        ki = lax.dynamic_slice_in_dim(k, rs, kh, axis=1)
        vi = lax.dynamic_slice_in_dim(v, rs, kh, axis=1)
        dr_idx = rs + jnp.arange(kh) - r + NA_ROWS - 1
        bias = jnp.take(bias_cols, dr_idx, axis=1).transpose(0, 2, 1, 3)
        s_loc = jnp.einsum('bqhd,bjkhd->bhqjk', qi, ki, preferred_element_type=jnp.float32) * scale + bias[None]
        s_loc = s_loc.reshape(b, NA_HEADS, GRID_W, kh * GRID_W)
        s_ctx = jnp.einsum('bqhd,blhd->bhql', qi, kc, preferred_element_type=jnp.float32) * scale
        p = jax.nn.softmax(jnp.concatenate([s_loc, s_ctx], axis=-1), axis=-1)
        p_loc = p[..., :kh * GRID_W].reshape(b, NA_HEADS, GRID_W, kh, GRID_W).astype(v.dtype)
        p_ctx = p[..., kh * GRID_W:].astype(v.dtype)
        return (jnp.einsum('bhqjk,bjkhd->bqhd', p_loc, vi)
                + jnp.einsum('bhql,blhd->bqhd', p_ctx, vc))

    o = lax.map(row_block, jnp.arange(rows))
    y = o.transpose(1, 0, 2, 3, 4).reshape(b, n, dm) @ w_o
    yc = None
    if need_ctx:
        qc = (hc @ w_qkv[:, :dm]).reshape(b, L, NA_HEADS, NA_HEAD_DIM)
        yc = ctx_attention(qc, kc, vc, scale).reshape(b, L, dm) @ w_o
    return y, yc


def sq_relu_mlp(h, w1, w2):
    return jnp.square(jax.nn.relu(h @ w1)) @ w2


def setup_inputs(seed: int = 0) -> dict:
    key = jax.random.key(seed)
    ks = jax.random.split(key, 24)

    def w(k, shape, fan_in, gain=1.0):
        return jax.random.normal(k, shape, jnp.float32) * (gain * fan_in ** -0.5)

    def gn(k, shape):
        return 1.0 + 0.05 * jax.random.normal(k, shape, jnp.float32)

    D = D_MODEL
    return {
        'x': jax.random.normal(ks[0], (BATCH, SEQ, D), jnp.float32),
        'c': jax.random.normal(ks[1], (BATCH, D), jnp.float32),
        'ctx': jax.random.normal(ks[2], (BATCH, CTX_LEN, D), jnp.float32),
        'c_ctx': jax.random.normal(ks[3], (D,), jnp.float32),
        'ada_w': w(ks[4], (DEPTH, D, N_MOD * D), D, 0.5),
        'ada_b': 0.02 * jax.random.normal(ks[5], (DEPTH, N_MOD * D), jnp.float32),
        'norm_mix_g': gn(ks[6], (DEPTH, D)),
        'norm_mlp_g': gn(ks[7], (DEPTH, D)),
        'norm_out_g': gn(ks[8], (D,)),
        'mlp_w1': w(ks[9], (DEPTH, D, D_FF), D),
        'mlp_w2': w(ks[10], (DEPTH, D_FF, D), D_FF),
        'mla_w_in': w(ks[11], (N_A_LAYERS, D, MLA_Q_RANK + MLA_KV_RANK + MLA_ROPE), D),
        'mla_qa_g': gn(ks[12], (N_A_LAYERS, MLA_Q_RANK)),
        'mla_w_qb': w(ks[13], (N_A_LAYERS, MLA_Q_RANK, MLA_HEADS * (MLA_NOPE + MLA_ROPE)), MLA_Q_RANK),
        'mla_kva_g': gn(ks[14], (N_A_LAYERS, MLA_KV_RANK)),
        'mla_w_kvb': w(ks[15], (N_A_LAYERS, MLA_KV_RANK, MLA_HEADS * (MLA_NOPE + MLA_V)), MLA_KV_RANK),
        'mla_w_o': w(ks[16], (N_A_LAYERS, MLA_HEADS * MLA_V, D), MLA_HEADS * MLA_V),
        'swa_w_qkv': w(ks[17], (N_B_LAYERS, D, (SWA_Q_HEADS + 2 * SWA_KV_HEADS) * SWA_HEAD_DIM), D),
        'swa_sink': 0.5 * jax.random.normal(ks[18], (N_B_LAYERS, SWA_Q_HEADS), jnp.float32),
        'swa_w_o': w(ks[19], (N_B_LAYERS, SWA_Q_HEADS * SWA_HEAD_DIM, D), SWA_Q_HEADS * SWA_HEAD_DIM),
        'na_w_qkv': w(ks[20], (N_C_LAYERS, D, 3 * NA_HEADS * NA_HEAD_DIM), D),
        'na_rel_bias': 0.5 * jax.random.normal(ks[21], (N_C_LAYERS, NA_HEADS, 2 * NA_ROWS - 1, 2 * NA_COLS - 1), jnp.float32),
        'na_w_o': w(ks[22], (N_C_LAYERS, NA_HEADS * NA_HEAD_DIM, D), NA_HEADS * NA_HEAD_DIM),
    }


def reference(x, c, ctx, c_ctx, ada_w, ada_b, norm_mix_g, norm_mlp_g, norm_out_g, mlp_w1, mlp_w2,
              mla_w_in, mla_qa_g, mla_w_qb, mla_kva_g, mla_w_kvb, mla_w_o,
              swa_w_qkv, swa_sink, swa_w_o, na_w_qkv, na_rel_bias, na_w_o):
    D = D_MODEL
    c_act = jax.nn.silu(c)
    cc_act = jax.nn.silu(c_ctx)
    for i in range(DEPTH):
        need_ctx = i < DEPTH - 1
        mod = c_act @ ada_w[i] + ada_b[i]
        sh1, sc1, g1, sh2, sc2, g2 = jnp.split(mod[:, None, :], N_MOD, axis=-1)
        n_mod_c = N_MOD if need_ctx else 3
        mod_c = cc_act @ ada_w[i][:, :n_mod_c * D] + ada_b[i][:n_mod_c * D]
        mods_c = jnp.split(mod_c, n_mod_c, axis=-1)
        h = modulate(rmsnorm(x, norm_mix_g[i]), sh1, sc1)
        hc = modulate(rmsnorm(ctx, norm_mix_g[i]), mods_c[0], mods_c[1])
        kind, j = i % N_MIXERS, i // N_MIXERS
        if kind == 0:
            y, yc = mixer_mla(h, hc, mla_w_in[j], mla_qa_g[j], mla_w_qb[j], mla_kva_g[j], mla_w_kvb[j], mla_w_o[j], need_ctx)
        elif kind == 1:
            y, yc = mixer_swa(h, hc, swa_w_qkv[j], swa_sink[j], swa_w_o[j], need_ctx)
        else:
            y, yc = mixer_na(h, hc, na_w_qkv[j], na_rel_bias[j], na_w_o[j], need_ctx)
        x = x + g1 * y
        x = x + g2 * sq_relu_mlp(modulate(rmsnorm(x, norm_mlp_g[i]), sh2, sc2), mlp_w1[i], mlp_w2[i])
        if need_ctx:
            ctx = ctx + mods_c[2] * yc
            hc2 = modulate(rmsnorm(ctx, norm_mlp_g[i]), mods_c[3], mods_c[4])
            ctx = ctx + mods_c[5] * sq_relu_mlp(hc2, mlp_w1[i], mlp_w2[i])
    return rmsnorm(x, norm_out_g)
```

```cpp
#include <hip/hip_runtime.h>
#include <hip/hip_cooperative_groups.h>
#include <cstdio>
#include <cstdint>
namespace cg = cooperative_groups;

#define LAS __attribute__((address_space(3)))
typedef unsigned short bf16_t;
typedef short bf16x8 __attribute__((ext_vector_type(8)));
typedef float f32x4 __attribute__((ext_vector_type(4)));
typedef float f32x16 __attribute__((ext_vector_type(16)));
typedef unsigned u32x4 __attribute__((ext_vector_type(4)));
typedef unsigned u32x2 __attribute__((ext_vector_type(2)));

constexpr int NB = 8, SEQ = 8192, DM = 1024, CTX = 256, FF = 4096;
constexpr int ML = NB * SEQ;
constexpr int MC = NB * CTX;
constexpr int MT = ML + MC;
constexpr int KVLEN = CTX + SEQ;
constexpr float EPS = 1e-6f;
constexpr float LOG2E = 1.4426950408889634f;

__device__ __forceinline__ unsigned cvtpk(float lo, float hi) {
    typedef float f2 __attribute__((ext_vector_type(2))); typedef __bf16 b2 __attribute__((ext_vector_type(2)));
    f2 v = {lo, hi}; b2 b = __builtin_convertvector(v, b2); return __builtin_bit_cast(unsigned, b);
}
__device__ __forceinline__ int lane_id() { int l; asm volatile("v_mbcnt_lo_u32_b32 %0, -1, 0\n\tv_mbcnt_hi_u32_b32 %0, -1, %0" : "=v"(l)); return l; }
__device__ __forceinline__ float shfl_xor_l(float v, int mask, int lane) { return __int_as_float(__builtin_amdgcn_ds_bpermute((lane ^ mask) << 2, __float_as_int(v))); }
__device__ __forceinline__ int perm16(int x) { return 8 * ((x >> 2) & 1) + (x & 3) + 4 * (x >> 3); }

namespace pg8 {
constexpr int BM = 256, BK = 64, HALF = 128, HTB = HALF * BK * 2, STAGE_BYTES = 8 * HTB, NXCD = 8, WGM = 8;
__host__ __device__ __forceinline__ int lds_byte(int r, int c) { const int st = (r >> 4) * 2 + (c >> 5), rr = r & 15, cc = c & 31, ob = rr * 64 + cc * 2; return st * 1024 + (ob ^ (((ob >> 9) & 1) << 5)); }
__host__ __device__ __forceinline__ void stage_rc(int b, int& R, int& C) { const int st = b / 1024, sb = b % 1024, swz = sb ^ (((sb >> 9) & 1) << 5); R = (st >> 1) * 16 + swz / 64; C = (st & 1) * 32 + (swz % 64) / 2; }
__host__ __device__ __forceinline__ int perm32(int rho) { const int n = rho >> 4, i = rho & 15; return 8 * (i >> 2) + 4 * n + (i & 3); }

struct Unit { int pm, pn; };
struct Gemm { const bf16_t* A; const bf16_t* Bt; int M, N, K, lda, ldb; };

struct StaticOrder {
    int nM, nN, nwg, G, c;
    __device__ void init(int M, int N, int G_, int c_) { nM = M / BM; nN = N / BM; nwg = nM * nN; G = G_; c = c_; }
    __device__ bool next(int i, Unit& u) const {
        const long L = (long)i * G + c; if (L >= nwg) return false;
        int wgid = (int)L; { const int q = nwg / NXCD, r = nwg % NXCD, xcd = wgid % NXCD, off = wgid / NXCD; wgid = (xcd < r ? xcd * (q + 1) : r * (q + 1) + (xcd - r) * q) + off; }
        const int nig = WGM * nN, gid = wgid / nig, fm = gid * WGM, gsz = (nM - fm) < WGM ? (nM - fm) : WGM;
        u.pm = fm + ((wgid % nig) % gsz); u.pn = (wgid % nig) / gsz; return true;
    }
};

template <class Epi, class Sched, bool ALIGN_EPI>
__device__ __forceinline__ void gemm_phase(LAS unsigned char* lds, const Gemm g, const Sched& S, const Epi& E, int wave_s) {
    int tid_l = wave_s * 64 + lane_id(); asm volatile("" : "+v"(tid_l));
    const int tid = tid_l, wid = __builtin_amdgcn_readfirstlane(tid >> 6), lane = tid & 63, wr = wid >> 2, wc = wid & 3, fr = lane & 15, fq = lane >> 4;
    const int K = g.K, nt = K / BK;
    unsigned voffA[2], voffB[2];
#pragma unroll
    for (int i = 0; i < 2; ++i) { int R, C; stage_rc(tid * 16 + i * 8192, R, C); const int Rb = Epi::PERM ? ((R & ~31) + perm32(R & 31)) : R;
        voffA[i] = (unsigned)(R * g.lda + C) * 2u; voffB[i] = (unsigned)(Rb * g.ldb + C) * 2u; }
    const size_t kstep = (size_t)(BK * 2);
    const size_t hstepA = (size_t)HALF * g.lda * 2, hstepB = (size_t)HALF * g.ldb * 2;
    const size_t tstepA = 2 * hstepA, tstepB = 2 * hstepB;
    const unsigned ldsw = (unsigned)wid * 1024u;
    const int aoff = lds_byte(wr * 64 + fr, fq * 8), boff = lds_byte(wc * 32 + fr, fq * 8);
#define PG8_SA(b, h) (((b) * 2 + (h)) * HTB)
#define PG8_SB(b, h) ((4 + (b) * 2 + (h)) * HTB)
#define PG8_STAGE(bufoff, gbase, voff) do { _Pragma("unroll") for (int _i = 0; _i < 2; ++_i) \
        __builtin_amdgcn_global_load_lds((const unsigned*)((const char*)(gbase) + (voff)[_i]), (LAS unsigned*)(lds + (bufoff) + ldsw + _i * 8192), 16, 0, 0); } while (0)
#define PG8_LDA(dst, b, h) do { _Pragma("unroll") for (int m = 0; m < 4; ++m) _Pragma("unroll") for (int k = 0; k < 2; ++k) dst[m][k] = *(const LAS bf16x8*)(lds + PG8_SA(b, h) + aoff + m * 2048 + k * 1024); } while (0)
#define PG8_LDB(dst, b, h) do { _Pragma("unroll") for (int n = 0; n < 2; ++n) _Pragma("unroll") for (int k = 0; k < 2; ++k) dst[n][k] = *(const LAS bf16x8*)(lds + PG8_SB(b, h) + boff + n * 2048 + k * 1024); } while (0)
#define PG8_MMA(ai, bj, At, Bt) do { __builtin_amdgcn_s_setprio(1); _Pragma("unroll") for (int m = 0; m < 4; ++m) _Pragma("unroll") for (int n = 0; n < 2; ++n) _Pragma("unroll") for (int k = 0; k < 2; ++k) \
        acc[ai][bj][m][n] = __builtin_amdgcn_mfma_f32_16x16x32_bf16(Bt[n][k], At[m][k], acc[ai][bj][m][n], 0, 0, 0); __builtin_amdgcn_s_setprio(0); } while (0)
#define PG8_WAIT_V(n) asm volatile("s_waitcnt vmcnt(" #n ")" ::: "memory")
#define PG8_WAIT_L(n) asm volatile("s_waitcnt lgkmcnt(" #n ")" ::: "memory")
#define PG8_BAR __builtin_amdgcn_s_barrier()
#define PG8_SCHED __builtin_amdgcn_sched_barrier(0)
    Unit cur, nxt; int ui = 0;
    if (!S.next(0, cur)) return;
    f32x4 acc[2][2][4][2];
#pragma unroll
    for (int a = 0; a < 2; ++a)
#pragma unroll
        for (int b = 0; b < 2; ++b)
#pragma unroll
            for (int m = 0; m < 4; ++m)
#pragma unroll
                for (int n = 0; n < 2; ++n) acc[a][b][m][n] = (f32x4){0.f, 0.f, 0.f, 0.f};
    bf16x8 At[4][2], B0[2][2], B1[2][2];
    const char* cA = (const char*)g.A + (size_t)cur.pm * tstepA; const char* cB = (const char*)g.Bt + (size_t)cur.pn * tstepB;
    PG8_STAGE(PG8_SB(0, 0), cB, voffB); PG8_STAGE(PG8_SB(0, 1), cB + hstepB, voffB); PG8_STAGE(PG8_SA(0, 0), cA, voffA); PG8_STAGE(PG8_SA(0, 1), cA + hstepA, voffA);
    if (wr == 1) PG8_BAR;
    PG8_WAIT_V(2); PG8_BAR;
    PG8_STAGE(PG8_SB(1, 0), cB + kstep, voffB); PG8_STAGE(PG8_SA(1, 0), cA + kstep, voffA); PG8_STAGE(PG8_SB(1, 1), cB + hstepB + kstep, voffB);
    PG8_WAIT_V(6); PG8_BAR;
    for (;;) {
        const bool has_next = S.next(ui + 1, nxt);
        const char* nA = has_next ? (const char*)g.A + (size_t)nxt.pm * tstepA : cA; const char* nB = has_next ? (const char*)g.Bt + (size_t)nxt.pn * tstepB : cB;
        for (int t = 0; t < nt; t += 2) {
            const bool last = (t == nt - 2);
            const char* a1 = cA + (size_t)(t + 1) * kstep;
            const char* a2 = last ? nA : cA + (size_t)(t + 2) * kstep; const char* b2 = last ? nB : cB + (size_t)(t + 2) * kstep;
            const char* a3 = a2 + kstep; const char* b3 = b2 + kstep;
            PG8_LDB(B0, 0, 0); PG8_LDB(B1, 0, 1); PG8_SCHED; PG8_LDA(At, 0, 0); PG8_STAGE(PG8_SA(1, 1), a1 + hstepA, voffA);
            PG8_WAIT_V(8); PG8_WAIT_L(0); PG8_BAR; PG8_MMA(0, 0, At, B0); PG8_MMA(0, 1, At, B1); PG8_BAR; PG8_SCHED;
            PG8_LDA(At, 0, 1); PG8_STAGE(PG8_SB(0, 0), b2, voffB); PG8_STAGE(PG8_SB(0, 1), b2 + hstepB, voffB); PG8_STAGE(PG8_SA(0, 0), a2, voffA);
            PG8_WAIT_V(8); PG8_WAIT_L(0); PG8_BAR; PG8_MMA(1, 0, At, B0); PG8_MMA(1, 1, At, B1); PG8_BAR; PG8_SCHED;
            PG8_LDB(B0, 1, 0); PG8_LDB(B1, 1, 1); PG8_SCHED; PG8_LDA(At, 1, 0); PG8_STAGE(PG8_SA(0, 1), a2 + hstepA, voffA);
            PG8_WAIT_V(8); PG8_WAIT_L(0); PG8_BAR; PG8_MMA(0, 0, At, B0); PG8_MMA(0, 1, At, B1); PG8_BAR; PG8_SCHED;
            PG8_LDA(At, 1, 1); PG8_STAGE(PG8_SB(1, 0), b3, voffB); PG8_STAGE(PG8_SB(1, 1), b3 + hstepB, voffB); PG8_STAGE(PG8_SA(1, 0), a3, voffA);
            PG8_WAIT_V(8); PG8_WAIT_L(0); PG8_BAR; PG8_MMA(1, 0, At, B0); PG8_MMA(1, 1, At, B1); PG8_BAR; PG8_SCHED;
        }
        if constexpr (ALIGN_EPI) { if (wr == 0) PG8_BAR; }
        E(acc, cur, wr, wc, fr, fq);
        if (!has_next) break;
#pragma unroll
        for (int a = 0; a < 2; ++a)
#pragma unroll
            for (int b = 0; b < 2; ++b)
#pragma unroll
                for (int m = 0; m < 4; ++m)
#pragma unroll
                    for (int n = 0; n < 2; ++n) acc[a][b][m][n] = (f32x4){0.f, 0.f, 0.f, 0.f};
        cur = nxt; cA = nA; cB = nB; ++ui;
        if constexpr (ALIGN_EPI) { if (wr == 1) PG8_BAR; }
    }
    PG8_WAIT_V(0);
    if constexpr (!ALIGN_EPI) { if (wr == 0) PG8_BAR; }
    PG8_BAR;
#undef PG8_SA
#undef PG8_SB
#undef PG8_STAGE
#undef PG8_LDA
#undef PG8_LDB
#undef PG8_MMA
#undef PG8_WAIT_V
#undef PG8_WAIT_L
#undef PG8_BAR
#undef PG8_SCHED
}
}

typedef const f32x4 (&AccRef)[2][2][4][2];

__device__ __forceinline__ void rope8(float (&v)[8], const float* tab) {
    const f32x4 t0 = *(const f32x4*)tab, t1 = *(const f32x4*)(tab + 4);
    float x1, x2;
    x1 = v[0]; x2 = v[1]; v[0] = x1 * t0[0] - x2 * t0[1]; v[1] = x1 * t0[1] + x2 * t0[0];
    x1 = v[2]; x2 = v[3]; v[2] = x1 * t0[2] - x2 * t0[3]; v[3] = x1 * t0[3] + x2 * t0[2];
    x1 = v[4]; x2 = v[5]; v[4] = x1 * t1[0] - x2 * t1[1]; v[5] = x1 * t1[1] + x2 * t1[0];
    x1 = v[6]; x2 = v[7]; v[6] = x1 * t1[2] - x2 * t1[3]; v[7] = x1 * t1[3] + x2 * t1[2];
}
__device__ __forceinline__ u32x4 pack8(const float (&v)[8]) { u32x4 w; w.x = cvtpk(v[0], v[1]); w.y = cvtpk(v[2], v[3]); w.z = cvtpk(v[4], v[5]); w.w = cvtpk(v[6], v[7]); return w; }

template <int MODE> struct EpiProj {
    static constexpr bool PERM = true;
    bf16_t* Q; bf16_t* K; bf16_t* VT; const float* rope; const float* ssq; float qscale;
    __device__ __forceinline__ void operator()(AccRef acc, const pg8::Unit& u, int wr, int wc, int fr_, int fq_) const {
        int lane_e = lane_id(); asm volatile("" : "+v"(lane_e)); const int fr = lane_e & 15, fq = lane_e >> 4; (void)fr_; (void)fq_;
        constexpr int LDQ = (MODE == 0) ? 1536 : 1024, NQ = (MODE == 0) ? 1536 : (MODE == 1 ? 0 : 1024);
        constexpr int LDK = (MODE == 2) ? 256 : 1024, NK = LDK, VCOLS = LDK;
#pragma unroll
        for (int ai = 0; ai < 2; ++ai)
#pragma unroll
            for (int m = 0; m < 4; ++m) {
                const int row = u.pm * 256 + ai * 128 + wr * 64 + m * 16 + fr;
                const bool isctx = row >= ML; const int rc = row - ML;
                const int b = isctx ? (rc >> 8) : (row >> 13);
                const int tok = row & 8191;
                const int kpos = isctx ? (rc & 255) : 256 + tok;
                const size_t kvrow = (size_t)b * KVLEN + kpos;
                const int vpos = (kpos & ~15) | perm16(kpos & 15);
                float rs = 1.f; if (MODE <= 1) rs = rsqrtf(ssq[row] * (MODE == 0 ? 1.f / 256.f : 1.f / 128.f) + EPS);
#pragma unroll
                for (int bj = 0; bj < 2; ++bj) {
                    const int col = u.pn * 256 + bj * 128 + wc * 32 + 8 * fq;
                    float v[8];
#pragma unroll
                    for (int j = 0; j < 4; ++j) { v[j] = acc[ai][bj][m][0][j] * rs; v[4 + j] = acc[ai][bj][m][1][j] * rs; }
                    if (MODE == 2) { if (!isctx && col < 1280) rope8(v, rope + ((size_t)tok * 32 + ((col & 63) >> 1)) * 2); }
                    if (MODE == 0) { const int c96 = col % 96; if (!isctx && c96 >= 64) rope8(v, rope + ((size_t)tok * 16 + ((c96 - 64) >> 1)) * 2); }
                    bool isv; int kc;
                    if (MODE == 1) { const int within = col & 127; isv = within >= 64; kc = (col >> 7) * 64 + (within & 63); }
                    else { isv = col >= NQ + NK; kc = isv ? col - NQ - NK : col - NQ; }
                    if (MODE != 1 && col < NQ) {
#pragma unroll
                        for (int j = 0; j < 8; ++j) v[j] *= qscale;
                        *(u32x4*)(Q + (size_t)row * LDQ + col) = pack8(v);
                    } else if (MODE != 0 && !isv) {
                        *(u32x4*)(K + kvrow * LDK + kc) = pack8(v);
                    } else if (MODE != 0) {
                        bf16_t* vp = VT + ((size_t)(b * VCOLS + kc)) * KVLEN + vpos;
#pragma unroll
                        for (int j = 0; j < 8; ++j) vp[(size_t)j * KVLEN] = (bf16_t)(cvtpk(v[j], 0.f) & 0xffffu);
                    }
                }
            }
    }
};

struct EpiLat {
    static constexpr bool PERM = true;
    bf16_t* lat; float* ssq_q; float* ssq_kv; bf16_t* KPE; const float* rope;
    __device__ __forceinline__ void operator()(AccRef acc, const pg8::Unit& u, int wr, int wc, int fr_, int fq_) const {
        int lane_e = lane_id(); asm volatile("" : "+v"(lane_e)); const int fr = lane_e & 15, fq = lane_e >> 4; (void)fr_; (void)fq_;
#pragma unroll
        for (int ai = 0; ai < 2; ++ai)
#pragma unroll
            for (int m = 0; m < 4; ++m) {
                const int row = u.pm * 256 + ai * 128 + wr * 64 + m * 16 + fr;
                const bool isctx = row >= ML; const int rc = row - ML;
                const int b = isctx ? (rc >> 8) : (row >> 13);
                const int tok = row & 8191;
                const int kpos = isctx ? (rc & 255) : 256 + tok;
                const size_t kvrow = (size_t)b * KVLEN + kpos;
                float ss = 0.f;
#pragma unroll
                for (int bj = 0; bj < 2; ++bj) {
                    const int col = u.pn * 256 + bj * 128 + wc * 32 + 8 * fq;
                    float v[8];
#pragma unroll
                    for (int j = 0; j < 4; ++j) { v[j] = acc[ai][bj][m][0][j]; v[4 + j] = acc[ai][bj][m][1][j]; }
                    if (col < 384) {
#pragma unroll
                        for (int j = 0; j < 8; ++j) ss += v[j] * v[j];
                        *(u32x4*)(lat + (size_t)row * 512 + col) = pack8(v);
                    } else if (col < 416) {
                        if (!isctx) rope8(v, rope + ((size_t)tok * 16 + ((col - 384) >> 1)) * 2);
                        *(u32x4*)(KPE + kvrow * 32 + (col - 384)) = pack8(v);
                    }
                }
                ss += shfl_xor_l(ss, 16, lane_e); ss += shfl_xor_l(ss, 32, lane_e);
                if (fq == 0 && (u.pn == 0 || wc < 4)) unsafeAtomicAdd((u.pn == 0 ? ssq_q : ssq_kv) + row, ss);
            }
    }
};

struct EpiResid {
    static constexpr bool PERM = false;
    const float* xin_l; const float* xin_c; float* xout_l; float* xout_c; const float* gate;
    __device__ __forceinline__ void operator()(AccRef acc, const pg8::Unit& u, int wr, int wc, int fr_, int fq_) const {
        int lane_e = lane_id(); asm volatile("" : "+v"(lane_e)); const int fr = lane_e & 15, fq = lane_e >> 4; (void)fr_; (void)fq_;
#pragma unroll
        for (int ai = 0; ai < 2; ++ai)
#pragma unroll
            for (int m = 0; m < 4; ++m) {
                const int row = u.pm * 256 + ai * 128 + wr * 64 + m * 16 + fr;
                const bool isctx = row >= ML;
                const float* xi = isctx ? xin_c + (size_t)(row - ML) * DM : xin_l + (size_t)row * DM;
                float* xo = isctx ? xout_c + (size_t)(row - ML) * DM : xout_l + (size_t)row * DM;
                const float* gp = gate + (isctx ? 8 : (row >> 13)) * 6144;
#pragma unroll
                for (int bj = 0; bj < 2; ++bj)
#pragma unroll
                    for (int n = 0; n < 2; ++n) {
                        const int col = u.pn * 256 + bj * 128 + wc * 32 + 16 * n + 4 * fq;
                        const f32x4 x = *(const f32x4*)(xi + col), gv = *(const f32x4*)(gp + col);
                        *(f32x4*)(xo + col) = x + gv * acc[ai][bj][m][n];
                    }
            }
    }
};

struct EpiSqRelu {
    static constexpr bool PERM = true;
    bf16_t* O; int ldc;
    __device__ __forceinline__ void operator()(AccRef acc, const pg8::Unit& u, int wr, int wc, int fr_, int fq_) const {
        int lane_e = lane_id(); asm volatile("" : "+v"(lane_e)); const int fr = lane_e & 15, fq = lane_e >> 4; (void)fr_; (void)fq_;
#pragma unroll
        for (int ai = 0; ai < 2; ++ai)
#pragma unroll
            for (int m = 0; m < 4; ++m) {
                const int row = u.pm * 256 + ai * 128 + wr * 64 + m * 16 + fr;
#pragma unroll
                for (int bj = 0; bj < 2; ++bj) {
                    const int col = u.pn * 256 + bj * 128 + wc * 32 + 8 * fq;
                    float v[8];
#pragma unroll
                    for (int j = 0; j < 4; ++j) { float a = fmaxf(acc[ai][bj][m][0][j], 0.f), c = fmaxf(acc[ai][bj][m][1][j], 0.f); v[j] = a * a; v[4 + j] = c * c; }
                    *(u32x4*)(O + (size_t)row * ldc + col) = pack8(v);
                }
            }
    }
};

constexpr int KP = 208, VP = 144;
constexpr int KT_BYTES = 64 * KP, VT_BYTES = 64 * VP, ABUF = KT_BYTES + VT_BYTES;
constexpr int ATT_BIAS_OFF = 2 * ABUF;
struct AttnP { const bf16_t* Q; const bf16_t* K; const bf16_t* KPE; const bf16_t* VT; bf16_t* O; const float* sink; const float* bias; int nunits; };

template <int VAR>
__device__ __forceinline__ void attn_phase(LAS unsigned char* lds, const AttnP P, int vcu, int G, int wave_s) {
    constexpr int ND0 = (VAR == 0) ? 6 : 4;
    constexpr int QPITCH = (VAR == 0) ? 1536 : 1024, QH = (VAR == 0) ? 96 : 64;
    constexpr int KPITCH = (VAR == 1) ? 256 : 1024, VCOLS = (VAR == 1) ? 256 : 1024;
    int tid_l = wave_s * 64 + lane_id(); asm volatile("" : "+v"(tid_l));
    const int tid = tid_l, lane = tid & 63, r32 = lane & 31, hi = lane >> 5;
    const int w = __builtin_amdgcn_readfirstlane(tid >> 6);
    LAS float* bias_lds = (LAS float*)(lds + ATT_BIAS_OFF);
    for (int it = 0;; ++it) {
        int u;
        if (VAR == 0 && G == 256) { u = (it < 16) ? ((it * 8 + (vcu >> 5)) * 32 + (vcu & 31)) : (4096 + (it - 16) * 256 + vcu); }
        else u = it * G + vcu;
        if (u >= P.nunits) break;
        const bool isctx = u >= 4096;
        int b, hq, hk, qrow, nt; int p_a = 0, p_b = 0;
        if (VAR == 0) {
            if (!isctx) { const int bh = u >> 5, qb = u & 31; b = bh >> 4; hq = bh & 15; qrow = b * SEQ + qb * 256 + 32 * w; nt = 132; }
            else { const int cu = u - 4096; b = cu >> 4; hq = cu & 15; qrow = ML + b * 256 + 32 * w; nt = 4; }
            hk = hq;
        } else if (VAR == 1) {
            if (!isctx) { const int blk = u & 63, hp = (u >> 6) & 7; b = u >> 9; hq = 2 * hp + (w >> 2); hk = hp >> 1; qrow = b * SEQ + blk * 128 + 32 * (w & 3);
                          const int jlo = blk == 0 ? 2 : 0, jhi = blk == 63 ? 4 : 6; nt = 4 + jhi - jlo; p_a = blk * 128 - 128 + 64 * jlo;   p_b = blk * 128 + 32 * (w & 3);   }
            else { const int cu = u - 4096, half = cu & 1, hp = (cu >> 1) & 7; b = cu >> 4; hq = 2 * hp + (w >> 2); hk = hp >> 1; qrow = ML + b * 256 + half * 128 + 32 * (w & 3); nt = 4; }
        } else {
            if (!isctx) { const int rq = u & 31; hq = (u >> 5) & 15; b = u >> 9; const int r0 = 4 * rq; qrow = b * SEQ + (r0 + (w >> 1)) * 64 + 32 * (w & 1);
                          int lo = r0 - 4; lo = lo < 0 ? 0 : (lo > 120 ? 120 : lo); int h2 = r0 - 1; h2 = h2 < 0 ? 0 : (h2 > 120 ? 120 : h2); nt = 4 + (h2 + 8 - lo); p_a = lo;   p_b = r0 + (w >> 1);   }
            else { const int cu = u - 4096; b = cu >> 4; hq = cu & 15; qrow = ML + b * 256 + 32 * w; nt = 4; }
            hk = hq;
        }
        if (VAR == 2 && !isctx) { if (tid < 465) bias_lds[tid] = P.bias[hq * 465 + tid] * LOG2E; }
        bf16x8 qf[ND0];
        { const bf16_t* qp = P.Q + (size_t)(qrow + r32) * QPITCH + hq * QH + hi * 8;
#pragma unroll
          for (int d0 = 0; d0 < ND0; ++d0) qf[d0] = *(const bf16x8*)(qp + d0 * 16); }
        float mrun = -1e30f, lrun = 0.f;
        if (VAR == 1) { mrun = P.sink[hq] * LOG2E; lrun = (hi == 0) ? 1.f : 0.f; }
        f32x16 o0 = {}, o1 = {};
        const bf16_t* kbase = P.K + ((size_t)b * KVLEN + (tid >> 3)) * KPITCH + hk * 64 + (tid & 7) * 8;
        const bf16_t* pebase = P.KPE + ((size_t)b * KVLEN + (tid >> 2)) * 32 + (tid & 3) * 8;
        const bf16_t* vbase = P.VT + ((size_t)(b * VCOLS + hk * 64 + (tid >> 3))) * KVLEN + (tid & 7) * 8;
        u32x4 kreg, pereg = {}, vreg;
#define TILE_KPOS(t) ((t) < 4 ? 64 * (t) : (VAR == 0 ? 64 * (t) : (VAR == 1 ? 256 + p_a + 64 * ((t) - 4) : 256 + 64 * (p_a + (t) - 4))))
#define TILE_LOAD(t) do { const int kp_ = TILE_KPOS(t); kreg = *(const u32x4*)(kbase + (size_t)kp_ * KPITCH); \
        if (VAR == 0 && tid < 256) pereg = *(const u32x4*)(pebase + (size_t)kp_ * 32); vreg = *(const u32x4*)(vbase + kp_); } while (0)
#define TILE_STORE(buf) do { LAS unsigned char* kb_ = lds + (buf) * ABUF; *(LAS u32x4*)(kb_ + (tid >> 3) * KP + (tid & 7) * 16) = kreg; \
        if (VAR == 0 && tid < 256) *(LAS u32x4*)(kb_ + (tid >> 2) * KP + 128 + (tid & 3) * 16) = pereg; \
        *(LAS u32x4*)(kb_ + KT_BYTES + (tid >> 3) * VP + (tid & 7) * 16) = vreg; } while (0)
        TILE_LOAD(0); TILE_STORE(0); __syncthreads();
        for (int t = 0; t < nt; ++t) {
            if (t + 1 < nt) TILE_LOAD(t + 1);
            bool need = true;
            if (VAR == 1 && t >= 4) { const int lp = p_a + 64 * (t - 4); need = (lp + 63 >= p_b - 128) && (lp <= p_b + 31 + 128); }
            if (VAR == 2 && t >= 4) { const int kr = p_a + t - 4; int rs = p_b - 4; rs = rs < 0 ? 0 : (rs > 120 ? 120 : rs); need = (kr >= rs) && (kr < rs + 8); }
            if (need) {
                const LAS unsigned char* kt = lds + (t & 1) * ABUF; const LAS unsigned char* vt = kt + KT_BYTES;
                f32x16 p0 = {}, p1 = {};
#pragma unroll
                for (int d0 = 0; d0 < ND0; ++d0) {
                    const bf16x8 k0 = *(const LAS bf16x8*)(kt + r32 * KP + d0 * 32 + hi * 16);
                    const bf16x8 k1 = *(const LAS bf16x8*)(kt + (32 + r32) * KP + d0 * 32 + hi * 16);
                    p0 = __builtin_amdgcn_mfma_f32_32x32x16_bf16(k0, qf[d0], p0, 0, 0, 0);
                    p1 = __builtin_amdgcn_mfma_f32_32x32x16_bf16(k1, qf[d0], p1, 0, 0, 0);
                }
                if (VAR == 1 && t >= 4) {
                    const int d0_ = p_a + 64 * (t - 4) - (p_b + r32) + 4 * hi + 128;
#pragma unroll
                    for (int r = 0; r < 16; ++r) { const int dd = d0_ + (r & 3) + 8 * (r >> 2);
                        if ((unsigned)dd > 256u) p0[r] = -1e30f; if ((unsigned)(dd + 32) > 256u) p1[r] = -1e30f; }
                }
                if (VAR == 2 && t >= 4) {
                    const int kr = p_a + t - 4, c = (qrow & 63) + r32; int cs = c - 8; cs = cs < 0 ? 0 : (cs > 48 ? 48 : cs);
                    const LAS float* brow = bias_lds + (kr - p_b + 7) * 31;
#pragma unroll
                    for (int r = 0; r < 16; ++r) { const int kc = 4 * hi + (r & 3) + 8 * (r >> 2);
                        { int bi = kc - c + 15; bi = bi < 0 ? 0 : (bi > 30 ? 30 : bi); p0[r] = ((unsigned)(kc - cs) < 16u) ? p0[r] + brow[bi] : -1e30f; }
                        { int bi = kc + 32 - c + 15; bi = bi < 0 ? 0 : (bi > 30 ? 30 : bi); p1[r] = ((unsigned)(kc + 32 - cs) < 16u) ? p1[r] + brow[bi] : -1e30f; } }
                }
                float rm = fmaxf(p0[0], p1[0]);
#pragma unroll
                for (int r = 1; r < 16; ++r) rm = fmaxf(rm, fmaxf(p0[r], p1[r]));
                rm = fmaxf(rm, shfl_xor_l(rm, 32, lane));
                const float mn = fmaxf(mrun, rm), f = __builtin_amdgcn_exp2f(mrun - mn); mrun = mn;
                float sum = 0.f;
#pragma unroll
                for (int r = 0; r < 16; ++r) { p0[r] = __builtin_amdgcn_exp2f(p0[r] - mn); p1[r] = __builtin_amdgcn_exp2f(p1[r] - mn); sum += p0[r] + p1[r]; }
                lrun = lrun * f + sum;
#pragma unroll
                for (int r = 0; r < 16; ++r) { o0[r] *= f; o1[r] *= f; }
                bf16x8 pk[4];
                { u32x4 a; a.x = cvtpk(p0[0], p0[1]); a.y = cvtpk(p0[2], p0[3]); a.z = cvtpk(p0[4], p0[5]); a.w = cvtpk(p0[6], p0[7]); pk[0] = __builtin_bit_cast(bf16x8, a); }
                { u32x4 a; a.x = cvtpk(p0[8], p0[9]); a.y = cvtpk(p0[10], p0[11]); a.z = cvtpk(p0[12], p0[13]); a.w = cvtpk(p0[14], p0[15]); pk[1] = __builtin_bit_cast(bf16x8, a); }
                { u32x4 a; a.x = cvtpk(p1[0], p1[1]); a.y = cvtpk(p1[2], p1[3]); a.z = cvtpk(p1[4], p1[5]); a.w = cvtpk(p1[6], p1[7]); pk[2] = __builtin_bit_cast(bf16x8, a); }
                { u32x4 a; a.x = cvtpk(p1[8], p1[9]); a.y = cvtpk(p1[10], p1[11]); a.z = cvtpk(p1[12], p1[13]); a.w = cvtpk(p1[14], p1[15]); pk[3] = __builtin_bit_cast(bf16x8, a); }
#pragma unroll
                for (int kk = 0; kk < 4; ++kk) {
                    const bf16x8 v0 = *(const LAS bf16x8*)(vt + r32 * VP + kk * 32 + hi * 16);
                    const bf16x8 v1 = *(const LAS bf16x8*)(vt + (32 + r32) * VP + kk * 32 + hi * 16);
                    o0 = __builtin_amdgcn_mfma_f32_32x32x16_bf16(v0, pk[kk], o0, 0, 0, 0);
                    o1 = __builtin_amdgcn_mfma_f32_32x32x16_bf16(v1, pk[kk], o1, 0, 0, 0);
                }
            }
            if (t + 1 < nt) TILE_STORE((t + 1) & 1);
            __syncthreads();
        }
#undef TILE_KPOS
#undef TILE_LOAD
#undef TILE_STORE
        const float lt = lrun + shfl_xor_l(lrun, 32, lane), inv = 1.f / lt;
        bf16_t* op = P.O + (size_t)(qrow + r32) * DM + hq * 64 + 4 * hi;
#pragma unroll
        for (int g = 0; g < 4; ++g) {
            u32x2 a; a.x = cvtpk(o0[4 * g] * inv, o0[4 * g + 1] * inv); a.y = cvtpk(o0[4 * g + 2] * inv, o0[4 * g + 3] * inv); *(u32x2*)(op + 8 * g) = a;
            u32x2 c; c.x = cvtpk(o1[4 * g] * inv, o1[4 * g + 1] * inv); c.y = cvtpk(o1[4 * g + 2] * inv, o1[4 * g + 3] * inv); *(u32x2*)(op + 32 + 8 * g) = c;
        }
    }
}

constexpr size_t MiB = 1u << 20;
constexpr size_t WS_MOD = 0, WS_SSQ = 1 * MiB, WS_ROPE16 = 3 * MiB, WS_ROPE32 = 4 * MiB, WS_KPE = 6 * MiB, WS_XC = 12 * MiB;
constexpr size_t WS_W1T = 20 * MiB, WS_W2T = 52 * MiB, WS_MLA = 84 * MiB  , WS_SWA = 94 * MiB  , WS_NA = 99 * MiB  ;
constexpr size_t WS_H = 108 * MiB, WS_Q = 240 * MiB, WS_K = 438 * MiB, WS_VT = 570 * MiB, WS_O = 702 * MiB, WS_LAT = 702 * MiB, WS_HID = 240 * MiB, WS_END = 834 * MiB;

__device__ __forceinline__ float wave_sum(float v, int lane) {
#pragma unroll
    for (int o = 1; o < 64; o <<= 1) v += shfl_xor_l(v, o, lane);
    return v;
}
__device__ __forceinline__ void sincos_red(float x, float& sn, float& cs) {
    const float n = rintf(x * 0.15915494309189535f);
    float r = fmaf(-n, 6.2831854820251465f, x); r = fmaf(-n, -1.7484555e-7f, r);
    const float rev = r * 0.15915494309189535f;
    sn = __builtin_amdgcn_sinf(rev); cs = __builtin_amdgcn_cosf(rev);
}
__device__ __forceinline__ void transpose_item(const float* W, int K, int N, bf16_t* WT, const float* g, LAS float* scr, int item, int lane) {
    const int nblk = N / 32, kb = item / nblk, nb = item % nblk, k0 = 64 * kb, n0 = 32 * nb;
#pragma unroll 8
    for (int i = 0; i < 32; ++i) { const int kk = 2 * i + (lane >> 5); float v = W[(size_t)(k0 + kk) * N + n0 + (lane & 31)]; if (g) v *= g[k0 + kk]; scr[kk * 33 + (lane & 31)] = v; }
    asm volatile("s_waitcnt lgkmcnt(0)" ::: "memory");
    const int c = lane & 7;
#pragma unroll
    for (int j = 0; j < 4; ++j) { const int n = (lane >> 3) + 8 * j; const LAS float* s = scr + (8 * c) * 33 + n;
        u32x4 o; o.x = cvtpk(s[0 * 33], s[1 * 33]); o.y = cvtpk(s[2 * 33], s[3 * 33]); o.z = cvtpk(s[4 * 33], s[5 * 33]); o.w = cvtpk(s[6 * 33], s[7 * 33]);
        *(u32x4*)(WT + (size_t)(n0 + n) * K + k0 + 8 * c) = o; }
    asm volatile("s_waitcnt lgkmcnt(0)" ::: "memory");
}

struct Args { const float* in[23]; float* out; unsigned char* ws; };

__device__ __forceinline__ void norm_pass(const float* xl, const float* xc, const float* g, const float* mod, int sh_off, int sc_off, bf16_t* H, int Mrows, int gw, int NGW) {
    int lane = lane_id(); asm volatile("" : "+v"(lane));
    for (int row = gw; row < Mrows; row += NGW) {
        const bool isctx = row >= ML;
        const float* xr = isctx ? xc + (size_t)(row - ML) * DM : xl + (size_t)row * DM;
        const float* mp = mod + (isctx ? 8 : (row >> 13)) * 6144;
        f32x4 v[4]; float ss = 0.f;
#pragma unroll
        for (int j = 0; j < 4; ++j) { v[j] = *(const f32x4*)(xr + 4 * lane + 256 * j); ss += (v[j][0] * v[j][0] + v[j][1] * v[j][1]) + (v[j][2] * v[j][2] + v[j][3] * v[j][3]); }
        const float rstd = rsqrtf(wave_sum(ss, lane) * (1.f / DM) + EPS);
#pragma unroll
        for (int j = 0; j < 4; ++j) { const int col = 4 * lane + 256 * j;
            const f32x4 gg = *(const f32x4*)(g + col), sh = *(const f32x4*)(mp + sh_off + col), sc = *(const f32x4*)(mp + sc_off + col);
            const f32x4 y = v[j] * rstd * gg * (sc + 1.f) + sh;
            u32x2 o; o.x = cvtpk(y[0], y[1]); o.y = cvtpk(y[2], y[3]); *(u32x2*)(H + (size_t)row * DM + col) = o; }
    }
}

__global__ void __launch_bounds__(512, 2) fwd_megakernel(Args a) {
    extern __shared__ __attribute__((aligned(16))) unsigned char lds_raw[];
    LAS unsigned char* lds = (LAS unsigned char*)lds_raw;
    cg::grid_group grid = cg::this_grid();
    const int wave = __builtin_amdgcn_readfirstlane((int)threadIdx.x >> 6);
    const int G = gridDim.x, bid = blockIdx.x;
    const int vcu = (G % 8 == 0) ? (bid % 8) * (G / 8) + bid / 8 : bid;
    const int gw = vcu * 8 + wave, NGW = G * 8;
    unsigned char* ws = a.ws;
    const float* x_in = a.in[0]; const float* c_in = a.in[1]; const float* ctx_in = a.in[2]; const float* cctx_in = a.in[3];
    const float* ada_w = a.in[4]; const float* ada_b = a.in[5]; const float* norm_mix_g = a.in[6]; const float* norm_mlp_g = a.in[7]; const float* norm_out_g = a.in[8];
    float* MOD = (float*)(ws + WS_MOD); float* SSQ = (float*)(ws + WS_SSQ);
    float* ROPE16 = (float*)(ws + WS_ROPE16); float* ROPE32 = (float*)(ws + WS_ROPE32);
    bf16_t* KPE = (bf16_t*)(ws + WS_KPE); float* XC = (float*)(ws + WS_XC);
    bf16_t* H = (bf16_t*)(ws + WS_H); bf16_t* Qb = (bf16_t*)(ws + WS_Q); bf16_t* Kb = (bf16_t*)(ws + WS_K); bf16_t* VTb = (bf16_t*)(ws + WS_VT);
    bf16_t* Ob = (bf16_t*)(ws + WS_O); bf16_t* LAT = (bf16_t*)(ws + WS_LAT); bf16_t* HID = (bf16_t*)(ws + WS_HID);
    float* X = a.out;

    {
        const int lane = lane_id(), tid = wave * 64 + lane;
        LAS float* act = (LAS float*)(lds + 65536); LAS float* red = (LAS float*)(lds + 102400);
        for (int i = tid; i < 9 * 1024; i += 512) { const int b = i >> 10, k = i & 1023; const float v = b < 8 ? c_in[b * 1024 + k] : cctx_in[k]; act[i] = v / (1.f + __builtin_amdgcn_exp2f(-v * LOG2E)); }
        __syncthreads();
        for (int it = bid; it < 384; it += G) {
            const int layer = it / 96, n0 = (it % 96) * 64;
            const float* W = ada_w + (size_t)layer * 1024 * 6144 + n0 + lane;
            float s0 = 0, s1 = 0, s2 = 0, s3 = 0, s4 = 0, s5 = 0, s6 = 0, s7 = 0, s8 = 0;
#pragma unroll 8
            for (int k = wave * 128; k < wave * 128 + 128; ++k) { const float wv = W[(size_t)k * 6144];
                s0 += act[k] * wv; s1 += act[1024 + k] * wv; s2 += act[2048 + k] * wv; s3 += act[3072 + k] * wv; s4 += act[4096 + k] * wv;
                s5 += act[5120 + k] * wv; s6 += act[6144 + k] * wv; s7 += act[7168 + k] * wv; s8 += act[8192 + k] * wv; }
            LAS float* rp = red + wave * 576 + lane;
            rp[0] = s0; rp[64] = s1; rp[128] = s2; rp[192] = s3; rp[256] = s4; rp[320] = s5; rp[384] = s6; rp[448] = s7; rp[512] = s8;
            __syncthreads();
            for (int i = tid; i < 576; i += 512) { float s = 0.f;
#pragma unroll
                for (int ww = 0; ww < 8; ++ww) s += red[ww * 576 + i];
                const int b = i >> 6, l = i & 63; MOD[((size_t)layer * 9 + b) * 6144 + n0 + l] = s + ada_b[layer * 6144 + n0 + l]; }
            __syncthreads();
        }
        __syncthreads();
        LAS float* scr = (LAS float*)(lds + wave * 16384);
        int base = 0;
#define TR(Wsrc, K_, N_, dst, gsc) do { const int n_ = ((K_) / 64) * ((N_) / 32); \
            for (int it_ = (gw + NGW - (base % NGW)) % NGW; it_ < n_; it_ += NGW) transpose_item((Wsrc), (K_), (N_), (dst), (gsc), scr, it_, lane); base += n_; } while (0)
        for (int L = 0; L < 4; ++L) {
            TR(a.in[9] + (size_t)L * DM * FF, DM, FF, (bf16_t*)(ws + WS_W1T + (size_t)L * 8 * MiB), (const float*)nullptr);
            TR(a.in[10] + (size_t)L * FF * DM, FF, DM, (bf16_t*)(ws + WS_W2T + (size_t)L * 8 * MiB), (const float*)nullptr);
        }
        for (int j = 0; j < 2; ++j) {
            unsigned char* mb = ws + WS_MLA + (size_t)j * 5 * MiB;
            TR(a.in[11] + (size_t)j * DM * 416, DM, 416, (bf16_t*)mb, (const float*)nullptr);
            TR(a.in[13] + (size_t)j * 256 * 1536, 256, 1536, (bf16_t*)(mb + 1 * MiB), a.in[12] + j * 256);
            TR(a.in[15] + (size_t)j * 128 * 2048, 128, 2048, (bf16_t*)(mb + 1 * MiB + 768 * 1024), a.in[14] + j * 128);
            TR(a.in[16] + (size_t)j * DM * DM, DM, DM, (bf16_t*)(mb + 3 * MiB), (const float*)nullptr);
            u32x4* z = (u32x4*)(mb + (size_t)416 * 1024 * 2);
            for (int i = gw * 64 + lane; i < 96 * 1024 * 2 / 16; i += NGW * 64) z[i] = (u32x4){0u, 0u, 0u, 0u};
        }
        TR(a.in[17], DM, 1536, (bf16_t*)(ws + WS_SWA), (const float*)nullptr);
        TR(a.in[19], DM, DM, (bf16_t*)(ws + WS_SWA + 3 * MiB), (const float*)nullptr);
        TR(a.in[20], DM, 3072, (bf16_t*)(ws + WS_NA), (const float*)nullptr);
        TR(a.in[22], DM, DM, (bf16_t*)(ws + WS_NA + 6 * MiB), (const float*)nullptr);
#undef TR
        for (int i = gw * 64 + lane; i < 8192 * 16; i += NGW * 64) { const int t = i >> 4, p = i & 15; const int f = p & 7; const float pos = (float)(p < 8 ? (t >> 6) : (t & 63));
            const float ang = pos * __builtin_amdgcn_exp2f(-(float)f * (13.287712379549449f / 8.f)); float sn, cs; sincos_red(ang, sn, cs); ROPE16[2 * i] = cs; ROPE16[2 * i + 1] = sn; }
        for (int i = gw * 64 + lane; i < 8192 * 32; i += NGW * 64) { const int t = i >> 5, p = i & 31; const int f = p & 15; const float pos = (float)(p < 16 ? (t >> 6) : (t & 63));
            const float ang = pos * __builtin_amdgcn_exp2f(-(float)f * (13.287712379549449f / 16.f)); float sn, cs; sincos_red(ang, sn, cs); ROPE32[2 * i] = cs; ROPE32[2 * i + 1] = sn; }
        for (int i = gw * 64 + lane; i < 4 * MT; i += NGW * 64) SSQ[i] = 0.f;
    }
    grid.sync();

    for (int L = 0; L < 4; ++L) {
        const int kind = L % 3, jl = L / 3; const bool last = (L == 3);
        const float* modL = MOD + (size_t)L * 9 * 6144;
        const float* xl = (L == 0) ? x_in : X; const float* xc = (L == 0) ? ctx_in : XC;
        norm_pass(xl, xc, norm_mix_g + L * DM, modL, 0, 1024, H, MT, gw, NGW);
        grid.sync();
        if (kind == 0) {
            unsigned char* mb = ws + WS_MLA + (size_t)jl * 5 * MiB;
            float* ssq_q = SSQ + (size_t)jl * 2 * MT; float* ssq_kv = ssq_q + MT;
            {
                pg8::Gemm g{H, (const bf16_t*)mb, MT, 512, DM, DM, DM}; pg8::StaticOrder S; S.init(MT, 512, G, bid);
                EpiLat E{LAT, ssq_q, ssq_kv, KPE, ROPE16};
                pg8::gemm_phase<EpiLat, pg8::StaticOrder, true>(lds, g, S, E, wave);
            }
            grid.sync();
            {
                pg8::Gemm g{LAT, (const bf16_t*)(mb + 1 * MiB), MT, 1536, 256, 512, 256}; pg8::StaticOrder S; S.init(MT, 1536, G, bid);
                EpiProj<0> E{Qb, nullptr, nullptr, ROPE16, ssq_q, 0.10206207261596577f * LOG2E};
                pg8::gemm_phase<EpiProj<0>, pg8::StaticOrder, true>(lds, g, S, E, wave);
            }
            {
                pg8::Gemm g{LAT + 256, (const bf16_t*)(mb + 1 * MiB + 768 * 1024), MT, 2048, 128, 512, 128}; pg8::StaticOrder S; S.init(MT, 2048, G, bid);
                EpiProj<1> E{nullptr, Kb, VTb, nullptr, ssq_kv, 1.f};
                pg8::gemm_phase<EpiProj<1>, pg8::StaticOrder, true>(lds, g, S, E, wave);
            }
        } else if (kind == 1) {
            pg8::Gemm g{H, (const bf16_t*)(ws + WS_SWA), MT, 1536, DM, DM, DM}; pg8::StaticOrder S; S.init(MT, 1536, G, bid);
            EpiProj<2> E{Qb, Kb, VTb, ROPE32, nullptr, 0.125f * LOG2E};
            pg8::gemm_phase<EpiProj<2>, pg8::StaticOrder, true>(lds, g, S, E, wave);
        } else {
            pg8::Gemm g{H, (const bf16_t*)(ws + WS_NA), MT, 3072, DM, DM, DM}; pg8::StaticOrder S; S.init(MT, 3072, G, bid);
            EpiProj<3> E{Qb, Kb, VTb, nullptr, nullptr, 0.125f * LOG2E};
            pg8::gemm_phase<EpiProj<3>, pg8::StaticOrder, true>(lds, g, S, E, wave);
        }
        grid.sync();
        {
            AttnP P{Qb, Kb, KPE, VTb, Ob, a.in[18], a.in[21], last ? 4096 : 4096 + 128};
            if (kind == 0) attn_phase<0>(lds, P, vcu, G, wave);
            else if (kind == 1) attn_phase<1>(lds, P, vcu, G, wave);
            else attn_phase<2>(lds, P, vcu, G, wave);
        }
        grid.sync();
        const int Mres = last ? ML : MT;
        {
            const bf16_t* wo = (const bf16_t*)(kind == 0 ? ws + WS_MLA + (size_t)jl * 5 * MiB + 3 * MiB : (kind == 1 ? ws + WS_SWA + 3 * MiB : ws + WS_NA + 6 * MiB));
            pg8::Gemm g{Ob, wo, Mres, DM, DM, DM, DM}; pg8::StaticOrder S; S.init(Mres, DM, G, bid);
            EpiResid E{xl, xc, X, XC, modL + 2048};
            pg8::gemm_phase<EpiResid, pg8::StaticOrder, true>(lds, g, S, E, wave);
        }
        grid.sync();
        norm_pass(X, XC, norm_mlp_g + L * DM, modL, 3072, 4096, H, Mres, gw, NGW);
        grid.sync();
        {
            pg8::Gemm g{H, (const bf16_t*)(ws + WS_W1T + (size_t)L * 8 * MiB), Mres, FF, DM, DM, DM}; pg8::StaticOrder S; S.init(Mres, FF, G, bid);
            EpiSqRelu E{HID, FF};
            pg8::gemm_phase<EpiSqRelu, pg8::StaticOrder, true>(lds, g, S, E, wave);
        }
        grid.sync();
        {
            pg8::Gemm g{HID, (const bf16_t*)(ws + WS_W2T + (size_t)L * 8 * MiB), Mres, DM, FF, FF, FF}; pg8::StaticOrder S; S.init(Mres, DM, G, bid);
            EpiResid E{X, XC, X, XC, modL + 5120};
            pg8::gemm_phase<EpiResid, pg8::StaticOrder, true>(lds, g, S, E, wave);
        }
        grid.sync();
    }
    int lane = lane_id(); asm volatile("" : "+v"(lane));
    for (int row = gw; row < ML; row += NGW) {
        float* xr = X + (size_t)row * DM;
        f32x4 v[4]; float ss = 0.f;
#pragma unroll
        for (int j = 0; j < 4; ++j) { v[j] = *(const f32x4*)(xr + 4 * lane + 256 * j); ss += (v[j][0] * v[j][0] + v[j][1] * v[j][1]) + (v[j][2] * v[j][2] + v[j][3] * v[j][3]); }
        const float rstd = rsqrtf(wave_sum(ss, lane) * (1.f / DM) + EPS);
#pragma unroll
        for (int j = 0; j < 4; ++j) { const int col = 4 * lane + 256 * j; const f32x4 gg = *(const f32x4*)(norm_out_g + col); *(f32x4*)(xr + col) = v[j] * rstd * gg; }
    }
}

constexpr int LDS_BYTES = 147456;
extern "C" void kernel_launch(void* const* d_in, const int* in_sizes, int n_in, void* d_out, int out_size, void* d_ws, size_t ws_size, hipStream_t stream) {
    static int grid = 0;
    if (grid == 0) {
        if (n_in != 23 || out_size != ML * DM || ws_size < WS_END) { fprintf(stderr, "kernel_launch: unexpected shapes (n_in %d out %d ws %zu)\n", n_in, out_size, ws_size); grid = -1; return; }
        int dev = 0, cus = 0, per_cu = 0;
        hipGetDevice(&dev); hipDeviceGetAttribute(&cus, hipDeviceAttributeMultiprocessorCount, dev);
        if (hipFuncSetAttribute((const void*)fwd_megakernel, hipFuncAttributeMaxDynamicSharedMemorySize, LDS_BYTES) != hipSuccess) { fprintf(stderr, "kernel_launch: hipFuncSetAttribute failed\n"); grid = -1; return; }
        if (hipOccupancyMaxActiveBlocksPerMultiprocessor(&per_cu, (const void*)fwd_megakernel, 512, LDS_BYTES) != hipSuccess || per_cu < 1) { fprintf(stderr, "kernel_launch: occupancy query gave %d\n", per_cu); per_cu = 1; }
        (void)hipGetLastError();
        grid = cus * per_cu;
    }
    if (grid < 0) return;
    Args a{};
    for (int i = 0; i < 23; ++i) a.in[i] = (const float*)d_in[i];
    a.out = (float*)d_out; a.ws = (unsigned char*)d_ws;
    void* args[] = {&a};
    hipError_t e = hipLaunchCooperativeKernel((const void*)fwd_megakernel, dim3(grid), dim3(512), args, LDS_BYTES, stream);
    if (e != hipSuccess) fprintf(stderr, "cooperative launch failed: %s (grid %d)\n", hipGetErrorString(e), grid);
}
```

```cpp
#include <hip/hip_runtime.h>
#include <hip/hip_cooperative_groups.h>
#include <cstdio>
#include <cstdint>
namespace cg = cooperative_groups;

#define LAS __attribute__((address_space(3)))
typedef unsigned short bf16_t;
typedef short bf16x8 __attribute__((ext_vector_type(8)));
typedef float f32x4 __attribute__((ext_vector_type(4)));
typedef float f32x16 __attribute__((ext_vector_type(16)));
typedef unsigned u32x4 __attribute__((ext_vector_type(4)));
typedef unsigned u32x2 __attribute__((ext_vector_type(2)));

constexpr int NB = 8, SEQ = 8192, DM = 1024, CTX = 256, FF = 4096;
constexpr int ML = NB * SEQ;
constexpr int MC = NB * CTX;
constexpr int MT = ML + MC;
constexpr int KVLEN = CTX + SEQ;
constexpr float EPS = 1e-6f;
constexpr float LOG2E = 1.4426950408889634f;

__device__ __forceinline__ unsigned cvtpk(float lo, float hi) {
    typedef float f2 __attribute__((ext_vector_type(2))); typedef __bf16 b2 __attribute__((ext_vector_type(2)));
    f2 v = {lo, hi}; b2 b = __builtin_convertvector(v, b2); return __builtin_bit_cast(unsigned, b);
}
__device__ __forceinline__ int lane_id() { int l; asm volatile("v_mbcnt_lo_u32_b32 %0, -1, 0\n\tv_mbcnt_hi_u32_b32 %0, -1, %0" : "=v"(l)); return l; }
__device__ __forceinline__ float shfl_xor_l(float v, int mask, int lane) { return __int_as_float(__builtin_amdgcn_ds_bpermute((lane ^ mask) << 2, __float_as_int(v))); }
__device__ __forceinline__ int perm16(int x) { return 8 * ((x >> 2) & 1) + (x & 3) + 4 * (x >> 3); }

namespace pg8 {
constexpr int BM = 256, BK = 64, HALF = 128, HTB = HALF * BK * 2, STAGE_BYTES = 8 * HTB, NXCD = 8, WGM = 8;
__host__ __device__ __forceinline__ int lds_byte(int r, int c) { const int st = (r >> 4) * 2 + (c >> 5), rr = r & 15, cc = c & 31, ob = rr * 64 + cc * 2; return st * 1024 + (ob ^ (((ob >> 9) & 1) << 5)); }
__host__ __device__ __forceinline__ void stage_rc(int b, int& R, int& C) { const int st = b / 1024, sb = b % 1024, swz = sb ^ (((sb >> 9) & 1) << 5); R = (st >> 1) * 16 + swz / 64; C = (st & 1) * 32 + (swz % 64) / 2; }
__host__ __device__ __forceinline__ int perm32(int rho) { const int n = rho >> 4, i = rho & 15; return 8 * (i >> 2) + 4 * n + (i & 3); }

struct Unit { int pm, pn; };
struct Gemm { const bf16_t* A; const bf16_t* Bt; int M, N, K, lda, ldb; };

struct StaticOrder {
    int nM, nN, nwg, G, c;
    __device__ void init(int M, int N, int G_, int c_) { nM = M / BM; nN = N / BM; nwg = nM * nN; G = G_; c = c_; }
    __device__ bool next(int i, Unit& u) const {
        const long L = (long)i * G + c; if (L >= nwg) return false;
        int wgid = (int)L; { const int q = nwg / NXCD, r = nwg % NXCD, xcd = wgid % NXCD, off = wgid / NXCD; wgid = (xcd < r ? xcd * (q + 1) : r * (q + 1) + (xcd - r) * q) + off; }
        const int nig = WGM * nN, gid = wgid / nig, fm = gid * WGM, gsz = (nM - fm) < WGM ? (nM - fm) : WGM;
        u.pm = fm + ((wgid % nig) % gsz); u.pn = (wgid % nig) / gsz; return true;
    }
};

template <class Epi, class Sched, bool ALIGN_EPI>
__device__ __forceinline__ void gemm_phase(LAS unsigned char* lds, const Gemm g, const Sched& S, const Epi& E, int wave_s) {
    int tid_l = wave_s * 64 + lane_id(); asm volatile("" : "+v"(tid_l));
    const int tid = tid_l, wid = __builtin_amdgcn_readfirstlane(tid >> 6), lane = tid & 63, wr = wid >> 2, wc = wid & 3, fr = lane & 15, fq = lane >> 4;
    const int K = g.K, nt = K / BK;
    unsigned voffA[2], voffB[2];
#pragma unroll
    for (int i = 0; i < 2; ++i) { int R, C; stage_rc(tid * 16 + i * 8192, R, C); const int Rb = Epi::PERM ? ((R & ~31) + perm32(R & 31)) : R;
        voffA[i] = (unsigned)(R * g.lda + C) * 2u; voffB[i] = (unsigned)(Rb * g.ldb + C) * 2u; }
    const size_t kstep = (size_t)(BK * 2);
    const size_t hstepA = (size_t)HALF * g.lda * 2, hstepB = (size_t)HALF * g.ldb * 2;
    const size_t tstepA = 2 * hstepA, tstepB = 2 * hstepB;
    const unsigned ldsw = (unsigned)wid * 1024u;
    const int aoff = lds_byte(wr * 64 + fr, fq * 8), boff = lds_byte(wc * 32 + fr, fq * 8);
#define PG8_SA(b, h) (((b) * 2 + (h)) * HTB)
#define PG8_SB(b, h) ((4 + (b) * 2 + (h)) * HTB)
#define PG8_STAGE(bufoff, gbase, voff) do { _Pragma("unroll") for (int _i = 0; _i < 2; ++_i) \
        __builtin_amdgcn_global_load_lds((const unsigned*)((const char*)(gbase) + (voff)[_i]), (LAS unsigned*)(lds + (bufoff) + ldsw + _i * 8192), 16, 0, 0); } while (0)
#define PG8_LDA(dst, b, h) do { _Pragma("unroll") for (int m = 0; m < 4; ++m) _Pragma("unroll") for (int k = 0; k < 2; ++k) dst[m][k] = *(const LAS bf16x8*)(lds + PG8_SA(b, h) + aoff + m * 2048 + k * 1024); } while (0)
#define PG8_LDB(dst, b, h) do { _Pragma("unroll") for (int n = 0; n < 2; ++n) _Pragma("unroll") for (int k = 0; k < 2; ++k) dst[n][k] = *(const LAS bf16x8*)(lds + PG8_SB(b, h) + boff + n * 2048 + k * 1024); } while (0)
#define PG8_MMA(ai, bj, At, Bt) do { __builtin_amdgcn_s_setprio(1); _Pragma("unroll") for (int m = 0; m < 4; ++m) _Pragma("unroll") for (int n = 0; n < 2; ++n) _Pragma("unroll") for (int k = 0; k < 2; ++k) \
        acc[ai][bj][m][n] = __builtin_amdgcn_mfma_f32_16x16x32_bf16(Bt[n][k], At[m][k], acc[ai][bj][m][n], 0, 0, 0); __builtin_amdgcn_s_setprio(0); } while (0)
#define PG8_WAIT_V(n) asm volatile("s_waitcnt vmcnt(" #n ")" ::: "memory")
#define PG8_WAIT_L(n) asm volatile("s_waitcnt lgkmcnt(" #n ")" ::: "memory")
#define PG8_BAR __builtin_amdgcn_s_barrier()
#define PG8_SCHED __builtin_amdgcn_sched_barrier(0)
    Unit cur, nxt; int ui = 0;
    if (!S.next(0, cur)) return;
    f32x4 acc[2][2][4][2];
#pragma unroll
    for (int a = 0; a < 2; ++a)
#pragma unroll
        for (int b = 0; b < 2; ++b)
#pragma unroll
            for (int m = 0; m < 4; ++m)
#pragma unroll
                for (int n = 0; n < 2; ++n) acc[a][b][m][n] = (f32x4){0.f, 0.f, 0.f, 0.f};
    bf16x8 At[4][2], B0[2][2], B1[2][2];
    const char* cA = (const char*)g.A + (size_t)cur.pm * tstepA; const char* cB = (const char*)g.Bt + (size_t)cur.pn * tstepB;
    PG8_STAGE(PG8_SB(0, 0), cB, voffB); PG8_STAGE(PG8_SB(0, 1), cB + hstepB, voffB); PG8_STAGE(PG8_SA(0, 0), cA, voffA); PG8_STAGE(PG8_SA(0, 1), cA + hstepA, voffA);
    if (wr == 1) PG8_BAR;
    PG8_WAIT_V(2); PG8_BAR;
    PG8_STAGE(PG8_SB(1, 0), cB + kstep, voffB); PG8_STAGE(PG8_SA(1, 0), cA + kstep, voffA); PG8_STAGE(PG8_SB(1, 1), cB + hstepB + kstep, voffB);
    PG8_WAIT_V(6); PG8_BAR;
    for (;;) {
        const bool has_next = S.next(ui + 1, nxt);
        const char* nA = has_next ? (const char*)g.A + (size_t)nxt.pm * tstepA : cA; const char* nB = has_next ? (const char*)g.Bt + (size_t)nxt.pn * tstepB : cB;
        for (int t = 0; t < nt; t += 2) {
            const bool last = (t == nt - 2);
            const char* a1 = cA + (size_t)(t + 1) * kstep;
            const char* a2 = last ? nA : cA + (size_t)(t + 2) * kstep; const char* b2 = last ? nB : cB + (size_t)(t + 2) * kstep;
            const char* a3 = a2 + kstep; const char* b3 = b2 + kstep;
            PG8_LDB(B0, 0, 0); PG8_LDB(B1, 0, 1); PG8_SCHED; PG8_LDA(At, 0, 0); PG8_STAGE(PG8_SA(1, 1), a1 + hstepA, voffA);
            PG8_WAIT_V(8); PG8_WAIT_L(0); PG8_BAR; PG8_MMA(0, 0, At, B0); PG8_MMA(0, 1, At, B1); PG8_BAR; PG8_SCHED;
            PG8_LDA(At, 0, 1); PG8_STAGE(PG8_SB(0, 0), b2, voffB); PG8_STAGE(PG8_SB(0, 1), b2 + hstepB, voffB); PG8_STAGE(PG8_SA(0, 0), a2, voffA);
            PG8_WAIT_V(8); PG8_WAIT_L(0); PG8_BAR; PG8_MMA(1, 0, At, B0); PG8_MMA(1, 1, At, B1); PG8_BAR; PG8_SCHED;
            PG8_LDB(B0, 1, 0); PG8_LDB(B1, 1, 1); PG8_SCHED; PG8_LDA(At, 1, 0); PG8_STAGE(PG8_SA(0, 1), a2 + hstepA, voffA);
            PG8_WAIT_V(8); PG8_WAIT_L(0); PG8_BAR; PG8_MMA(0, 0, At, B0); PG8_MMA(0, 1, At, B1); PG8_BAR; PG8_SCHED;
            PG8_LDA(At, 1, 1); PG8_STAGE(PG8_SB(1, 0), b3, voffB); PG8_STAGE(PG8_SB(1, 1), b3 + hstepB, voffB); PG8_STAGE(PG8_SA(1, 0), a3, voffA);
            PG8_WAIT_V(8); PG8_WAIT_L(0); PG8_BAR; PG8_MMA(1, 0, At, B0); PG8_MMA(1, 1, At, B1); PG8_BAR; PG8_SCHED;
        }
        if constexpr (ALIGN_EPI) { if (wr == 0) PG8_BAR; }
        E(acc, cur, wr, wc, fr, fq);
        if (!has_next) break;
#pragma unroll
        for (int a = 0; a < 2; ++a)
#pragma unroll
            for (int b = 0; b < 2; ++b)
#pragma unroll
                for (int m = 0; m < 4; ++m)
#pragma unroll
                    for (int n = 0; n < 2; ++n) acc[a][b][m][n] = (f32x4){0.f, 0.f, 0.f, 0.f};
        cur = nxt; cA = nA; cB = nB; ++ui;
        if constexpr (ALIGN_EPI) { if (wr == 1) PG8_BAR; }
    }
    PG8_WAIT_V(0);
    if constexpr (!ALIGN_EPI) { if (wr == 0) PG8_BAR; }
    PG8_BAR;
#undef PG8_SA
#undef PG8_SB
#undef PG8_STAGE
#undef PG8_LDA
#undef PG8_LDB
#undef PG8_MMA
#undef PG8_WAIT_V
#undef PG8_WAIT_L
#undef PG8_BAR
#undef PG8_SCHED
}
}

typedef const f32x4 (&AccRef)[2][2][4][2];

__device__ __forceinline__ void rope8(float (&v)[8], const float* tab) {
    const f32x4 t0 = *(const f32x4*)tab, t1 = *(const f32x4*)(tab + 4);
    float x1, x2;
    x1 = v[0]; x2 = v[1]; v[0] = x1 * t0[0] - x2 * t0[1]; v[1] = x1 * t0[1] + x2 * t0[0];
    x1 = v[2]; x2 = v[3]; v[2] = x1 * t0[2] - x2 * t0[3]; v[3] = x1 * t0[3] + x2 * t0[2];
    x1 = v[4]; x2 = v[5]; v[4] = x1 * t1[0] - x2 * t1[1]; v[5] = x1 * t1[1] + x2 * t1[0];
    x1 = v[6]; x2 = v[7]; v[6] = x1 * t1[2] - x2 * t1[3]; v[7] = x1 * t1[3] + x2 * t1[2];
}
__device__ __forceinline__ u32x4 pack8(const float (&v)[8]) { u32x4 w; w.x = cvtpk(v[0], v[1]); w.y = cvtpk(v[2], v[3]); w.z = cvtpk(v[4], v[5]); w.w = cvtpk(v[6], v[7]); return w; }

template <int MODE> struct EpiProj {
    static constexpr bool PERM = true;
    bf16_t* Q; bf16_t* K; bf16_t* VT; const float* rope; const float* ssq; float qscale; const float* nbias;
    __device__ __forceinline__ void operator()(AccRef acc, const pg8::Unit& u, int wr, int wc, int fr_, int fq_) const {
        int lane_e = lane_id(); asm volatile("" : "+v"(lane_e)); const int fr = lane_e & 15, fq = lane_e >> 4; (void)fr_; (void)fq_;
        constexpr int LDQ = (MODE == 0) ? 1536 : 1024, NQ = (MODE == 0) ? 1536 : (MODE == 1 ? 0 : 1024);
        constexpr int LDK = (MODE == 2) ? 256 : 1024, NK = LDK, VCOLS = LDK;
#pragma unroll
        for (int ai = 0; ai < 2; ++ai)
#pragma unroll
            for (int m = 0; m < 4; ++m) {
                const int row = u.pm * 256 + ai * 128 + wr * 64 + m * 16 + fr;
                const bool isctx = row >= ML; const int rc = row - ML;
                const int b = isctx ? (rc >> 8) : (row >> 13);
                const int tok = row & 8191;
                const int kpos = isctx ? (rc & 255) : 256 + tok;
                const size_t kvrow = (size_t)b * KVLEN + kpos;
                const int vpos = (kpos & ~15) | perm16(kpos & 15);
                const float rs = rsqrtf(ssq[row] * (MODE == 0 ? 1.f / 256.f : (MODE == 1 ? 1.f / 128.f : 1.f / 1024.f)) + EPS);
                const float* nb = nbias + (isctx ? 8 : b) * 4096;
#pragma unroll
                for (int bj = 0; bj < 2; ++bj) {
                    const int col = u.pn * 256 + bj * 128 + wc * 32 + 8 * fq;
                    float v[8];
#pragma unroll
                    for (int j = 0; j < 4; ++j) { v[j] = acc[ai][bj][m][0][j] * rs; v[4 + j] = acc[ai][bj][m][1][j] * rs; }
                    if (MODE >= 2) { const f32x4 b0 = *(const f32x4*)(nb + col), b1 = *(const f32x4*)(nb + col + 4);
#pragma unroll
                        for (int j = 0; j < 4; ++j) { v[j] += b0[j]; v[4 + j] += b1[j]; } }
                    if (MODE == 2) { if (!isctx && col < 1280) rope8(v, rope + ((size_t)tok * 32 + ((col & 63) >> 1)) * 2); }
                    if (MODE == 0) { const int c96 = col % 96; if (!isctx && c96 >= 64) rope8(v, rope + ((size_t)tok * 16 + ((c96 - 64) >> 1)) * 2); }
                    bool isv; int kc;
                    if (MODE == 1) { const int within = col & 127; isv = within >= 64; kc = (col >> 7) * 64 + (within & 63); }
                    else { isv = col >= NQ + NK; kc = isv ? col - NQ - NK : col - NQ; }
                    if (MODE != 1 && col < NQ) {
#pragma unroll
                        for (int j = 0; j < 8; ++j) v[j] *= qscale;
                        *(u32x4*)(Q + (size_t)row * LDQ + col) = pack8(v);
                    } else if (MODE != 0 && !isv) {
                        *(u32x4*)(K + kvrow * LDK + kc) = pack8(v);
                    } else if (MODE != 0) {
                        bf16_t* vp = VT + ((size_t)(b * VCOLS + kc)) * KVLEN + vpos;
#pragma unroll
                        for (int j = 0; j < 8; ++j) vp[(size_t)j * KVLEN] = (bf16_t)(cvtpk(v[j], 0.f) & 0xffffu);
                    }
                }
            }
    }
};

struct EpiLat {
    static constexpr bool PERM = true;
    bf16_t* lat; float* ssq_q; float* ssq_kv; bf16_t* KPE; const float* rope; const float* ssqn; const float* nbias;
    __device__ __forceinline__ void operator()(AccRef acc, const pg8::Unit& u, int wr, int wc, int fr_, int fq_) const {
        int lane_e = lane_id(); asm volatile("" : "+v"(lane_e)); const int fr = lane_e & 15, fq = lane_e >> 4; (void)fr_; (void)fq_;
#pragma unroll
        for (int ai = 0; ai < 2; ++ai)
#pragma unroll
            for (int m = 0; m < 4; ++m) {
                const int row = u.pm * 256 + ai * 128 + wr * 64 + m * 16 + fr;
                const bool isctx = row >= ML; const int rc = row - ML;
                const int b = isctx ? (rc >> 8) : (row >> 13);
                const int tok = row & 8191;
                const int kpos = isctx ? (rc & 255) : 256 + tok;
                const size_t kvrow = (size_t)b * KVLEN + kpos;
                const float rs = rsqrtf(ssqn[row] * (1.f / 1024.f) + EPS); const float* nb = nbias + (isctx ? 8 : b) * 4096;
                float ss = 0.f;
#pragma unroll
                for (int bj = 0; bj < 2; ++bj) {
                    const int col = u.pn * 256 + bj * 128 + wc * 32 + 8 * fq;
                    float v[8];
#pragma unroll
                    for (int j = 0; j < 4; ++j) { v[j] = acc[ai][bj][m][0][j] * rs; v[4 + j] = acc[ai][bj][m][1][j] * rs; }
                    { const f32x4 b0 = *(const f32x4*)(nb + col), b1 = *(const f32x4*)(nb + col + 4);
#pragma unroll
                      for (int j = 0; j < 4; ++j) { v[j] += b0[j]; v[4 + j] += b1[j]; } }
                    if (col < 384) {
#pragma unroll
                        for (int j = 0; j < 8; ++j) ss += v[j] * v[j];
                        *(u32x4*)(lat + (size_t)row * 512 + col) = pack8(v);
                    } else if (col < 416) {
                        if (!isctx) rope8(v, rope + ((size_t)tok * 16 + ((col - 384) >> 1)) * 2);
                        *(u32x4*)(KPE + kvrow * 32 + (col - 384)) = pack8(v);
                    }
                }
                ss += shfl_xor_l(ss, 16, lane_e); ss += shfl_xor_l(ss, 32, lane_e);
                if (fq == 0 && (u.pn == 0 || wc < 4)) unsafeAtomicAdd((u.pn == 0 ? ssq_q : ssq_kv) + row, ss);
            }
    }
};

struct EpiResid {
    static constexpr bool PERM = false;
    const float* xin_l; const float* xin_c; float* xout_l; float* xout_c; const float* gate;
    bf16_t* xa; const float* gn; const float* scn; float* ssqn;
    __device__ __forceinline__ void operator()(AccRef acc, const pg8::Unit& u, int wr, int wc, int fr_, int fq_) const {
        int lane_e = lane_id(); asm volatile("" : "+v"(lane_e)); const int fr = lane_e & 15, fq = lane_e >> 4; (void)fr_; (void)fq_;
#pragma unroll
        for (int ai = 0; ai < 2; ++ai)
#pragma unroll
            for (int m = 0; m < 4; ++m) {
                const int row = u.pm * 256 + ai * 128 + wr * 64 + m * 16 + fr;
                const bool isctx = row >= ML;
                const float* xi = isctx ? xin_c + (size_t)(row - ML) * DM : xin_l + (size_t)row * DM;
                float* xo = isctx ? xout_c + (size_t)(row - ML) * DM : xout_l + (size_t)row * DM;
                const int bsel = isctx ? 8 : (row >> 13);
                const float* gp = gate + bsel * 6144;
                float ss = 0.f;
#pragma unroll
                for (int bj = 0; bj < 2; ++bj)
#pragma unroll
                    for (int n = 0; n < 2; ++n) {
                        const int col = u.pn * 256 + bj * 128 + wc * 32 + 16 * n + 4 * fq;
                        const f32x4 x = *(const f32x4*)(xi + col), gv = *(const f32x4*)(gp + col);
                        const f32x4 y = x + gv * acc[ai][bj][m][n];
                        *(f32x4*)(xo + col) = y;
                        if (xa) { const f32x4 g4 = *(const f32x4*)(gn + col), s4 = *(const f32x4*)(scn + bsel * 6144 + col); const f32x4 z = y * g4 * (s4 + 1.f);
                            ss += (y[0] * y[0] + y[1] * y[1]) + (y[2] * y[2] + y[3] * y[3]);
                            u32x2 o; o.x = cvtpk(z[0], z[1]); o.y = cvtpk(z[2], z[3]); *(u32x2*)(xa + (size_t)row * DM + col) = o; }
                    }
                if (xa) { ss += shfl_xor_l(ss, 16, lane_e); ss += shfl_xor_l(ss, 32, lane_e); if (fq == 0) unsafeAtomicAdd(ssqn + row, ss); }
            }
    }
};

struct EpiSqRelu {
    static constexpr bool PERM = true;
    bf16_t* O; int ldc; const float* ssqn; const float* nbias;
    __device__ __forceinline__ void operator()(AccRef acc, const pg8::Unit& u, int wr, int wc, int fr_, int fq_) const {
        int lane_e = lane_id(); asm volatile("" : "+v"(lane_e)); const int fr = lane_e & 15, fq = lane_e >> 4; (void)fr_; (void)fq_;
#pragma unroll
        for (int ai = 0; ai < 2; ++ai)
#pragma unroll
            for (int m = 0; m < 4; ++m) {
                const int row = u.pm * 256 + ai * 128 + wr * 64 + m * 16 + fr;
                const float rs = rsqrtf(ssqn[row] * (1.f / 1024.f) + EPS); const float* nb = nbias + (row >= ML ? 8 : (row >> 13)) * 4096;
#pragma unroll
                for (int bj = 0; bj < 2; ++bj) {
                    const int col = u.pn * 256 + bj * 128 + wc * 32 + 8 * fq;
                    const f32x4 b0 = *(const f32x4*)(nb + col), b1 = *(const f32x4*)(nb + col + 4);
                    float v[8];
#pragma unroll
                    for (int j = 0; j < 4; ++j) { float a = fmaxf(acc[ai][bj][m][0][j] * rs + b0[j], 0.f), c = fmaxf(acc[ai][bj][m][1][j] * rs + b1[j], 0.f); v[j] = a * a; v[4 + j] = c * c; }
                    *(u32x4*)(O + (size_t)row * ldc + col) = pack8(v);
                }
            }
    }
};

constexpr int KP = 208, VP = 144;
constexpr int KT_BYTES = 64 * KP, VT_BYTES = 64 * VP, ABUF = KT_BYTES + VT_BYTES;
constexpr int ATT_BIAS_OFF = 2 * ABUF;
struct AttnP { const bf16_t* Q; const bf16_t* K; const bf16_t* KPE; const bf16_t* VT; bf16_t* O; const float* sink; const float* bias; int nunits; };

__device__ __forceinline__ float rowmax32(const f32x16& a, const f32x16& b) {
    float x = __builtin_fmaxf(__builtin_fmaxf(a[0], a[1]), b[0]), y = __builtin_fmaxf(__builtin_fmaxf(a[2], a[3]), b[1]); x = __builtin_fmaxf(__builtin_fmaxf(x, b[2]), b[3]);
#pragma unroll
    for (int r = 4; r < 16; r += 4) { x = __builtin_fmaxf(__builtin_fmaxf(x, a[r]), a[r + 1]); y = __builtin_fmaxf(__builtin_fmaxf(y, a[r + 2]), a[r + 3]); x = __builtin_fmaxf(__builtin_fmaxf(x, b[r]), b[r + 1]); y = __builtin_fmaxf(__builtin_fmaxf(y, b[r + 2]), b[r + 3]); }
    const float m = __builtin_fmaxf(x, y);
    auto rr = __builtin_amdgcn_permlane32_swap(__float_as_uint(m), __float_as_uint(m), false, false);
    return __builtin_fmaxf(__uint_as_float(rr[0]), __uint_as_float(rr[1]));
}

template <int VAR>
__device__ __forceinline__ void attn_phase(LAS unsigned char* lds, const AttnP P, int vcu, int G, int wave_s) {
    constexpr int ND0 = (VAR == 0) ? 6 : 4;
    constexpr int QPITCH = (VAR == 0) ? 1536 : 1024, QH = (VAR == 0) ? 96 : 64;
    constexpr int KPITCH = (VAR == 1) ? 256 : 1024, VCOLS = (VAR == 1) ? 256 : 1024;
    constexpr bool USE_NEGM = (VAR != 2);
    constexpr float THR = 8.f;
    int tid_l = wave_s * 64 + lane_id(); asm volatile("" : "+v"(tid_l));
    const int tid = tid_l, lane = tid & 63, r32 = lane & 31, hi = lane >> 5;
    const int w = __builtin_amdgcn_readfirstlane(tid >> 6);
    LAS float* bias_lds = (LAS float*)(lds + ATT_BIAS_OFF);
    for (int it = 0;; ++it) {
        int u;
        if (VAR == 0 && G == 256) { u = (it < 16) ? ((it * 8 + (vcu >> 5)) * 32 + (vcu & 31)) : (4096 + (it - 16) * 256 + vcu); }
        else u = it * G + vcu;
        if (u >= P.nunits) break;
        const bool isctx = u >= 4096;
        int b, hq, hk, qrow, nt; int p_a = 0, p_b = 0;
        if (VAR == 0) {
            if (!isctx) { const int bh = u >> 5, qb = u & 31; b = bh >> 4; hq = bh & 15; qrow = b * SEQ + qb * 256 + 32 * w; nt = 132; }
            else { const int cu = u - 4096; b = cu >> 4; hq = cu & 15; qrow = ML + b * 256 + 32 * w; nt = 4; }
            hk = hq;
        } else if (VAR == 1) {
            if (!isctx) { const int blk = u & 63, hp = (u >> 6) & 7; b = u >> 9; hq = 2 * hp + (w >> 2); hk = hp >> 1; qrow = b * SEQ + blk * 128 + 32 * (w & 3);
                          const int jlo = blk == 0 ? 2 : 0, jhi = blk == 63 ? 4 : 6; nt = 4 + jhi - jlo; p_a = blk * 128 - 128 + 64 * jlo; p_b = blk * 128 + 32 * (w & 3); }
            else { const int cu = u - 4096, half = cu & 1, hp = (cu >> 1) & 7; b = cu >> 4; hq = 2 * hp + (w >> 2); hk = hp >> 1; qrow = ML + b * 256 + half * 128 + 32 * (w & 3); nt = 4; }
        } else {
            if (!isctx) { const int rq = u & 31; hq = (u >> 5) & 15; b = u >> 9; const int r0 = 4 * rq; qrow = b * SEQ + (r0 + (w >> 1)) * 64 + 32 * (w & 1);
                          int lo = r0 - 4; lo = lo < 0 ? 0 : (lo > 120 ? 120 : lo); int h2 = r0 - 1; h2 = h2 < 0 ? 0 : (h2 > 120 ? 120 : h2); nt = 4 + (h2 + 8 - lo); p_a = lo; p_b = r0 + (w >> 1); }
            else { const int cu = u - 4096; b = cu >> 4; hq = cu & 15; qrow = ML + b * 256 + 32 * w; nt = 4; }
            hk = hq;
        }
        if (VAR == 2 && !isctx) { if (tid < 465) bias_lds[tid] = P.bias[hq * 465 + tid] * LOG2E; }
        bf16x8 qf[ND0];
        { const bf16_t* qp = P.Q + (size_t)(qrow + r32) * QPITCH + hq * QH + hi * 8;
#pragma unroll
          for (int d0 = 0; d0 < ND0; ++d0) qf[d0] = *(const bf16x8*)(qp + d0 * 16); }
        f32x16 o0 = {}, o1 = {};
        const unsigned koff = (unsigned)(((b * KVLEN + (tid >> 3)) * KPITCH + hk * 64 + (tid & 7) * 8) * 2);
        const unsigned peoff = (unsigned)(((b * KVLEN + (tid >> 2)) * 32 + (tid & 3) * 8) * 2);
        const unsigned voff = (unsigned)(((b * VCOLS + hk * 64 + (tid >> 3)) * KVLEN + (tid & 7) * 8) * 2);
        u32x4 kreg, pereg = {}, vreg;
#define TILE_KPOS(t) (VAR == 0 ? 64 * (((t) + rot >= nt) ? (t) + rot - nt : (t) + rot) : ((t) < 4 ? 64 * (t) : (VAR == 1 ? 256 + p_a + 64 * ((t) - 4) : 256 + 64 * (p_a + (t) - 4))))
#define LOADK(t) do { const int kp_ = TILE_KPOS(t); kreg = *(const u32x4*)((const char*)P.K + (size_t)(koff + (unsigned)(kp_ * KPITCH * 2))); if (VAR == 0 && tid < 256) pereg = *(const u32x4*)((const char*)P.KPE + (size_t)(peoff + (unsigned)(kp_ * 64))); } while (0)
#define LOADV(t) do { const int kp_ = TILE_KPOS(t); vreg = *(const u32x4*)((const char*)P.VT + (size_t)(voff + (unsigned)(kp_ * 2))); } while (0)
#define STOREK(buf) do { LAS unsigned char* kb_ = lds + (buf) * ABUF; *(LAS u32x4*)(kb_ + (tid >> 3) * KP + (tid & 7) * 16) = kreg; \
        if (VAR == 0 && tid < 256) *(LAS u32x4*)(kb_ + (tid >> 2) * KP + 128 + (tid & 3) * 16) = pereg; } while (0)
#define STOREV(buf) do { *(LAS u32x4*)(lds + (buf) * ABUF + KT_BYTES + (tid >> 3) * VP + (tid & 7) * 16) = vreg; } while (0)
#define NEED(t) (((t) < 4) ? true : (VAR == 1 ? ((p_a + 64 * ((t) - 4) + 63 >= p_b - 128) && (p_a + 64 * ((t) - 4) <= p_b + 31 + 128)) : (VAR == 2 ? ((p_a + (t) - 4 >= na_rs) && (p_a + (t) - 4 < na_rs + 8)) : true)))
#define QK_TILE(P0, P1, buf, CINIT) do { const LAS unsigned char* kt_ = lds + (buf) * ABUF; P0 = (CINIT); P1 = (CINIT); \
        _Pragma("unroll") for (int d0 = 0; d0 < ND0; ++d0) { \
            const bf16x8 k0_ = *(const LAS bf16x8*)(kt_ + r32 * KP + d0 * 32 + hi * 16); const bf16x8 k1_ = *(const LAS bf16x8*)(kt_ + (32 + r32) * KP + d0 * 32 + hi * 16); \
            P0 = __builtin_amdgcn_mfma_f32_32x32x16_bf16(k0_, qf[d0], P0, 0, 0, 0); P1 = __builtin_amdgcn_mfma_f32_32x32x16_bf16(k1_, qf[d0], P1, 0, 0, 0); } } while (0)
#define MASK_TILE(P0, P1, t) do { \
        if (VAR == 1 && (t) >= 4) { const int d0_ = p_a + 64 * ((t) - 4) - (p_b + r32) + 4 * hi + 128; \
            _Pragma("unroll") for (int r = 0; r < 16; ++r) { const int dd = d0_ + (r & 3) + 8 * (r >> 2); if ((unsigned)dd > 256u) P0[r] = -1e30f; if ((unsigned)(dd + 32) > 256u) P1[r] = -1e30f; } } \
        if (VAR == 2 && (t) >= 4) { int c = (qrow & 63) + r32; asm volatile("" : "+v"(c)); const int kr = p_a + (t) - 4; int cs = c - 8; cs = cs < 0 ? 0 : (cs > 48 ? 48 : cs); const LAS float* brow = bias_lds + (kr - p_b + 7) * 31; \
            _Pragma("unroll") for (int r = 0; r < 16; ++r) { const int kc = 4 * hi + (r & 3) + 8 * (r >> 2); \
                { int bi = kc - c + 15; bi = bi < 0 ? 0 : (bi > 30 ? 30 : bi); P0[r] = ((unsigned)(kc - cs) < 16u) ? P0[r] + brow[bi] : -1e30f; } \
                { int bi = kc + 32 - c + 15; bi = bi < 0 ? 0 : (bi > 30 ? 30 : bi); P1[r] = ((unsigned)(kc + 32 - cs) < 16u) ? P1[r] + brow[bi] : -1e30f; } } } } while (0)
        const int rot = (VAR == 0 && !isctx) ? ((vcu & 31) * 4 + (vcu >> 5)) % 132 : 0;
        int na_rs = 0; if (VAR == 2) { na_rs = p_b - 4; na_rs = na_rs < 0 ? 0 : (na_rs > 120 ? 120 : na_rs); }
        LOADK(0); LOADV(0); STOREK(0); STOREV(0);
        if (nt > 1) { LOADK(1); STOREK(1); }
        __syncthreads();
        f32x16 pc0, pc1; const f32x16 zero16 = {};
        QK_TILE(pc0, pc1, 0, zero16);
        float mref = rowmax32(pc0, pc1), lrun = 0.f;
        if (VAR == 1) { const float sk = P.sink[hq] * LOG2E; mref = __builtin_fmaxf(mref, sk); lrun = (hi == 0) ? __builtin_amdgcn_exp2f(sk - mref) : 0.f; }
        f32x16 negm = {};
        if (USE_NEGM) {
#pragma unroll
            for (int r = 0; r < 16; ++r) { pc0[r] -= mref; pc1[r] -= mref; negm[r] = -mref; }
        }
        float rmc = 0.f;
        bool need_c = true;
        __syncthreads();
        for (int t = 0; t < nt; ++t) {
            const bool hn = (t + 1 < nt);
            if (hn) { const int t2 = (t + 2 < nt) ? t + 2 : nt - 1; LOADK(t2); LOADV(t + 1); }
            const bool need_n = hn && NEED(t + 1);
            if (need_c && __any(rmc > THR)) {
                const float dl = __builtin_fmaxf(rmc, 0.f), f = __builtin_amdgcn_exp2f(-dl);
                mref += dl; lrun *= f;
#pragma unroll
                for (int r = 0; r < 16; ++r) { if (USE_NEGM) { pc0[r] -= dl; pc1[r] -= dl; negm[r] = -mref; } o0[r] *= f; o1[r] *= f; }
            }
            f32x16 pn0 = {}, pn1 = {};
            float rmn = -1e30f;
            if (VAR != 2 && need_c && need_n) {
                const LAS unsigned char* kt_ = lds + ((t + 1) & 1) * ABUF; const LAS unsigned char* vt_ = lds + (t & 1) * ABUF + KT_BYTES;
                bf16x8 kf[2 * ND0], vf[8]; u32x4 w0, w1, w2, w3; float sacc = 0.f;
#define KRD(d0) do { kf[2 * (d0)] = *(const LAS bf16x8*)(kt_ + r32 * KP + (d0) * 32 + hi * 16); kf[2 * (d0) + 1] = *(const LAS bf16x8*)(kt_ + (32 + r32) * KP + (d0) * 32 + hi * 16); } while (0)
#define VRD(kk) do { vf[2 * (kk)] = *(const LAS bf16x8*)(vt_ + r32 * VP + (kk) * 32 + hi * 16); vf[2 * (kk) + 1] = *(const LAS bf16x8*)(vt_ + (32 + r32) * VP + (kk) * 32 + hi * 16); } while (0)
#define EX4(Pv, a, W, lo) do { if (!USE_NEGM) { Pv[a] -= mref; Pv[a + 1] -= mref; Pv[a + 2] -= mref; Pv[a + 3] -= mref; } Pv[a] = __builtin_amdgcn_exp2f(Pv[a]); Pv[a + 1] = __builtin_amdgcn_exp2f(Pv[a + 1]); Pv[a + 2] = __builtin_amdgcn_exp2f(Pv[a + 2]); Pv[a + 3] = __builtin_amdgcn_exp2f(Pv[a + 3]); \
        sacc += Pv[a]; sacc += Pv[a + 1]; sacc += Pv[a + 2]; sacc += Pv[a + 3]; if (lo) { W.x = cvtpk(Pv[a], Pv[a + 1]); W.y = cvtpk(Pv[a + 2], Pv[a + 3]); } else { W.z = cvtpk(Pv[a], Pv[a + 1]); W.w = cvtpk(Pv[a + 2], Pv[a + 3]); } } while (0)
#define SB() __builtin_amdgcn_sched_barrier(0)
#define QKP(d0, C0, C1) do { pn0 = __builtin_amdgcn_mfma_f32_32x32x16_bf16(kf[2 * (d0)], qf[d0], C0, 0, 0, 0); pn1 = __builtin_amdgcn_mfma_f32_32x32x16_bf16(kf[2 * (d0) + 1], qf[d0], C1, 0, 0, 0); } while (0)
#define PVP(kk, W) do { const bf16x8 pb_ = __builtin_bit_cast(bf16x8, W); o0 = __builtin_amdgcn_mfma_f32_32x32x16_bf16(vf[2 * (kk)], pb_, o0, 0, 0, 0); o1 = __builtin_amdgcn_mfma_f32_32x32x16_bf16(vf[2 * (kk) + 1], pb_, o1, 0, 0, 0); } while (0)
                KRD(0); KRD(1); SB();
                QKP(0, negm, negm); EX4(pc0, 0, w0, true); KRD(2); SB();
                QKP(1, pn0, pn1); EX4(pc0, 4, w0, false); KRD(3); SB();
                if (ND0 > 4) {
                    QKP(2, pn0, pn1); EX4(pc0, 8, w1, true); KRD(4); SB();
                    QKP(3, pn0, pn1); EX4(pc0, 12, w1, false); KRD(5); SB();
                    QKP(4, pn0, pn1); EX4(pc1, 0, w2, true); VRD(0); SB();
                    QKP(5, pn0, pn1); EX4(pc1, 4, w2, false); VRD(1); SB();
                } else {
                    QKP(2, pn0, pn1); EX4(pc0, 8, w1, true); VRD(0); SB();
                    QKP(3, pn0, pn1); EX4(pc0, 12, w1, false); VRD(1); SB();
                    EX4(pc1, 0, w2, true); EX4(pc1, 4, w2, false); SB();
                }
                PVP(0, w0); EX4(pc1, 8, w3, true); VRD(2); SB();
                PVP(1, w1); EX4(pc1, 12, w3, false); VRD(3); SB();
                lrun += sacc;
                PVP(2, w2); MASK_TILE(pn0, pn1, t + 1); SB();
                PVP(3, w3); rmn = rowmax32(pn0, pn1); if (!USE_NEGM) rmn -= mref; SB();
#undef KRD
#undef VRD
#undef EX4
#undef SB
#undef QKP
#undef PVP
            } else {
            if (need_n) QK_TILE(pn0, pn1, (t + 1) & 1, negm);
            if (need_c) {
                float sum = 0.f;
#pragma unroll
                for (int r = 0; r < 16; ++r) { if (!USE_NEGM) { pc0[r] -= mref; pc1[r] -= mref; } pc0[r] = __builtin_amdgcn_exp2f(pc0[r]); pc1[r] = __builtin_amdgcn_exp2f(pc1[r]); sum += pc0[r]; sum += pc1[r]; }
                lrun += sum;
                bf16x8 pk[4];
                { u32x4 a; a.x = cvtpk(pc0[0], pc0[1]); a.y = cvtpk(pc0[2], pc0[3]); a.z = cvtpk(pc0[4], pc0[5]); a.w = cvtpk(pc0[6], pc0[7]); pk[0] = __builtin_bit_cast(bf16x8, a); }
                { u32x4 a; a.x = cvtpk(pc0[8], pc0[9]); a.y = cvtpk(pc0[10], pc0[11]); a.z = cvtpk(pc0[12], pc0[13]); a.w = cvtpk(pc0[14], pc0[15]); pk[1] = __builtin_bit_cast(bf16x8, a); }
                { u32x4 a; a.x = cvtpk(pc1[0], pc1[1]); a.y = cvtpk(pc1[2], pc1[3]); a.z = cvtpk(pc1[4], pc1[5]); a.w = cvtpk(pc1[6], pc1[7]); pk[2] = __builtin_bit_cast(bf16x8, a); }
                { u32x4 a; a.x = cvtpk(pc1[8], pc1[9]); a.y = cvtpk(pc1[10], pc1[11]); a.z = cvtpk(pc1[12], pc1[13]); a.w = cvtpk(pc1[14], pc1[15]); pk[3] = __builtin_bit_cast(bf16x8, a); }
                const LAS unsigned char* vt = lds + (t & 1) * ABUF + KT_BYTES;
#pragma unroll
                for (int kk = 0; kk < 4; ++kk) {
                    const bf16x8 v0 = *(const LAS bf16x8*)(vt + r32 * VP + kk * 32 + hi * 16);
                    const bf16x8 v1 = *(const LAS bf16x8*)(vt + (32 + r32) * VP + kk * 32 + hi * 16);
                    o0 = __builtin_amdgcn_mfma_f32_32x32x16_bf16(v0, pk[kk], o0, 0, 0, 0);
                    o1 = __builtin_amdgcn_mfma_f32_32x32x16_bf16(v1, pk[kk], o1, 0, 0, 0);
                }
            }
            if (need_n) { MASK_TILE(pn0, pn1, t + 1); rmn = rowmax32(pn0, pn1); if (!USE_NEGM) rmn -= mref; }
            }
            if (hn) { STOREK(t & 1); STOREV((t + 1) & 1); }
            __syncthreads();
            pc0 = pn0; pc1 = pn1; rmc = rmn; need_c = need_n;
        }
#undef TILE_KPOS
#undef LOADK
#undef LOADV
#undef STOREK
#undef STOREV
#undef NEED
#undef QK_TILE
#undef MASK_TILE
        const float lt = lrun + shfl_xor_l(lrun, 32, lane), inv = 1.f / lt;
        bf16_t* op = P.O + (size_t)(qrow + r32) * DM + hq * 64 + 4 * hi;
#pragma unroll
        for (int g = 0; g < 4; ++g) {
            u32x2 a; a.x = cvtpk(o0[4 * g] * inv, o0[4 * g + 1] * inv); a.y = cvtpk(o0[4 * g + 2] * inv, o0[4 * g + 3] * inv); *(u32x2*)(op + 8 * g) = a;
            u32x2 c; c.x = cvtpk(o1[4 * g] * inv, o1[4 * g + 1] * inv); c.y = cvtpk(o1[4 * g + 2] * inv, o1[4 * g + 3] * inv); *(u32x2*)(op + 32 + 8 * g) = c;
        }
    }
}

constexpr size_t MiB = 1u << 20;
constexpr size_t WS_BAR = 983040  ;
constexpr size_t WS_MOD = 0, WS_SSQ = 1 * MiB, WS_ROPE16 = 3 * MiB, WS_ROPE32 = 4 * MiB, WS_KPE = 6 * MiB, WS_XC = 12 * MiB;
constexpr size_t WS_W1T = 20 * MiB, WS_W2T = 52 * MiB, WS_MLA = 84 * MiB  , WS_SWA = 94 * MiB  , WS_NA = 99 * MiB  ;
constexpr size_t WS_H = 108 * MiB, WS_Q = 240 * MiB, WS_K = 438 * MiB, WS_VT = 570 * MiB, WS_O = 702 * MiB, WS_LAT = 702 * MiB, WS_HID = 240 * MiB, WS_NBIAS = 834 * MiB  , WS_SSQN = 836 * MiB  , WS_END = 840 * MiB;

#define XB_TMO      128
#define XB_XCNT(j)  (256  + 64 * (j))
#define XB_XSUB(j)  (1280 + 64 * (j))
#define XB_XGEN(j)  (2304 + 64 * (j))
#define XB_TOP      3328
#define XB_TOPGEN   3392
#define XCD_BAR_WORDS 3456
#define XB_SPIN_CAP (1u << 18)
__device__ __forceinline__ unsigned xb_ld(unsigned* p)              { return __hip_atomic_load(p, __ATOMIC_RELAXED, __HIP_MEMORY_SCOPE_AGENT); }
__device__ __forceinline__ unsigned xb_add(unsigned* p, unsigned v) { return __hip_atomic_fetch_add(p, v, __ATOMIC_RELAXED, __HIP_MEMORY_SCOPE_AGENT); }
__device__ __forceinline__ unsigned xb_xcc_id() { return (unsigned)__builtin_amdgcn_s_getreg((3 << 11) | 20) & 0xFu; }
#define XB_SPIN(cond, bar) do { unsigned _sp = 0; while (cond) { __builtin_amdgcn_s_sleep(1); \
    if ((++_sp & 255u) == 0u) { if (xb_ld(&(bar)[XB_TMO])) break; if (_sp > XB_SPIN_CAP) { atomicAdd(&(bar)[XB_TMO], 1u); break; } } } } while (0)
struct XcdBarrier { unsigned* bar; unsigned x; volatile LAS unsigned* st; };
__device__ __forceinline__ XcdBarrier xcd_barrier_post(unsigned* bar, volatile LAS unsigned* st, bool t0) {
    XcdBarrier b; b.bar = bar; b.x = xb_xcc_id(); b.st = st;
    if (t0) (void)xb_add(&bar[XB_XCNT(b.x)], 1u);
    return b;
}
__device__ __forceinline__ void xcd_barrier_complete(unsigned* bar, unsigned x, unsigned& nloc, unsigned& nx) {
    const unsigned G = gridDim.x * gridDim.y * gridDim.z;
    unsigned sum, cnt, mine, sp = 0u;
    for (;;) {
        sum = 0u; cnt = 0u; mine = 0u;
#pragma unroll
        for (unsigned j = 0; j < 16; ++j) { const unsigned c = xb_ld(&bar[XB_XCNT(j)]); sum += c; cnt += (c > 0u) ? 1u : 0u; mine = (j == x) ? c : mine; }
        if (sum == G) break;
        __builtin_amdgcn_s_sleep(1);
        if ((++sp & 255u) == 0u) { if (xb_ld(&bar[XB_TMO])) break; if (sp > XB_SPIN_CAP) { atomicAdd(&bar[XB_TMO], 1u); break; } }
    }
    nloc = mine > 0u ? mine : 1u; nx = cnt > 0u ? cnt : 1u;
}
__device__ __forceinline__ void xcd_barrier(const XcdBarrier& b, bool t0) {
    asm volatile("s_waitcnt vmcnt(0)" ::: "memory");
    __syncthreads();
    if (t0) {
        unsigned* bar = b.bar; unsigned bx = b.x; asm volatile("" : "+s"(bar), "+s"(bx));
        __builtin_amdgcn_s_waitcnt(0);
        unsigned nloc = b.st[0], nx = b.st[1];
        if (nloc == 0u) { xcd_barrier_complete(bar, bx, nloc, nx); b.st[0] = nloc; b.st[1] = nx; }
        const unsigned old = xb_add(&bar[XB_XSUB(bx)], 1u);
        const unsigned gen = old / nloc;
        if (old + 1u == (gen + 1u) * nloc) {
            __builtin_amdgcn_fence(__ATOMIC_RELEASE, "agent");
            asm volatile("s_waitcnt vmcnt(0)" ::: "memory");
            const unsigned og = xb_add(&bar[XB_TOP], 1u);
            const unsigned tg = og / nx;
            if (og + 1u == (tg + 1u) * nx) xb_add(&bar[XB_TOPGEN], 1u);
            else XB_SPIN(xb_ld(&bar[XB_TOPGEN]) == tg, bar);
            __builtin_amdgcn_fence(__ATOMIC_ACQUIRE, "agent");
            xb_add(&bar[XB_XGEN(bx)], 1u);
            asm volatile("s_waitcnt vmcnt(0)" ::: "memory");
        } else {
            XB_SPIN(xb_ld(&bar[XB_XGEN(bx)]) == gen, bar);
            __builtin_amdgcn_fence(__ATOMIC_ACQUIRE, "agent");
            asm volatile("s_waitcnt vmcnt(0)" ::: "memory");
        }
    }
    __syncthreads();
}

__device__ __forceinline__ float wave_sum(float v, int lane) {
#pragma unroll
    for (int o = 1; o < 64; o <<= 1) v += shfl_xor_l(v, o, lane);
    return v;
}
__device__ __forceinline__ void sincos_red(float x, float& sn, float& cs) {
    const float n = rintf(x * 0.15915494309189535f);
    float r = fmaf(-n, 6.2831854820251465f, x); r = fmaf(-n, -1.7484555e-7f, r);
    const float rev = r * 0.15915494309189535f;
    sn = __builtin_amdgcn_sinf(rev); cs = __builtin_amdgcn_cosf(rev);
}
__device__ __forceinline__ void transpose_item(const float* W, int K, int N, bf16_t* WT, const float* g, LAS float* scr, int item, int lane) {
    const int nblk = N / 32, kb = item / nblk, nb = item % nblk, k0 = 64 * kb, n0 = 32 * nb;
#pragma unroll 8
    for (int i = 0; i < 32; ++i) { const int kk = 2 * i + (lane >> 5); float v = W[(size_t)(k0 + kk) * N + n0 + (lane & 31)]; if (g) v *= g[k0 + kk]; scr[kk * 33 + (lane & 31)] = v; }
    asm volatile("s_waitcnt lgkmcnt(0)" ::: "memory");
    const int c = lane & 7;
#pragma unroll
    for (int j = 0; j < 4; ++j) { const int n = (lane >> 3) + 8 * j; const LAS float* s = scr + (8 * c) * 33 + n;
        u32x4 o; o.x = cvtpk(s[0 * 33], s[1 * 33]); o.y = cvtpk(s[2 * 33], s[3 * 33]); o.z = cvtpk(s[4 * 33], s[5 * 33]); o.w = cvtpk(s[6 * 33], s[7 * 33]);
        *(u32x4*)(WT + (size_t)(n0 + n) * K + k0 + 8 * c) = o; }
    asm volatile("s_waitcnt lgkmcnt(0)" ::: "memory");
}

struct Args { const float* in[23]; float* out; unsigned char* ws; };

__device__ __forceinline__ void norm_pass0(const float* xl, const float* xc, const float* g, const float* mod, int sc_off, bf16_t* H, float* ssq, int gw, int NGW) {
    int lane = lane_id(); asm volatile("" : "+v"(lane));
    for (int row = gw; row < MT; row += NGW) {
        const bool isctx = row >= ML;
        const float* xr = isctx ? xc + (size_t)(row - ML) * DM : xl + (size_t)row * DM;
        const float* mp = mod + (isctx ? 8 : (row >> 13)) * 6144;
        f32x4 v[4]; float ss = 0.f;
#pragma unroll
        for (int j = 0; j < 4; ++j) { v[j] = *(const f32x4*)(xr + 4 * lane + 256 * j); ss += (v[j][0] * v[j][0] + v[j][1] * v[j][1]) + (v[j][2] * v[j][2] + v[j][3] * v[j][3]); }
        ss = wave_sum(ss, lane);
        if (lane == 0) ssq[row] = ss;
#pragma unroll
        for (int j = 0; j < 4; ++j) { const int col = 4 * lane + 256 * j;
            const f32x4 gg = *(const f32x4*)(g + col), sc = *(const f32x4*)(mp + sc_off + col);
            const f32x4 y = v[j] * gg * (sc + 1.f);
            u32x2 o; o.x = cvtpk(y[0], y[1]); o.y = cvtpk(y[2], y[3]); *(u32x2*)(H + (size_t)row * DM + col) = o; }
    }
}
__device__ __forceinline__ void nbias_item(LAS unsigned char* lds, const float* W, int N, int n0, const float* mod, int sh_off, float* out, int wave, int lane) {
    LAS float* shl = (LAS float*)(lds + 65536); LAS float* red = (LAS float*)(lds + 102400);
    const int tid = wave * 64 + lane;
    for (int i = tid; i < 9 * 1024; i += 512) shl[i] = mod[(i >> 10) * 6144 + sh_off + (i & 1023)];
    __syncthreads();
    const int n = n0 + lane; const bool ok = n < N;
    const float* Wp = W + (ok ? n : 0);
    float s0 = 0, s1 = 0, s2 = 0, s3 = 0, s4 = 0, s5 = 0, s6 = 0, s7 = 0, s8 = 0;
#pragma unroll 8
    for (int k = wave * 128; k < wave * 128 + 128; ++k) { const float wv = Wp[(size_t)k * N];
        s0 += shl[k] * wv; s1 += shl[1024 + k] * wv; s2 += shl[2048 + k] * wv; s3 += shl[3072 + k] * wv; s4 += shl[4096 + k] * wv;
        s5 += shl[5120 + k] * wv; s6 += shl[6144 + k] * wv; s7 += shl[7168 + k] * wv; s8 += shl[8192 + k] * wv; }
    LAS float* rp = red + wave * 576 + lane;
    rp[0] = s0; rp[64] = s1; rp[128] = s2; rp[192] = s3; rp[256] = s4; rp[320] = s5; rp[384] = s6; rp[448] = s7; rp[512] = s8;
    __syncthreads();
    for (int i = tid; i < 576; i += 512) { float sum = 0.f;
#pragma unroll
        for (int ww = 0; ww < 8; ++ww) sum += red[ww * 576 + i];
        const int b = i >> 6, l = i & 63; if (n0 + l < N) out[b * 4096 + n0 + l] = sum; else if (n0 + l < 4096) out[b * 4096 + n0 + l] = 0.f; }
    __syncthreads();
}

__global__ void __launch_bounds__(512, 2) fwd_megakernel(Args a) {
    extern __shared__ __attribute__((aligned(16))) unsigned char lds_raw[];
    LAS unsigned char* lds = (LAS unsigned char*)lds_raw;
    cg::grid_group grid = cg::this_grid();
    const int wave = __builtin_amdgcn_readfirstlane((int)threadIdx.x >> 6);
    const int G = gridDim.x, bid = blockIdx.x;
    const int vcu = (G % 8 == 0) ? (bid % 8) * (G / 8) + bid / 8 : bid;
    const int gw = vcu * 8 + wave, NGW = G * 8;
    unsigned char* ws = a.ws;
    volatile LAS unsigned* bar_st = (volatile LAS unsigned*)(lds + 131072 + 64);
    if (wave == 0 && lane_id() < 2) bar_st[lane_id()] = 0u;
    __syncthreads();
    XcdBarrier xbar = xcd_barrier_post((unsigned*)(ws + WS_BAR), bar_st, wave == 0 && lane_id() == 0);
#define GRID_BAR() xcd_barrier(xbar, wave == 0 && lane_id() == 0)
    const float* x_in = a.in[0]; const float* c_in = a.in[1]; const float* ctx_in = a.in[2]; const float* cctx_in = a.in[3];
    const float* ada_w = a.in[4]; const float* ada_b = a.in[5]; const float* norm_mix_g = a.in[6]; const float* norm_mlp_g = a.in[7]; const float* norm_out_g = a.in[8];
    float* MOD = (float*)(ws + WS_MOD); float* SSQ = (float*)(ws + WS_SSQ);
    float* ROPE16 = (float*)(ws + WS_ROPE16); float* ROPE32 = (float*)(ws + WS_ROPE32);
    bf16_t* KPE = (bf16_t*)(ws + WS_KPE); float* XC = (float*)(ws + WS_XC);
    bf16_t* H = (bf16_t*)(ws + WS_H); bf16_t* Qb = (bf16_t*)(ws + WS_Q); bf16_t* Kb = (bf16_t*)(ws + WS_K); bf16_t* VTb = (bf16_t*)(ws + WS_VT);
    bf16_t* Ob = (bf16_t*)(ws + WS_O); bf16_t* LAT = (bf16_t*)(ws + WS_LAT); bf16_t* HID = (bf16_t*)(ws + WS_HID);
    float* X = a.out;
    float* NBIAS = (float*)(ws + WS_NBIAS); float* SSQN = (float*)(ws + WS_SSQN);

    {
        const int lane = lane_id(), tid = wave * 64 + lane;
        LAS float* act = (LAS float*)(lds + 65536); LAS float* red = (LAS float*)(lds + 102400);
        for (int i = tid; i < 9 * 1024; i += 512) { const int b = i >> 10, k = i & 1023; const float v = b < 8 ? c_in[b * 1024 + k] : cctx_in[k]; act[i] = v / (1.f + __builtin_amdgcn_exp2f(-v * LOG2E)); }
        __syncthreads();
        for (int it = bid; it < 384; it += G) {
            const int layer = it / 96, n0 = (it % 96) * 64;
            const float* W = ada_w + (size_t)layer * 1024 * 6144 + n0 + lane;
            float s0 = 0, s1 = 0, s2 = 0, s3 = 0, s4 = 0, s5 = 0, s6 = 0, s7 = 0, s8 = 0;
#pragma unroll 8
            for (int k = wave * 128; k < wave * 128 + 128; ++k) { const float wv = W[(size_t)k * 6144];
                s0 += act[k] * wv; s1 += act[1024 + k] * wv; s2 += act[2048 + k] * wv; s3 += act[3072 + k] * wv; s4 += act[4096 + k] * wv;
                s5 += act[5120 + k] * wv; s6 += act[6144 + k] * wv; s7 += act[7168 + k] * wv; s8 += act[8192 + k] * wv; }
            LAS float* rp = red + wave * 576 + lane;
            rp[0] = s0; rp[64] = s1; rp[128] = s2; rp[192] = s3; rp[256] = s4; rp[320] = s5; rp[384] = s6; rp[448] = s7; rp[512] = s8;
            __syncthreads();
            for (int i = tid; i < 576; i += 512) { float s = 0.f;
#pragma unroll
                for (int ww = 0; ww < 8; ++ww) s += red[ww * 576 + i];
                const int b = i >> 6, l = i & 63; MOD[((size_t)layer * 9 + b) * 6144 + n0 + l] = s + ada_b[layer * 6144 + n0 + l]; }
            __syncthreads();
        }
        __syncthreads();
        LAS float* scr = (LAS float*)(lds + wave * 16384);
        int base = 0;
#define TR(Wsrc, K_, N_, dst, gsc) do { const int n_ = ((K_) / 64) * ((N_) / 32); \
            for (int it_ = (gw + NGW - (base % NGW)) % NGW; it_ < n_; it_ += NGW) transpose_item((Wsrc), (K_), (N_), (dst), (gsc), scr, it_, lane); base += n_; } while (0)
        for (int L = 0; L < 4; ++L) {
            TR(a.in[9] + (size_t)L * DM * FF, DM, FF, (bf16_t*)(ws + WS_W1T + (size_t)L * 8 * MiB), (const float*)nullptr);
            TR(a.in[10] + (size_t)L * FF * DM, FF, DM, (bf16_t*)(ws + WS_W2T + (size_t)L * 8 * MiB), (const float*)nullptr);
        }
        for (int j = 0; j < 2; ++j) {
            unsigned char* mb = ws + WS_MLA + (size_t)j * 5 * MiB;
            TR(a.in[11] + (size_t)j * DM * 416, DM, 416, (bf16_t*)mb, (const float*)nullptr);
            TR(a.in[13] + (size_t)j * 256 * 1536, 256, 1536, (bf16_t*)(mb + 1 * MiB), a.in[12] + j * 256);
            TR(a.in[15] + (size_t)j * 128 * 2048, 128, 2048, (bf16_t*)(mb + 1 * MiB + 768 * 1024), a.in[14] + j * 128);
            TR(a.in[16] + (size_t)j * DM * DM, DM, DM, (bf16_t*)(mb + 3 * MiB), (const float*)nullptr);
            u32x4* z = (u32x4*)(mb + (size_t)416 * 1024 * 2);
            for (int i = gw * 64 + lane; i < 96 * 1024 * 2 / 16; i += NGW * 64) z[i] = (u32x4){0u, 0u, 0u, 0u};
        }
        TR(a.in[17], DM, 1536, (bf16_t*)(ws + WS_SWA), (const float*)nullptr);
        TR(a.in[19], DM, DM, (bf16_t*)(ws + WS_SWA + 3 * MiB), (const float*)nullptr);
        TR(a.in[20], DM, 3072, (bf16_t*)(ws + WS_NA), (const float*)nullptr);
        TR(a.in[22], DM, DM, (bf16_t*)(ws + WS_NA + 6 * MiB), (const float*)nullptr);
#undef TR
        for (int i = gw * 64 + lane; i < 8192 * 16; i += NGW * 64) { const int t = i >> 4, p = i & 15; const int f = p & 7; const float pos = (float)(p < 8 ? (t >> 6) : (t & 63));
            const float ang = pos * __builtin_amdgcn_exp2f(-(float)f * (13.287712379549449f / 8.f)); float sn, cs; sincos_red(ang, sn, cs); ROPE16[2 * i] = cs; ROPE16[2 * i + 1] = sn; }
        for (int i = gw * 64 + lane; i < 8192 * 32; i += NGW * 64) { const int t = i >> 5, p = i & 31; const int f = p & 15; const float pos = (float)(p < 16 ? (t >> 6) : (t & 63));
            const float ang = pos * __builtin_amdgcn_exp2f(-(float)f * (13.287712379549449f / 16.f)); float sn, cs; sincos_red(ang, sn, cs); ROPE32[2 * i] = cs; ROPE32[2 * i + 1] = sn; }
        for (int i = gw * 64 + lane; i < 4 * MT; i += NGW * 64) SSQ[i] = 0.f;
        for (int i = gw * 64 + lane; i < 8 * MT; i += NGW * 64) SSQN[i] = 0.f;
    }
    grid.sync();
    {
        const int lane = lane_id();
        for (int it = bid; it < 8 + 24 + 48 + 8 + 256; it += G) {
            int r = it; const float* W; int N, L, which, blk;
            if (r < 8) { W = a.in[11]; N = 416; L = 0; which = 0; blk = r; }
            else if ((r -= 8) < 24) { W = a.in[17]; N = 1536; L = 1; which = 0; blk = r; }
            else if ((r -= 24) < 48) { W = a.in[20]; N = 3072; L = 2; which = 0; blk = r; }
            else if ((r -= 48) < 8) { W = a.in[11] + (size_t)DM * 416; N = 416; L = 3; which = 0; blk = r; }
            else { r -= 8; L = r >> 6; blk = r & 63; W = a.in[9] + (size_t)L * DM * FF; N = FF; which = 1; }
            nbias_item(lds, W, N, blk * 64, MOD + (size_t)L * 9 * 6144, which ? 3072 : 0, NBIAS + (size_t)(L * 2 + which) * 9 * 4096, wave, lane);
        }
        norm_pass0(x_in, ctx_in, norm_mix_g, MOD, 1024, H, SSQN, gw, NGW);
    }
    GRID_BAR();

    for (int L = 0; L < 4; ++L) {
        const int kind = L % 3, jl = L / 3; const bool last = (L == 3);
        const float* modL = MOD + (size_t)L * 9 * 6144;
        const float* xl = (L == 0) ? x_in : X; const float* xc = (L == 0) ? ctx_in : XC;
        const float* ssqn1 = SSQN + (size_t)(2 * L) * MT; const float* nbias1 = NBIAS + (size_t)(L * 2) * 9 * 4096;
        if (kind == 0) {
            unsigned char* mb = ws + WS_MLA + (size_t)jl * 5 * MiB;
            float* ssq_q = SSQ + (size_t)jl * 2 * MT; float* ssq_kv = ssq_q + MT;
            {
                pg8::Gemm g{H, (const bf16_t*)mb, MT, 512, DM, DM, DM}; pg8::StaticOrder S; S.init(MT, 512, G, bid);
                EpiLat E{LAT, ssq_q, ssq_kv, KPE, ROPE16, ssqn1, nbias1};
                pg8::gemm_phase<EpiLat, pg8::StaticOrder, true>(lds, g, S, E, wave);
            }
            GRID_BAR();
            {
                pg8::Gemm g{LAT, (const bf16_t*)(mb + 1 * MiB), MT, 1536, 256, 512, 256}; pg8::StaticOrder S; S.init(MT, 1536, G, bid);
                EpiProj<0> E{Qb, nullptr, nullptr, ROPE16, ssq_q, 0.10206207261596577f * LOG2E, nullptr};
                pg8::gemm_phase<EpiProj<0>, pg8::StaticOrder, true>(lds, g, S, E, wave);
            }
            {
                pg8::Gemm g{LAT + 256, (const bf16_t*)(mb + 1 * MiB + 768 * 1024), MT, 2048, 128, 512, 128}; pg8::StaticOrder S; S.init(MT, 2048, G, bid);
                EpiProj<1> E{nullptr, Kb, VTb, nullptr, ssq_kv, 1.f, nullptr};
                pg8::gemm_phase<EpiProj<1>, pg8::StaticOrder, true>(lds, g, S, E, wave);
            }
        } else if (kind == 1) {
            pg8::Gemm g{H, (const bf16_t*)(ws + WS_SWA), MT, 1536, DM, DM, DM}; pg8::StaticOrder S; S.init(MT, 1536, G, bid);
            EpiProj<2> E{Qb, Kb, VTb, ROPE32, ssqn1, 0.125f * LOG2E, nbias1};
            pg8::gemm_phase<EpiProj<2>, pg8::StaticOrder, true>(lds, g, S, E, wave);
        } else {
            pg8::Gemm g{H, (const bf16_t*)(ws + WS_NA), MT, 3072, DM, DM, DM}; pg8::StaticOrder S; S.init(MT, 3072, G, bid);
            EpiProj<3> E{Qb, Kb, VTb, nullptr, ssqn1, 0.125f * LOG2E, nbias1};
            pg8::gemm_phase<EpiProj<3>, pg8::StaticOrder, true>(lds, g, S, E, wave);
        }
        GRID_BAR();
        {
            AttnP P{Qb, Kb, KPE, VTb, Ob, a.in[18], a.in[21], last ? 4096 : 4096 + 128};
            if (kind == 0) attn_phase<0>(lds, P, vcu, G, wave);
            else if (kind == 1) attn_phase<1>(lds, P, vcu, G, wave);
            else attn_phase<2>(lds, P, vcu, G, wave);
        }
        GRID_BAR();
        const int Mres = last ? ML : MT;
        {
            const bf16_t* wo = (const bf16_t*)(kind == 0 ? ws + WS_MLA + (size_t)jl * 5 * MiB + 3 * MiB : (kind == 1 ? ws + WS_SWA + 3 * MiB : ws + WS_NA + 6 * MiB));
            pg8::Gemm g{Ob, wo, Mres, DM, DM, DM, DM}; pg8::StaticOrder S; S.init(Mres, DM, G, bid);
            EpiResid E{xl, xc, X, XC, modL + 2048, H, norm_mlp_g + L * DM, modL + 4096, SSQN + (size_t)(2 * L + 1) * MT};
            pg8::gemm_phase<EpiResid, pg8::StaticOrder, true>(lds, g, S, E, wave);
        }
        GRID_BAR();
        {
            pg8::Gemm g{H, (const bf16_t*)(ws + WS_W1T + (size_t)L * 8 * MiB), Mres, FF, DM, DM, DM}; pg8::StaticOrder S; S.init(Mres, FF, G, bid);
            EpiSqRelu E{HID, FF, SSQN + (size_t)(2 * L + 1) * MT, NBIAS + (size_t)(L * 2 + 1) * 9 * 4096};
            pg8::gemm_phase<EpiSqRelu, pg8::StaticOrder, true>(lds, g, S, E, wave);
        }
        GRID_BAR();
        {
            pg8::Gemm g{HID, (const bf16_t*)(ws + WS_W2T + (size_t)L * 8 * MiB), Mres, DM, FF, FF, FF}; pg8::StaticOrder S; S.init(Mres, DM, G, bid);
            EpiResid E{X, XC, X, XC, modL + 5120, last ? nullptr : H, norm_mix_g + (L + 1) * DM, MOD + (size_t)(L + 1) * 9 * 6144 + 1024, SSQN + (size_t)(2 * L + 2) * MT};
            pg8::gemm_phase<EpiResid, pg8::StaticOrder, true>(lds, g, S, E, wave);
        }
        GRID_BAR();
    }
    int lane = lane_id(); asm volatile("" : "+v"(lane));
    for (int row = gw; row < ML; row += NGW) {
        float* xr = X + (size_t)row * DM;
        f32x4 v[4]; float ss = 0.f;
#pragma unroll
        for (int j = 0; j < 4; ++j) { v[j] = *(const f32x4*)(xr + 4 * lane + 256 * j); ss += (v[j][0] * v[j][0] + v[j][1] * v[j][1]) + (v[j][2] * v[j][2] + v[j][3] * v[j][3]); }
        const float rstd = rsqrtf(wave_sum(ss, lane) * (1.f / DM) + EPS);
#pragma unroll
        for (int j = 0; j < 4; ++j) { const int col = 4 * lane + 256 * j; const f32x4 gg = *(const f32x4*)(norm_out_g + col); *(f32x4*)(xr + col) = v[j] * rstd * gg; }
    }
}

constexpr int LDS_BYTES = 147456;
extern "C" void kernel_launch(void* const* d_in, const int* in_sizes, int n_in, void* d_out, int out_size, void* d_ws, size_t ws_size, hipStream_t stream) {
    static int grid = 0;
    if (grid == 0) {
        if (n_in != 23 || out_size != ML * DM || ws_size < WS_END) { fprintf(stderr, "kernel_launch: unexpected shapes (n_in %d out %d ws %zu)\n", n_in, out_size, ws_size); grid = -1; return; }
        int dev = 0, cus = 0, per_cu = 0;
        hipGetDevice(&dev); hipDeviceGetAttribute(&cus, hipDeviceAttributeMultiprocessorCount, dev);
        if (hipFuncSetAttribute((const void*)fwd_megakernel, hipFuncAttributeMaxDynamicSharedMemorySize, LDS_BYTES) != hipSuccess) { fprintf(stderr, "kernel_launch: hipFuncSetAttribute failed\n"); grid = -1; return; }
        if (hipOccupancyMaxActiveBlocksPerMultiprocessor(&per_cu, (const void*)fwd_megakernel, 512, LDS_BYTES) != hipSuccess || per_cu < 1) { fprintf(stderr, "kernel_launch: occupancy query gave %d\n", per_cu); per_cu = 1; }
        (void)hipGetLastError();
        grid = cus * per_cu;
    }
    if (grid < 0) return;
    if (hipMemsetAsync((char*)d_ws + WS_BAR, 0, XCD_BAR_WORDS * 4, stream) != hipSuccess) { fprintf(stderr, "kernel_launch: memset of the barrier words failed\n"); return; }
    Args a{};
    for (int i = 0; i < 23; ++i) a.in[i] = (const float*)d_in[i];
    a.out = (float*)d_out; a.ws = (unsigned char*)d_ws;
    void* args[] = {&a};
    hipError_t e = hipLaunchCooperativeKernel((const void*)fwd_megakernel, dim3(grid), dim3(512), args, LDS_BYTES, stream);
    if (e != hipSuccess) fprintf(stderr, "cooperative launch failed: %s (grid %d)\n", hipGetErrorString(e), grid);
}
```

```cpp
#include <hip/hip_runtime.h>
#include <hip/hip_cooperative_groups.h>
#include <cstdio>
#include <cstdint>
namespace cg = cooperative_groups;

#define LAS __attribute__((address_space(3)))
typedef unsigned short bf16_t;
typedef short bf16x8 __attribute__((ext_vector_type(8)));
typedef float f32x4 __attribute__((ext_vector_type(4)));
typedef float f32x16 __attribute__((ext_vector_type(16)));
typedef unsigned u32x4 __attribute__((ext_vector_type(4)));
typedef unsigned u32x2 __attribute__((ext_vector_type(2)));

constexpr int NB = 8, SEQ = 8192, DM = 1024, CTX = 256, FF = 4096;
constexpr int ML = NB * SEQ;
constexpr int MC = NB * CTX;
constexpr int MT = ML + MC;
constexpr int KVLEN = CTX + SEQ;
constexpr float EPS = 1e-6f;
constexpr float LOG2E = 1.4426950408889634f;

__device__ __forceinline__ unsigned cvtpk(float lo, float hi) {
    typedef float f2 __attribute__((ext_vector_type(2))); typedef __bf16 b2 __attribute__((ext_vector_type(2)));
    f2 v = {lo, hi}; b2 b = __builtin_convertvector(v, b2); return __builtin_bit_cast(unsigned, b);
}
__device__ __forceinline__ int lane_id() { int l; asm volatile("v_mbcnt_lo_u32_b32 %0, -1, 0\n\tv_mbcnt_hi_u32_b32 %0, -1, %0" : "=v"(l)); return l; }
__device__ __forceinline__ float shfl_xor_l(float v, int mask, int lane) { return __int_as_float(__builtin_amdgcn_ds_bpermute((lane ^ mask) << 2, __float_as_int(v))); }
__device__ __forceinline__ int perm16(int x) { return 8 * ((x >> 2) & 1) + (x & 3) + 4 * (x >> 3); }

namespace pg8 {
constexpr int BM = 256, BK = 64, HALF = 128, HTB = HALF * BK * 2, STAGE_BYTES = 8 * HTB, NXCD = 8, WGM = 8;
__host__ __device__ __forceinline__ int lds_byte(int r, int c) { const int st = (r >> 4) * 2 + (c >> 5), rr = r & 15, cc = c & 31, ob = rr * 64 + cc * 2; return st * 1024 + (ob ^ (((ob >> 9) & 1) << 5)); }
__host__ __device__ __forceinline__ void stage_rc(int b, int& R, int& C) { const int st = b / 1024, sb = b % 1024, swz = sb ^ (((sb >> 9) & 1) << 5); R = (st >> 1) * 16 + swz / 64; C = (st & 1) * 32 + (swz % 64) / 2; }
__host__ __device__ __forceinline__ int perm32(int rho) { const int n = rho >> 4, i = rho & 15; return 8 * (i >> 2) + 4 * n + (i & 3); }

struct Unit { int pm, pn; };
struct Gemm { const bf16_t* A; const bf16_t* Bt; int M, N, K, lda, ldb; };

struct StaticOrder {
    int nM, nN, nwg, G, c;
    __device__ void init(int M, int N, int G_, int c_) { nM = M / BM; nN = N / BM; nwg = nM * nN; G = G_; c = c_; }
    __device__ bool next(int i, Unit& u) const {
        const long L = (long)i * G + c; if (L >= nwg) return false;
        int wgid = (int)L; { const int q = nwg / NXCD, r = nwg % NXCD, xcd = wgid % NXCD, off = wgid / NXCD; wgid = (xcd < r ? xcd * (q + 1) : r * (q + 1) + (xcd - r) * q) + off; }
        const int nig = WGM * nN, gid = wgid / nig, fm = gid * WGM, gsz = (nM - fm) < WGM ? (nM - fm) : WGM;
        u.pm = fm + ((wgid % nig) % gsz); u.pn = (wgid % nig) / gsz; return true;
    }
};

template <class Epi, class Sched, bool ALIGN_EPI>
__device__ __forceinline__ void gemm_phase(LAS unsigned char* lds, const Gemm g, const Sched& S, const Epi& E, int wave_s) {
    int tid_l = wave_s * 64 + lane_id(); asm volatile("" : "+v"(tid_l));
    const int tid = tid_l, wid = __builtin_amdgcn_readfirstlane(tid >> 6), lane = tid & 63, wr = wid >> 2, wc = wid & 3, fr = lane & 15, fq = lane >> 4;
    const int K = g.K, nt = K / BK;
    unsigned voffA[2], voffB[2];
#pragma unroll
    for (int i = 0; i < 2; ++i) { int R, C; stage_rc(tid * 16 + i * 8192, R, C); const int Rb = Epi::PERM ? ((R & ~31) + perm32(R & 31)) : R;
        voffA[i] = (unsigned)(R * g.lda + C) * 2u; voffB[i] = (unsigned)(Rb * g.ldb + C) * 2u; }
    const size_t kstep = (size_t)(BK * 2);
    const size_t hstepA = (size_t)HALF * g.lda * 2, hstepB = (size_t)HALF * g.ldb * 2;
    const size_t tstepA = 2 * hstepA, tstepB = 2 * hstepB;
    const unsigned ldsw = (unsigned)wid * 1024u;
    const int aoff = lds_byte(wr * 64 + fr, fq * 8), boff = lds_byte(wc * 32 + fr, fq * 8);
#define PG8_SA(b, h) (((b) * 2 + (h)) * HTB)
#define PG8_SB(b, h) ((4 + (b) * 2 + (h)) * HTB)
#define PG8_STAGE(bufoff, gbase, voff) do { _Pragma("unroll") for (int _i = 0; _i < 2; ++_i) \
        __builtin_amdgcn_global_load_lds((const unsigned*)((const char*)(gbase) + (voff)[_i]), (LAS unsigned*)(lds + (bufoff) + ldsw + _i * 8192), 16, 0, 0); } while (0)
#define PG8_LDA(dst, b, h) do { _Pragma("unroll") for (int m = 0; m < 4; ++m) _Pragma("unroll") for (int k = 0; k < 2; ++k) dst[m][k] = *(const LAS bf16x8*)(lds + PG8_SA(b, h) + aoff + m * 2048 + k * 1024); } while (0)
#define PG8_LDB(dst, b, h) do { _Pragma("unroll") for (int n = 0; n < 2; ++n) _Pragma("unroll") for (int k = 0; k < 2; ++k) dst[n][k] = *(const LAS bf16x8*)(lds + PG8_SB(b, h) + boff + n * 2048 + k * 1024); } while (0)
#define PG8_MMA(ai, bj, At, Bt) do { __builtin_amdgcn_s_setprio(1); _Pragma("unroll") for (int m = 0; m < 4; ++m) _Pragma("unroll") for (int n = 0; n < 2; ++n) _Pragma("unroll") for (int k = 0; k < 2; ++k) \
        acc[ai][bj][m][n] = __builtin_amdgcn_mfma_f32_16x16x32_bf16(Bt[n][k], At[m][k], acc[ai][bj][m][n], 0, 0, 0); __builtin_amdgcn_s_setprio(0); } while (0)
#define PG8_WAIT_V(n) asm volatile("s_waitcnt vmcnt(" #n ")" ::: "memory")
#define PG8_WAIT_L(n) asm volatile("s_waitcnt lgkmcnt(" #n ")" ::: "memory")
#define PG8_BAR __builtin_amdgcn_s_barrier()
#define PG8_SCHED __builtin_amdgcn_sched_barrier(0)
    Unit cur, nxt; int ui = 0;
    if (!S.next(0, cur)) return;
    f32x4 acc[2][2][4][2];
#pragma unroll
    for (int a = 0; a < 2; ++a)
#pragma unroll
        for (int b = 0; b < 2; ++b)
#pragma unroll
            for (int m = 0; m < 4; ++m)
#pragma unroll
                for (int n = 0; n < 2; ++n) acc[a][b][m][n] = (f32x4){0.f, 0.f, 0.f, 0.f};
    bf16x8 At[4][2], B0[2][2], B1[2][2];
    const char* cA = (const char*)g.A + (size_t)cur.pm * tstepA; const char* cB = (const char*)g.Bt + (size_t)cur.pn * tstepB;
    PG8_STAGE(PG8_SB(0, 0), cB, voffB); PG8_STAGE(PG8_SB(0, 1), cB + hstepB, voffB); PG8_STAGE(PG8_SA(0, 0), cA, voffA); PG8_STAGE(PG8_SA(0, 1), cA + hstepA, voffA);
    if (wr == 1) PG8_BAR;
    PG8_WAIT_V(2); PG8_BAR;
    PG8_STAGE(PG8_SB(1, 0), cB + kstep, voffB); PG8_STAGE(PG8_SA(1, 0), cA + kstep, voffA); PG8_STAGE(PG8_SB(1, 1), cB + hstepB + kstep, voffB);
    PG8_WAIT_V(6); PG8_BAR;
    for (;;) {
        const bool has_next = S.next(ui + 1, nxt);
        const char* nA = has_next ? (const char*)g.A + (size_t)nxt.pm * tstepA : cA; const char* nB = has_next ? (const char*)g.Bt + (size_t)nxt.pn * tstepB : cB;
        for (int t = 0; t < nt; t += 2) {
            const bool last = (t == nt - 2);
            const char* a1 = cA + (size_t)(t + 1) * kstep;
            const char* a2 = last ? nA : cA + (size_t)(t + 2) * kstep; const char* b2 = last ? nB : cB + (size_t)(t + 2) * kstep;
            const char* a3 = a2 + kstep; const char* b3 = b2 + kstep;
            PG8_LDB(B0, 0, 0); PG8_LDB(B1, 0, 1); PG8_SCHED; PG8_LDA(At, 0, 0); PG8_STAGE(PG8_SA(1, 1), a1 + hstepA, voffA);
            PG8_WAIT_V(8); PG8_WAIT_L(0); PG8_BAR; PG8_MMA(0, 0, At, B0); PG8_MMA(0, 1, At, B1); PG8_BAR; PG8_SCHED;
            PG8_LDA(At, 0, 1); PG8_STAGE(PG8_SB(0, 0), b2, voffB); PG8_STAGE(PG8_SB(0, 1), b2 + hstepB, voffB); PG8_STAGE(PG8_SA(0, 0), a2, voffA);
            PG8_WAIT_V(8); PG8_WAIT_L(0); PG8_BAR; PG8_MMA(1, 0, At, B0); PG8_MMA(1, 1, At, B1); PG8_BAR; PG8_SCHED;
            PG8_LDB(B0, 1, 0); PG8_LDB(B1, 1, 1); PG8_SCHED; PG8_LDA(At, 1, 0); PG8_STAGE(PG8_SA(0, 1), a2 + hstepA, voffA);
            PG8_WAIT_V(8); PG8_WAIT_L(0); PG8_BAR; PG8_MMA(0, 0, At, B0); PG8_MMA(0, 1, At, B1); PG8_BAR; PG8_SCHED;
            PG8_LDA(At, 1, 1); PG8_STAGE(PG8_SB(1, 0), b3, voffB); PG8_STAGE(PG8_SB(1, 1), b3 + hstepB, voffB); PG8_STAGE(PG8_SA(1, 0), a3, voffA);
            PG8_WAIT_V(8); PG8_WAIT_L(0); PG8_BAR; PG8_MMA(1, 0, At, B0); PG8_MMA(1, 1, At, B1); PG8_BAR; PG8_SCHED;
        }
        if constexpr (ALIGN_EPI) { if (wr == 0) PG8_BAR; }
        E(acc, cur, wr, wc, fr, fq);
        if (!has_next) break;
#pragma unroll
        for (int a = 0; a < 2; ++a)
#pragma unroll
            for (int b = 0; b < 2; ++b)
#pragma unroll
                for (int m = 0; m < 4; ++m)
#pragma unroll
                    for (int n = 0; n < 2; ++n) acc[a][b][m][n] = (f32x4){0.f, 0.f, 0.f, 0.f};
        cur = nxt; cA = nA; cB = nB; ++ui;
        if constexpr (ALIGN_EPI) { if (wr == 1) PG8_BAR; }
    }
    PG8_WAIT_V(0);
    if constexpr (!ALIGN_EPI) { if (wr == 0) PG8_BAR; }
    PG8_BAR;
#undef PG8_SA
#undef PG8_SB
#undef PG8_STAGE
#undef PG8_LDA
#undef PG8_LDB
#undef PG8_MMA
#undef PG8_WAIT_V
#undef PG8_WAIT_L
#undef PG8_BAR
#undef PG8_SCHED
}
}

typedef const f32x4 (&AccRef)[2][2][4][2];

__device__ __forceinline__ void rope8(float (&v)[8], const float* tab) {
    const f32x4 t0 = *(const f32x4*)tab, t1 = *(const f32x4*)(tab + 4);
    float x1, x2;
    x1 = v[0]; x2 = v[1]; v[0] = x1 * t0[0] - x2 * t0[1]; v[1] = x1 * t0[1] + x2 * t0[0];
    x1 = v[2]; x2 = v[3]; v[2] = x1 * t0[2] - x2 * t0[3]; v[3] = x1 * t0[3] + x2 * t0[2];
    x1 = v[4]; x2 = v[5]; v[4] = x1 * t1[0] - x2 * t1[1]; v[5] = x1 * t1[1] + x2 * t1[0];
    x1 = v[6]; x2 = v[7]; v[6] = x1 * t1[2] - x2 * t1[3]; v[7] = x1 * t1[3] + x2 * t1[2];
}
__device__ __forceinline__ u32x4 pack8(const float (&v)[8]) { u32x4 w; w.x = cvtpk(v[0], v[1]); w.y = cvtpk(v[2], v[3]); w.z = cvtpk(v[4], v[5]); w.w = cvtpk(v[6], v[7]); return w; }

template <int MODE> struct EpiProj {
    static constexpr bool PERM = true;
    bf16_t* Q; bf16_t* K; bf16_t* VT; const float* rope; const float* ssq; float qscale; const float* nbias;
    __device__ __forceinline__ void operator()(AccRef acc, const pg8::Unit& u, int wr, int wc, int fr_, int fq_) const {
        int lane_e = lane_id(); asm volatile("" : "+v"(lane_e)); const int fr = lane_e & 15, fq = lane_e >> 4; (void)fr_; (void)fq_;
        constexpr int LDQ = (MODE == 0) ? 1536 : 1024, NQ = (MODE == 0) ? 1536 : (MODE == 1 ? 0 : 1024);
        constexpr int LDK = (MODE == 2) ? 256 : 1024, NK = LDK, VCOLS = LDK;
#pragma unroll
        for (int ai = 0; ai < 2; ++ai)
#pragma unroll
            for (int m = 0; m < 4; ++m) {
                const int row = u.pm * 256 + ai * 128 + wr * 64 + m * 16 + fr;
                const bool isctx = row >= ML; const int rc = row - ML;
                const int b = isctx ? (rc >> 8) : (row >> 13);
                const int tok = row & 8191;
                const int kpos = isctx ? (rc & 255) : 256 + tok;
                const size_t kvrow = (size_t)b * KVLEN + kpos;
                const int vpos = (kpos & ~15) | perm16(kpos & 15);
                const float rs = rsqrtf(ssq[row] * (MODE == 0 ? 1.f / 256.f : (MODE == 1 ? 1.f / 128.f : 1.f / 1024.f)) + EPS);
                const float* nb = nbias + (isctx ? 8 : b) * 4096;
#pragma unroll
                for (int bj = 0; bj < 2; ++bj) {
                    const int col = u.pn * 256 + bj * 128 + wc * 32 + 8 * fq;
                    float v[8];
#pragma unroll
                    for (int j = 0; j < 4; ++j) { v[j] = acc[ai][bj][m][0][j] * rs; v[4 + j] = acc[ai][bj][m][1][j] * rs; }
                    if (MODE >= 2) { const f32x4 b0 = *(const f32x4*)(nb + col), b1 = *(const f32x4*)(nb + col + 4);
#pragma unroll
                        for (int j = 0; j < 4; ++j) { v[j] += b0[j]; v[4 + j] += b1[j]; } }
                    if (MODE == 2) { if (!isctx && col < 1280) rope8(v, rope + ((size_t)tok * 32 + ((col & 63) >> 1)) * 2); }
                    if (MODE == 0) { const int c96 = col % 96; if (!isctx && c96 >= 64) rope8(v, rope + ((size_t)tok * 16 + ((c96 - 64) >> 1)) * 2); }
                    bool isv; int kc;
                    if (MODE == 1) { const int within = col & 127; isv = within >= 64; kc = (col >> 7) * 64 + (within & 63); }
                    else { isv = col >= NQ + NK; kc = isv ? col - NQ - NK : col - NQ; }
                    if (MODE != 1 && col < NQ) {
#pragma unroll
                        for (int j = 0; j < 8; ++j) v[j] *= qscale;
                        *(u32x4*)(Q + (size_t)row * LDQ + col) = pack8(v);
                    } else if (MODE != 0 && !isv) {
                        *(u32x4*)(K + kvrow * LDK + kc) = pack8(v);
                    } else if (MODE != 0) {
                        bf16_t* vp = VT + ((size_t)(b * VCOLS + kc)) * KVLEN + vpos;
#pragma unroll
                        for (int j = 0; j < 8; ++j) vp[(size_t)j * KVLEN] = (bf16_t)(cvtpk(v[j], 0.f) & 0xffffu);
                    }
                }
            }
    }
};

struct EpiLat {
    static constexpr bool PERM = true;
    bf16_t* lat; float* ssq_q; float* ssq_kv; bf16_t* KPE; const float* rope; const float* ssqn; const float* nbias;
    __device__ __forceinline__ void operator()(AccRef acc, const pg8::Unit& u, int wr, int wc, int fr_, int fq_) const {
        int lane_e = lane_id(); asm volatile("" : "+v"(lane_e)); const int fr = lane_e & 15, fq = lane_e >> 4; (void)fr_; (void)fq_;
#pragma unroll
        for (int ai = 0; ai < 2; ++ai)
#pragma unroll
            for (int m = 0; m < 4; ++m) {
                const int row = u.pm * 256 + ai * 128 + wr * 64 + m * 16 + fr;
                const bool isctx = row >= ML; const int rc = row - ML;
                const int b = isctx ? (rc >> 8) : (row >> 13);
                const int tok = row & 8191;
                const int kpos = isctx ? (rc & 255) : 256 + tok;
                const size_t kvrow = (size_t)b * KVLEN + kpos;
                const float rs = rsqrtf(ssqn[row] * (1.f / 1024.f) + EPS); const float* nb = nbias + (isctx ? 8 : b) * 4096;
                float ss = 0.f;
#pragma unroll
                for (int bj = 0; bj < 2; ++bj) {
                    const int col = u.pn * 256 + bj * 128 + wc * 32 + 8 * fq;
                    float v[8];
#pragma unroll
                    for (int j = 0; j < 4; ++j) { v[j] = acc[ai][bj][m][0][j] * rs; v[4 + j] = acc[ai][bj][m][1][j] * rs; }
                    { const f32x4 b0 = *(const f32x4*)(nb + col), b1 = *(const f32x4*)(nb + col + 4);
#pragma unroll
                      for (int j = 0; j < 4; ++j) { v[j] += b0[j]; v[4 + j] += b1[j]; } }
                    if (col < 384) {
#pragma unroll
                        for (int j = 0; j < 8; ++j) ss += v[j] * v[j];
                        *(u32x4*)(lat + (size_t)row * 512 + col) = pack8(v);
                    } else if (col < 416) {
                        if (!isctx) rope8(v, rope + ((size_t)tok * 16 + ((col - 384) >> 1)) * 2);
                        *(u32x4*)(KPE + kvrow * 32 + (col - 384)) = pack8(v);
                    }
                }
                ss += shfl_xor_l(ss, 16, lane_e); ss += shfl_xor_l(ss, 32, lane_e);
                if (fq == 0 && (u.pn == 0 || wc < 4)) unsafeAtomicAdd((u.pn == 0 ? ssq_q : ssq_kv) + row, ss);
            }
    }
};

struct EpiResid {
    static constexpr bool PERM = false;
    const float* xin_l; const float* xin_c; float* xout_l; float* xout_c; const float* gate;
    bf16_t* xa; const float* gn; const float* scn; float* ssqn;
    __device__ __forceinline__ void operator()(AccRef acc, const pg8::Unit& u, int wr, int wc, int fr_, int fq_) const {
        int lane_e = lane_id(); asm volatile("" : "+v"(lane_e)); const int fr = lane_e & 15, fq = lane_e >> 4; (void)fr_; (void)fq_;
#pragma unroll
        for (int ai = 0; ai < 2; ++ai)
#pragma unroll
            for (int m = 0; m < 4; ++m) {
                const int row = u.pm * 256 + ai * 128 + wr * 64 + m * 16 + fr;
                const bool isctx = row >= ML;
                const float* xi = isctx ? xin_c + (size_t)(row - ML) * DM : xin_l + (size_t)row * DM;
                float* xo = isctx ? xout_c + (size_t)(row - ML) * DM : xout_l + (size_t)row * DM;
                const int bsel = isctx ? 8 : (row >> 13);
                const float* gp = gate + bsel * 6144;
                float ss = 0.f;
#pragma unroll
                for (int bj = 0; bj < 2; ++bj)
#pragma unroll
                    for (int n = 0; n < 2; ++n) {
                        const int col = u.pn * 256 + bj * 128 + wc * 32 + 16 * n + 4 * fq;
                        const f32x4 x = *(const f32x4*)(xi + col), gv = *(const f32x4*)(gp + col);
                        const f32x4 y = x + gv * acc[ai][bj][m][n];
                        *(f32x4*)(xo + col) = y;
                        if (xa) { const f32x4 g4 = *(const f32x4*)(gn + col), s4 = *(const f32x4*)(scn + bsel * 6144 + col); const f32x4 z = y * g4 * (s4 + 1.f);
                            ss += (y[0] * y[0] + y[1] * y[1]) + (y[2] * y[2] + y[3] * y[3]);
                            u32x2 o; o.x = cvtpk(z[0], z[1]); o.y = cvtpk(z[2], z[3]); *(u32x2*)(xa + (size_t)row * DM + col) = o; }
                    }
                if (xa) { ss += shfl_xor_l(ss, 16, lane_e); ss += shfl_xor_l(ss, 32, lane_e); if (fq == 0) unsafeAtomicAdd(ssqn + row, ss); }
            }
    }
};

struct EpiSqRelu {
    static constexpr bool PERM = true;
    bf16_t* O; int ldc; const float* ssqn; const float* nbias;
    __device__ __forceinline__ void operator()(AccRef acc, const pg8::Unit& u, int wr, int wc, int fr_, int fq_) const {
        int lane_e = lane_id(); asm volatile("" : "+v"(lane_e)); const int fr = lane_e & 15, fq = lane_e >> 4; (void)fr_; (void)fq_;
#pragma unroll
        for (int ai = 0; ai < 2; ++ai)
#pragma unroll
            for (int m = 0; m < 4; ++m) {
                const int row = u.pm * 256 + ai * 128 + wr * 64 + m * 16 + fr;
                const float rs = rsqrtf(ssqn[row] * (1.f / 1024.f) + EPS); const float* nb = nbias + (row >= ML ? 8 : (row >> 13)) * 4096;
#pragma unroll
                for (int bj = 0; bj < 2; ++bj) {
                    const int col = u.pn * 256 + bj * 128 + wc * 32 + 8 * fq;
                    const f32x4 b0 = *(const f32x4*)(nb + col), b1 = *(const f32x4*)(nb + col + 4);
                    float v[8];
#pragma unroll
                    for (int j = 0; j < 4; ++j) { float a = fmaxf(acc[ai][bj][m][0][j] * rs + b0[j], 0.f), c = fmaxf(acc[ai][bj][m][1][j] * rs + b1[j], 0.f); v[j] = a * a; v[4 + j] = c * c; }
                    *(u32x4*)(O + (size_t)row * ldc + col) = pack8(v);
                }
            }
    }
};

constexpr int KP = 208, VP = 144;
constexpr int KT_BYTES = 64 * KP, VT_BYTES = 64 * VP, ABUF = KT_BYTES + VT_BYTES;
constexpr int ATT_BIAS_OFF = 2 * ABUF;
struct AttnP { const bf16_t* Q; const bf16_t* K; const bf16_t* KPE; const bf16_t* VT; bf16_t* O; const float* sink; const float* bias; int nunits; };

__device__ __forceinline__ float rowmax32(const f32x16& a, const f32x16& b) {
    float x = __builtin_fmaxf(__builtin_fmaxf(a[0], a[1]), b[0]), y = __builtin_fmaxf(__builtin_fmaxf(a[2], a[3]), b[1]); x = __builtin_fmaxf(__builtin_fmaxf(x, b[2]), b[3]);
#pragma unroll
    for (int r = 4; r < 16; r += 4) { x = __builtin_fmaxf(__builtin_fmaxf(x, a[r]), a[r + 1]); y = __builtin_fmaxf(__builtin_fmaxf(y, a[r + 2]), a[r + 3]); x = __builtin_fmaxf(__builtin_fmaxf(x, b[r]), b[r + 1]); y = __builtin_fmaxf(__builtin_fmaxf(y, b[r + 2]), b[r + 3]); }
    const float m = __builtin_fmaxf(x, y);
    auto rr = __builtin_amdgcn_permlane32_swap(__float_as_uint(m), __float_as_uint(m), false, false);
    return __builtin_fmaxf(__uint_as_float(rr[0]), __uint_as_float(rr[1]));
}

template <int VAR>
__device__ __forceinline__ void attn_phase(LAS unsigned char* lds, const AttnP P, int vcu, int G, int wave_s) {
    constexpr int ND0 = (VAR == 0) ? 6 : 4;
    constexpr int QPITCH = (VAR == 0) ? 1536 : 1024, QH = (VAR == 0) ? 96 : 64;
    constexpr int KPITCH = (VAR == 1) ? 256 : 1024, VCOLS = (VAR == 1) ? 256 : 1024;
    constexpr bool USE_NEGM = (VAR != 2);
    constexpr float THR = 8.f;
    int tid_l = wave_s * 64 + lane_id(); asm volatile("" : "+v"(tid_l));
    const int tid = tid_l, lane = tid & 63, r32 = lane & 31, hi = lane >> 5;
    const int w = __builtin_amdgcn_readfirstlane(tid >> 6);
    LAS float* bias_lds = (LAS float*)(lds + ATT_BIAS_OFF);
    for (int it = 0;; ++it) {
        int u;
        if (VAR == 0 && G == 256) { u = (it < 16) ? ((it * 8 + (vcu >> 5)) * 32 + (vcu & 31)) : (4096 + (it - 16) * 256 + vcu); }
        else u = it * G + vcu;
        if (u >= P.nunits) break;
        const bool isctx = u >= 4096;
        int b, hq, hk, qrow, nt; int p_a = 0, p_b = 0;
        if (VAR == 0) {
            if (!isctx) { const int bh = u >> 5, qb = u & 31; b = bh >> 4; hq = bh & 15; qrow = b * SEQ + qb * 256 + 32 * w; nt = 132; }
            else { const int cu = u - 4096; b = cu >> 4; hq = cu & 15; qrow = ML + b * 256 + 32 * w; nt = 4; }
            hk = hq;
        } else if (VAR == 1) {
            if (!isctx) { const int blk = u & 63, hp = (u >> 6) & 7; b = u >> 9; hq = 2 * hp + (w >> 2); hk = hp >> 1; qrow = b * SEQ + blk * 128 + 32 * (w & 3);
                          const int jlo = blk == 0 ? 2 : 0, jhi = blk == 63 ? 4 : 6; nt = 4 + jhi - jlo; p_a = blk * 128 - 128 + 64 * jlo; p_b = blk * 128 + 32 * (w & 3); }
            else { const int cu = u - 4096, half = cu & 1, hp = (cu >> 1) & 7; b = cu >> 4; hq = 2 * hp + (w >> 2); hk = hp >> 1; qrow = ML + b * 256 + half * 128 + 32 * (w & 3); nt = 4; }
        } else {
            if (!isctx) { const int rq = u & 31; hq = (u >> 5) & 15; b = u >> 9; const int r0 = 4 * rq; qrow = b * SEQ + (r0 + (w >> 1)) * 64 + 32 * (w & 1);
                          int lo = r0 - 4; lo = lo < 0 ? 0 : (lo > 120 ? 120 : lo); int h2 = r0 - 1; h2 = h2 < 0 ? 0 : (h2 > 120 ? 120 : h2); nt = 4 + (h2 + 8 - lo); p_a = lo; p_b = r0 + (w >> 1); }
            else { const int cu = u - 4096; b = cu >> 4; hq = cu & 15; qrow = ML + b * 256 + 32 * w; nt = 4; }
            hk = hq;
        }
        if (VAR == 2 && !isctx) { if (tid < 465) bias_lds[tid] = P.bias[hq * 465 + tid] * LOG2E; }
        bf16x8 qf[ND0];
        { const bf16_t* qp = P.Q + (size_t)(qrow + r32) * QPITCH + hq * QH + hi * 8;
#pragma unroll
          for (int d0 = 0; d0 < ND0; ++d0) qf[d0] = *(const bf16x8*)(qp + d0 * 16); }
        f32x16 o0 = {}, o1 = {};
        const unsigned koff = (unsigned)(((b * KVLEN + (tid >> 3)) * KPITCH + hk * 64 + (tid & 7) * 8) * 2);
        const unsigned peoff = (unsigned)(((b * KVLEN + (tid >> 2)) * 32 + (tid & 3) * 8) * 2);
        const unsigned voff = (unsigned)(((b * VCOLS + hk * 64 + (tid >> 3)) * KVLEN + (tid & 7) * 8) * 2);
        u32x4 kreg, pereg = {}, vreg;
#define TILE_KPOS(t) (VAR == 0 ? 64 * (((t) + rot >= nt) ? (t) + rot - nt : (t) + rot) : ((t) < 4 ? 64 * (t) : (VAR == 1 ? 256 + p_a + 64 * ((t) - 4) : 256 + 64 * (p_a + (t) - 4))))
#define LOADK(t) do { const int kp_ = TILE_KPOS(t); kreg = *(const u32x4*)((const char*)P.K + (size_t)(koff + (unsigned)(kp_ * KPITCH * 2))); if (VAR == 0 && tid < 256) pereg = *(const u32x4*)((const char*)P.KPE + (size_t)(peoff + (unsigned)(kp_ * 64))); } while (0)
#define LOADV(t) do { const int kp_ = TILE_KPOS(t); vreg = *(const u32x4*)((const char*)P.VT + (size_t)(voff + (unsigned)(kp_ * 2))); } while (0)
#define STOREK(buf) do { LAS unsigned char* kb_ = lds + (buf) * ABUF; *(LAS u32x4*)(kb_ + (tid >> 3) * KP + (tid & 7) * 16) = kreg; \
        if (VAR == 0 && tid < 256) *(LAS u32x4*)(kb_ + (tid >> 2) * KP + 128 + (tid & 3) * 16) = pereg; } while (0)
#define STOREV(buf) do { *(LAS u32x4*)(lds + (buf) * ABUF + KT_BYTES + (tid >> 3) * VP + (tid & 7) * 16) = vreg; } while (0)
#define NEED(t) (((t) < 4) ? true : (VAR == 1 ? ((p_a + 64 * ((t) - 4) + 63 >= p_b - 128) && (p_a + 64 * ((t) - 4) <= p_b + 31 + 128)) : (VAR == 2 ? ((p_a + (t) - 4 >= na_rs) && (p_a + (t) - 4 < na_rs + 8)) : true)))
#define QK_TILE(P0, P1, buf, CINIT) do { const LAS unsigned char* kt_ = lds + (buf) * ABUF; P0 = (CINIT); P1 = (CINIT); \
        _Pragma("unroll") for (int d0 = 0; d0 < ND0; ++d0) { \
            const bf16x8 k0_ = *(const LAS bf16x8*)(kt_ + r32 * KP + d0 * 32 + hi * 16); const bf16x8 k1_ = *(const LAS bf16x8*)(kt_ + (32 + r32) * KP + d0 * 32 + hi * 16); \
            P0 = __builtin_amdgcn_mfma_f32_32x32x16_bf16(k0_, qf[d0], P0, 0, 0, 0); P1 = __builtin_amdgcn_mfma_f32_32x32x16_bf16(k1_, qf[d0], P1, 0, 0, 0); } } while (0)
#define MASK_TILE(P0, P1, t) do { \
        if (VAR == 1 && (t) >= 4) { const int d0_ = p_a + 64 * ((t) - 4) - (p_b + r32) + 4 * hi + 128; \
            _Pragma("unroll") for (int r = 0; r < 16; ++r) { const int dd = d0_ + (r & 3) + 8 * (r >> 2); if ((unsigned)dd > 256u) P0[r] = -1e30f; if ((unsigned)(dd + 32) > 256u) P1[r] = -1e30f; } } \
        if (VAR == 2 && (t) >= 4) { int c = (qrow & 63) + r32; asm volatile("" : "+v"(c)); const int kr = p_a + (t) - 4; int cs = c - 8; cs = cs < 0 ? 0 : (cs > 48 ? 48 : cs); const LAS float* brow = bias_lds + (kr - p_b + 7) * 31; \
            _Pragma("unroll") for (int r = 0; r < 16; ++r) { const int kc = 4 * hi + (r & 3) + 8 * (r >> 2); \
                { int bi = kc - c + 15; bi = bi < 0 ? 0 : (bi > 30 ? 30 : bi); P0[r] = ((unsigned)(kc - cs) < 16u) ? P0[r] + brow[bi] : -1e30f; } \
                { int bi = kc + 32 - c + 15; bi = bi < 0 ? 0 : (bi > 30 ? 30 : bi); P1[r] = ((unsigned)(kc + 32 - cs) < 16u) ? P1[r] + brow[bi] : -1e30f; } } } } while (0)
        const int rot = (VAR == 0 && !isctx) ? ((vcu & 31) * 4 + (vcu >> 5)) % 132 : 0;
        int na_rs = 0; if (VAR == 2) { na_rs = p_b - 4; na_rs = na_rs < 0 ? 0 : (na_rs > 120 ? 120 : na_rs); }
        LOADK(0); LOADV(0); STOREK(0); STOREV(0);
        if (nt > 1) { LOADK(1); STOREK(1); }
        __syncthreads();
        f32x16 pc0, pc1; const f32x16 zero16 = {};
        QK_TILE(pc0, pc1, 0, zero16);
        float mref = rowmax32(pc0, pc1), lrun = 0.f;
        if (VAR == 1) { const float sk = P.sink[hq] * LOG2E; mref = __builtin_fmaxf(mref, sk); lrun = (hi == 0) ? __builtin_amdgcn_exp2f(sk - mref) : 0.f; }
        f32x16 negm = {};
        if (USE_NEGM) {
#pragma unroll
            for (int r = 0; r < 16; ++r) { pc0[r] -= mref; pc1[r] -= mref; negm[r] = -mref; }
        }
        float rmc = 0.f;
        bool need_c = true;
        __syncthreads();
        for (int t = 0; t < nt; ++t) {
            const bool hn = (t + 1 < nt);
            if (hn) { const int t2 = (t + 2 < nt) ? t + 2 : nt - 1; LOADK(t2); LOADV(t + 1); }
            const bool need_n = hn && NEED(t + 1);
            if (need_c && __any(rmc > THR)) {
                const float dl = __builtin_fmaxf(rmc, 0.f), f = __builtin_amdgcn_exp2f(-dl);
                mref += dl; lrun *= f;
#pragma unroll
                for (int r = 0; r < 16; ++r) { if (USE_NEGM) { pc0[r] -= dl; pc1[r] -= dl; negm[r] = -mref; } o0[r] *= f; o1[r] *= f; }
            }
            f32x16 pn0 = {}, pn1 = {};
            float rmn = -1e30f;
            if (VAR != 2 && need_c && need_n) {
                const LAS unsigned char* kt_ = lds + ((t + 1) & 1) * ABUF; const LAS unsigned char* vt_ = lds + (t & 1) * ABUF + KT_BYTES;
                bf16x8 kf[2 * ND0], vf[8]; u32x4 w0, w1, w2, w3; float sacc = 0.f;
#define KRD(d0) do { kf[2 * (d0)] = *(const LAS bf16x8*)(kt_ + r32 * KP + (d0) * 32 + hi * 16); kf[2 * (d0) + 1] = *(const LAS bf16x8*)(kt_ + (32 + r32) * KP + (d0) * 32 + hi * 16); } while (0)
#define VRD(kk) do { vf[2 * (kk)] = *(const LAS bf16x8*)(vt_ + r32 * VP + (kk) * 32 + hi * 16); vf[2 * (kk) + 1] = *(const LAS bf16x8*)(vt_ + (32 + r32) * VP + (kk) * 32 + hi * 16); } while (0)
#define EX4(Pv, a, W, lo) do { if (!USE_NEGM) { Pv[a] -= mref; Pv[a + 1] -= mref; Pv[a + 2] -= mref; Pv[a + 3] -= mref; } Pv[a] = __builtin_amdgcn_exp2f(Pv[a]); Pv[a + 1] = __builtin_amdgcn_exp2f(Pv[a + 1]); Pv[a + 2] = __builtin_amdgcn_exp2f(Pv[a + 2]); Pv[a + 3] = __builtin_amdgcn_exp2f(Pv[a + 3]); \
        sacc += Pv[a]; sacc += Pv[a + 1]; sacc += Pv[a + 2]; sacc += Pv[a + 3]; if (lo) { W.x = cvtpk(Pv[a], Pv[a + 1]); W.y = cvtpk(Pv[a + 2], Pv[a + 3]); } else { W.z = cvtpk(Pv[a], Pv[a + 1]); W.w = cvtpk(Pv[a + 2], Pv[a + 3]); } } while (0)
#define SB() __builtin_amdgcn_sched_barrier(0)
#define QKP(d0, C0, C1) do { pn0 = __builtin_amdgcn_mfma_f32_32x32x16_bf16(kf[2 * (d0)], qf[d0], C0, 0, 0, 0); pn1 = __builtin_amdgcn_mfma_f32_32x32x16_bf16(kf[2 * (d0) + 1], qf[d0], C1, 0, 0, 0); } while (0)
#define PVP(kk, W) do { const bf16x8 pb_ = __builtin_bit_cast(bf16x8, W); o0 = __builtin_amdgcn_mfma_f32_32x32x16_bf16(vf[2 * (kk)], pb_, o0, 0, 0, 0); o1 = __builtin_amdgcn_mfma_f32_32x32x16_bf16(vf[2 * (kk) + 1], pb_, o1, 0, 0, 0); } while (0)
#define KR1(j) (kf[j] = *(const LAS bf16x8*)(kt_ + (32 * ((j) & 1) + r32) * KP + ((j) >> 1) * 32 + hi * 16))
#define VR1(i) (vf[i] = *(const LAS bf16x8*)(vt_ + (32 * ((i) & 1) + r32) * VP + ((i) >> 1) * 32 + hi * 16))
#define EX2(Pv, a, Wd) do { Pv[a] = __builtin_amdgcn_exp2f(Pv[a]); Pv[a + 1] = __builtin_amdgcn_exp2f(Pv[a + 1]); sacc += Pv[a]; sacc += Pv[a + 1]; Wd = cvtpk(Pv[a], Pv[a + 1]); } while (0)
#define QK1(j, C) do { if ((j) & 1) pn1 = __builtin_amdgcn_mfma_f32_32x32x16_bf16(kf[j], qf[(j) >> 1], C, 0, 0, 0); else pn0 = __builtin_amdgcn_mfma_f32_32x32x16_bf16(kf[j], qf[(j) >> 1], C, 0, 0, 0); } while (0)
#define PV1(i, W) do { const bf16x8 pb_ = __builtin_bit_cast(bf16x8, W); if ((i) & 1) o1 = __builtin_amdgcn_mfma_f32_32x32x16_bf16(vf[i], pb_, o1, 0, 0, 0); else o0 = __builtin_amdgcn_mfma_f32_32x32x16_bf16(vf[i], pb_, o0, 0, 0, 0); } while (0)
                if (ND0 == 6) {
                    KR1(0); KR1(1); KR1(2); KR1(3); SB();
                    QK1(0, negm); EX2(pc0, 0, w0.x); KR1(4); SB();
                    QK1(1, negm); EX2(pc0, 2, w0.y); KR1(5); SB();
                    QK1(2, pn0); EX2(pc0, 4, w0.z); KR1(6); SB();
                    QK1(3, pn1); EX2(pc0, 6, w0.w); KR1(7); SB();
                    QK1(4, pn0); EX2(pc0, 8, w1.x); KR1(8); SB();
                    QK1(5, pn1); EX2(pc0, 10, w1.y); KR1(9); SB();
                    QK1(6, pn0); EX2(pc0, 12, w1.z); KR1(10); SB();
                    QK1(7, pn1); EX2(pc0, 14, w1.w); KR1(11); SB();
                    QK1(8, pn0); EX2(pc1, 0, w2.x); VR1(0); SB();
                    QK1(9, pn1); EX2(pc1, 2, w2.y); VR1(1); SB();
                    QK1(10, pn0); EX2(pc1, 4, w2.z); VR1(2); SB();
                    QK1(11, pn1); EX2(pc1, 6, w2.w); VR1(3); SB();
                } else {
                    KR1(0); KR1(1); KR1(2); KR1(3); SB();
                    QK1(0, negm); EX2(pc0, 0, w0.x); EX2(pc0, 2, w0.y); KR1(4); SB();
                    QK1(1, negm); EX2(pc0, 4, w0.z); EX2(pc0, 6, w0.w); KR1(5); SB();
                    QK1(2, pn0); EX2(pc0, 8, w1.x); EX2(pc0, 10, w1.y); KR1(6); SB();
                    QK1(3, pn1); EX2(pc0, 12, w1.z); EX2(pc0, 14, w1.w); KR1(7); SB();
                    QK1(4, pn0); EX2(pc1, 0, w2.x); VR1(0); SB();
                    QK1(5, pn1); EX2(pc1, 2, w2.y); VR1(1); SB();
                    QK1(6, pn0); EX2(pc1, 4, w2.z); VR1(2); SB();
                    QK1(7, pn1); EX2(pc1, 6, w2.w); VR1(3); SB();
                }
                PV1(0, w0); EX2(pc1, 8, w3.x); VR1(4); SB();
                PV1(1, w0); EX2(pc1, 10, w3.y); VR1(5); SB();
                PV1(2, w1); EX2(pc1, 12, w3.z); VR1(6); SB();
                PV1(3, w1); EX2(pc1, 14, w3.w); VR1(7); SB();
                lrun += sacc;
                PV1(4, w2); MASK_TILE(pn0, pn1, t + 1); SB();
                PV1(5, w2); SB();
                PV1(6, w3); SB();
                PV1(7, w3); rmn = rowmax32(pn0, pn1); if (!USE_NEGM) rmn -= mref; SB();
#undef KR1
#undef VR1
#undef EX2
#undef QK1
#undef PV1
#undef KRD
#undef VRD
#undef EX4
#undef SB
#undef QKP
#undef PVP
            } else {
            if (need_n) QK_TILE(pn0, pn1, (t + 1) & 1, negm);
            if (need_c) {
                float sum = 0.f;
#pragma unroll
                for (int r = 0; r < 16; ++r) { if (!USE_NEGM) { pc0[r] -= mref; pc1[r] -= mref; } pc0[r] = __builtin_amdgcn_exp2f(pc0[r]); pc1[r] = __builtin_amdgcn_exp2f(pc1[r]); sum += pc0[r]; sum += pc1[r]; }
                lrun += sum;
                bf16x8 pk[4];
                { u32x4 a; a.x = cvtpk(pc0[0], pc0[1]); a.y = cvtpk(pc0[2], pc0[3]); a.z = cvtpk(pc0[4], pc0[5]); a.w = cvtpk(pc0[6], pc0[7]); pk[0] = __builtin_bit_cast(bf16x8, a); }
                { u32x4 a; a.x = cvtpk(pc0[8], pc0[9]); a.y = cvtpk(pc0[10], pc0[11]); a.z = cvtpk(pc0[12], pc0[13]); a.w = cvtpk(pc0[14], pc0[15]); pk[1] = __builtin_bit_cast(bf16x8, a); }
                { u32x4 a; a.x = cvtpk(pc1[0], pc1[1]); a.y = cvtpk(pc1[2], pc1[3]); a.z = cvtpk(pc1[4], pc1[5]); a.w = cvtpk(pc1[6], pc1[7]); pk[2] = __builtin_bit_cast(bf16x8, a); }
                { u32x4 a; a.x = cvtpk(pc1[8], pc1[9]); a.y = cvtpk(pc1[10], pc1[11]); a.z = cvtpk(pc1[12], pc1[13]); a.w = cvtpk(pc1[14], pc1[15]); pk[3] = __builtin_bit_cast(bf16x8, a); }
                const LAS unsigned char* vt = lds + (t & 1) * ABUF + KT_BYTES;
#pragma unroll
                for (int kk = 0; kk < 4; ++kk) {
                    const bf16x8 v0 = *(const LAS bf16x8*)(vt + r32 * VP + kk * 32 + hi * 16);
                    const bf16x8 v1 = *(const LAS bf16x8*)(vt + (32 + r32) * VP + kk * 32 + hi * 16);
                    o0 = __builtin_amdgcn_mfma_f32_32x32x16_bf16(v0, pk[kk], o0, 0, 0, 0);
                    o1 = __builtin_amdgcn_mfma_f32_32x32x16_bf16(v1, pk[kk], o1, 0, 0, 0);
                }
            }
            if (need_n) { MASK_TILE(pn0, pn1, t + 1); rmn = rowmax32(pn0, pn1); if (!USE_NEGM) rmn -= mref; }
            }
            if (hn) { STOREK(t & 1); STOREV((t + 1) & 1); }
            __syncthreads();
            pc0 = pn0; pc1 = pn1; rmc = rmn; need_c = need_n;
        }
#undef TILE_KPOS
#undef LOADK
#undef LOADV
#undef STOREK
#undef STOREV
#undef NEED
#undef QK_TILE
#undef MASK_TILE
        const float lt = lrun + shfl_xor_l(lrun, 32, lane), inv = 1.f / lt;
        bf16_t* op = P.O + (size_t)(qrow + r32) * DM + hq * 64 + 4 * hi;
#pragma unroll
        for (int g = 0; g < 4; ++g) {
            u32x2 a; a.x = cvtpk(o0[4 * g] * inv, o0[4 * g + 1] * inv); a.y = cvtpk(o0[4 * g + 2] * inv, o0[4 * g + 3] * inv); *(u32x2*)(op + 8 * g) = a;
            u32x2 c; c.x = cvtpk(o1[4 * g] * inv, o1[4 * g + 1] * inv); c.y = cvtpk(o1[4 * g + 2] * inv, o1[4 * g + 3] * inv); *(u32x2*)(op + 32 + 8 * g) = c;
        }
    }
}

constexpr size_t MiB = 1u << 20;
constexpr size_t WS_BAR = 983040  ;
constexpr size_t WS_MOD = 0, WS_SSQ = 1 * MiB, WS_ROPE16 = 3 * MiB, WS_ROPE32 = 4 * MiB, WS_KPE = 6 * MiB, WS_XC = 12 * MiB;
constexpr size_t WS_W1T = 20 * MiB, WS_W2T = 52 * MiB, WS_MLA = 84 * MiB  , WS_SWA = 94 * MiB  , WS_NA = 99 * MiB  ;
constexpr size_t WS_H = 108 * MiB, WS_Q = 240 * MiB, WS_K = 438 * MiB, WS_VT = 570 * MiB, WS_O = 702 * MiB, WS_LAT = 702 * MiB, WS_HID = 240 * MiB, WS_NBIAS = 834 * MiB  , WS_SSQN = 836 * MiB  , WS_END = 840 * MiB;

#define XB_TMO      128
#define XB_XCNT(j)  (256  + 64 * (j))
#define XB_XSUB(j)  (1280 + 64 * (j))
#define XB_XGEN(j)  (2304 + 64 * (j))
#define XB_TOP      3328
#define XB_TOPGEN   3392
#define XCD_BAR_WORDS 3456
#define XB_SPIN_CAP (1u << 18)
__device__ __forceinline__ unsigned xb_ld(unsigned* p)              { return __hip_atomic_load(p, __ATOMIC_RELAXED, __HIP_MEMORY_SCOPE_AGENT); }
__device__ __forceinline__ unsigned xb_add(unsigned* p, unsigned v) { return __hip_atomic_fetch_add(p, v, __ATOMIC_RELAXED, __HIP_MEMORY_SCOPE_AGENT); }
__device__ __forceinline__ unsigned xb_xcc_id() { return (unsigned)__builtin_amdgcn_s_getreg((3 << 11) | 20) & 0xFu; }
#define XB_SPIN(cond, bar) do { unsigned _sp = 0; while (cond) { __builtin_amdgcn_s_sleep(1); \
    if ((++_sp & 255u) == 0u) { if (xb_ld(&(bar)[XB_TMO])) break; if (_sp > XB_SPIN_CAP) { atomicAdd(&(bar)[XB_TMO], 1u); break; } } } } while (0)
struct XcdBarrier { unsigned* bar; unsigned x; volatile LAS unsigned* st; };
__device__ __forceinline__ XcdBarrier xcd_barrier_post(unsigned* bar, volatile LAS unsigned* st, bool t0) {
    XcdBarrier b; b.bar = bar; b.x = xb_xcc_id(); b.st = st;
    if (t0) (void)xb_add(&bar[XB_XCNT(b.x)], 1u);
    return b;
}
__device__ __forceinline__ void xcd_barrier_complete(unsigned* bar, unsigned x, unsigned& nloc, unsigned& nx) {
    const unsigned G = gridDim.x * gridDim.y * gridDim.z;
    unsigned sum, cnt, mine, sp = 0u;
    for (;;) {
        sum = 0u; cnt = 0u; mine = 0u;
#pragma unroll
        for (unsigned j = 0; j < 16; ++j) { const unsigned c = xb_ld(&bar[XB_XCNT(j)]); sum += c; cnt += (c > 0u) ? 1u : 0u; mine = (j == x) ? c : mine; }
        if (sum == G) break;
        __builtin_amdgcn_s_sleep(1);
        if ((++sp & 255u) == 0u) { if (xb_ld(&bar[XB_TMO])) break; if (sp > XB_SPIN_CAP) { atomicAdd(&bar[XB_TMO], 1u); break; } }
    }
    nloc = mine > 0u ? mine : 1u; nx = cnt > 0u ? cnt : 1u;
}
__device__ __forceinline__ void xcd_barrier(const XcdBarrier& b, bool t0) {
    asm volatile("s_waitcnt vmcnt(0)" ::: "memory");
    __syncthreads();
    if (t0) {
        unsigned* bar = b.bar; unsigned bx = b.x; asm volatile("" : "+s"(bar), "+s"(bx));
        __builtin_amdgcn_s_waitcnt(0);
        unsigned nloc = b.st[0], nx = b.st[1];
        if (nloc == 0u) { xcd_barrier_complete(bar, bx, nloc, nx); b.st[0] = nloc; b.st[1] = nx; }
        const unsigned old = xb_add(&bar[XB_XSUB(bx)], 1u);
        const unsigned gen = old / nloc;
        if (old + 1u == (gen + 1u) * nloc) {
            __builtin_amdgcn_fence(__ATOMIC_RELEASE, "agent");
            asm volatile("s_waitcnt vmcnt(0)" ::: "memory");
            const unsigned og = xb_add(&bar[XB_TOP], 1u);
            const unsigned tg = og / nx;
            if (og + 1u == (tg + 1u) * nx) xb_add(&bar[XB_TOPGEN], 1u);
            else XB_SPIN(xb_ld(&bar[XB_TOPGEN]) == tg, bar);
            __builtin_amdgcn_fence(__ATOMIC_ACQUIRE, "agent");
            xb_add(&bar[XB_XGEN(bx)], 1u);
            asm volatile("s_waitcnt vmcnt(0)" ::: "memory");
        } else {
            XB_SPIN(xb_ld(&bar[XB_XGEN(bx)]) == gen, bar);
            __builtin_amdgcn_fence(__ATOMIC_ACQUIRE, "agent");
            asm volatile("s_waitcnt vmcnt(0)" ::: "memory");
        }
    }
    __syncthreads();
}

__device__ __forceinline__ float wave_sum(float v, int lane) {
#pragma unroll
    for (int o = 1; o < 64; o <<= 1) v += shfl_xor_l(v, o, lane);
    return v;
}
__device__ __forceinline__ void sincos_red(float x, float& sn, float& cs) {
    const float n = rintf(x * 0.15915494309189535f);
    float r = fmaf(-n, 6.2831854820251465f, x); r = fmaf(-n, -1.7484555e-7f, r);
    const float rev = r * 0.15915494309189535f;
    sn = __builtin_amdgcn_sinf(rev); cs = __builtin_amdgcn_cosf(rev);
}
__device__ __forceinline__ void transpose_item(const float* W, int K, int N, bf16_t* WT, const float* g, LAS float* scr, int item, int lane) {
    const int nblk = N / 32, kb = item / nblk, nb = item % nblk, k0 = 64 * kb, n0 = 32 * nb;
#pragma unroll 8
    for (int i = 0; i < 32; ++i) { const int kk = 2 * i + (lane >> 5); float v = W[(size_t)(k0 + kk) * N + n0 + (lane & 31)]; if (g) v *= g[k0 + kk]; scr[kk * 33 + (lane & 31)] = v; }
    asm volatile("s_waitcnt lgkmcnt(0)" ::: "memory");
    const int c = lane & 7;
#pragma unroll
    for (int j = 0; j < 4; ++j) { const int n = (lane >> 3) + 8 * j; const LAS float* s = scr + (8 * c) * 33 + n;
        u32x4 o; o.x = cvtpk(s[0 * 33], s[1 * 33]); o.y = cvtpk(s[2 * 33], s[3 * 33]); o.z = cvtpk(s[4 * 33], s[5 * 33]); o.w = cvtpk(s[6 * 33], s[7 * 33]);
        *(u32x4*)(WT + (size_t)(n0 + n) * K + k0 + 8 * c) = o; }
    asm volatile("s_waitcnt lgkmcnt(0)" ::: "memory");
}

struct Args { const float* in[23]; float* out; unsigned char* ws; };

__device__ __forceinline__ void norm_pass0(const float* xl, const float* xc, const float* g, const float* mod, int sc_off, bf16_t* H, float* ssq, int gw, int NGW) {
    int lane = lane_id(); asm volatile("" : "+v"(lane));
    for (int row = gw; row < MT; row += NGW) {
        const bool isctx = row >= ML;
        const float* xr = isctx ? xc + (size_t)(row - ML) * DM : xl + (size_t)row * DM;
        const float* mp = mod + (isctx ? 8 : (row >> 13)) * 6144;
        f32x4 v[4]; float ss = 0.f;
#pragma unroll
        for (int j = 0; j < 4; ++j) { v[j] = *(const f32x4*)(xr + 4 * lane + 256 * j); ss += (v[j][0] * v[j][0] + v[j][1] * v[j][1]) + (v[j][2] * v[j][2] + v[j][3] * v[j][3]); }
        ss = wave_sum(ss, lane);
        if (lane == 0) ssq[row] = ss;
#pragma unroll
        for (int j = 0; j < 4; ++j) { const int col = 4 * lane + 256 * j;
            const f32x4 gg = *(const f32x4*)(g + col), sc = *(const f32x4*)(mp + sc_off + col);
            const f32x4 y = v[j] * gg * (sc + 1.f);
            u32x2 o; o.x = cvtpk(y[0], y[1]); o.y = cvtpk(y[2], y[3]); *(u32x2*)(H + (size_t)row * DM + col) = o; }
    }
}
__device__ __forceinline__ void nbias_item(LAS unsigned char* lds, const float* W, int N, int n0, const float* mod, int sh_off, float* out, int wave, int lane) {
    LAS float* shl = (LAS float*)(lds + 65536); LAS float* red = (LAS float*)(lds + 102400);
    const int tid = wave * 64 + lane;
    for (int i = tid; i < 9 * 1024; i += 512) shl[i] = mod[(i >> 10) * 6144 + sh_off + (i & 1023)];
    __syncthreads();
    const int n = n0 + lane; const bool ok = n < N;
    const float* Wp = W + (ok ? n : 0);
    float s0 = 0, s1 = 0, s2 = 0, s3 = 0, s4 = 0, s5 = 0, s6 = 0, s7 = 0, s8 = 0;
#pragma unroll 8
    for (int k = wave * 128; k < wave * 128 + 128; ++k) { const float wv = Wp[(size_t)k * N];
        s0 += shl[k] * wv; s1 += shl[1024 + k] * wv; s2 += shl[2048 + k] * wv; s3 += shl[3072 + k] * wv; s4 += shl[4096 + k] * wv;
        s5 += shl[5120 + k] * wv; s6 += shl[6144 + k] * wv; s7 += shl[7168 + k] * wv; s8 += shl[8192 + k] * wv; }
    LAS float* rp = red + wave * 576 + lane;
    rp[0] = s0; rp[64] = s1; rp[128] = s2; rp[192] = s3; rp[256] = s4; rp[320] = s5; rp[384] = s6; rp[448] = s7; rp[512] = s8;
    __syncthreads();
    for (int i = tid; i < 576; i += 512) { float sum = 0.f;
#pragma unroll
        for (int ww = 0; ww < 8; ++ww) sum += red[ww * 576 + i];
        const int b = i >> 6, l = i & 63; if (n0 + l < N) out[b * 4096 + n0 + l] = sum; else if (n0 + l < 4096) out[b * 4096 + n0 + l] = 0.f; }
    __syncthreads();
}

__global__ void __launch_bounds__(512, 2) fwd_megakernel(Args a) {
    extern __shared__ __attribute__((aligned(16))) unsigned char lds_raw[];
    LAS unsigned char* lds = (LAS unsigned char*)lds_raw;
    cg::grid_group grid = cg::this_grid();
    const int wave = __builtin_amdgcn_readfirstlane((int)threadIdx.x >> 6);
    const int G = gridDim.x, bid = blockIdx.x;
    const int vcu = (G % 8 == 0) ? (bid % 8) * (G / 8) + bid / 8 : bid;
    const int gw = vcu * 8 + wave, NGW = G * 8;
    unsigned char* ws = a.ws;
    volatile LAS unsigned* bar_st = (volatile LAS unsigned*)(lds + 131072 + 64);
    if (wave == 0 && lane_id() < 2) bar_st[lane_id()] = 0u;
    __syncthreads();
    XcdBarrier xbar = xcd_barrier_post((unsigned*)(ws + WS_BAR), bar_st, wave == 0 && lane_id() == 0);
#define GRID_BAR() xcd_barrier(xbar, wave == 0 && lane_id() == 0)
    const float* x_in = a.in[0]; const float* c_in = a.in[1]; const float* ctx_in = a.in[2]; const float* cctx_in = a.in[3];
    const float* ada_w = a.in[4]; const float* ada_b = a.in[5]; const float* norm_mix_g = a.in[6]; const float* norm_mlp_g = a.in[7]; const float* norm_out_g = a.in[8];
    float* MOD = (float*)(ws + WS_MOD); float* SSQ = (float*)(ws + WS_SSQ);
    float* ROPE16 = (float*)(ws + WS_ROPE16); float* ROPE32 = (float*)(ws + WS_ROPE32);
    bf16_t* KPE = (bf16_t*)(ws + WS_KPE); float* XC = (float*)(ws + WS_XC);
    bf16_t* H = (bf16_t*)(ws + WS_H); bf16_t* Qb = (bf16_t*)(ws + WS_Q); bf16_t* Kb = (bf16_t*)(ws + WS_K); bf16_t* VTb = (bf16_t*)(ws + WS_VT);
    bf16_t* Ob = (bf16_t*)(ws + WS_O); bf16_t* LAT = (bf16_t*)(ws + WS_LAT); bf16_t* HID = (bf16_t*)(ws + WS_HID);
    float* X = a.out;
    float* NBIAS = (float*)(ws + WS_NBIAS); float* SSQN = (float*)(ws + WS_SSQN);

    {
        const int lane = lane_id(), tid = wave * 64 + lane;
        LAS float* act = (LAS float*)(lds + 65536); LAS float* red = (LAS float*)(lds + 102400);
        for (int i = tid; i < 9 * 1024; i += 512) { const int b = i >> 10, k = i & 1023; const float v = b < 8 ? c_in[b * 1024 + k] : cctx_in[k]; act[i] = v / (1.f + __builtin_amdgcn_exp2f(-v * LOG2E)); }
        __syncthreads();
        for (int it = bid; it < 384; it += G) {
            const int layer = it / 96, n0 = (it % 96) * 64;
            const float* W = ada_w + (size_t)layer * 1024 * 6144 + n0 + lane;
            float s0 = 0, s1 = 0, s2 = 0, s3 = 0, s4 = 0, s5 = 0, s6 = 0, s7 = 0, s8 = 0;
#pragma unroll 8
            for (int k = wave * 128; k < wave * 128 + 128; ++k) { const float wv = W[(size_t)k * 6144];
                s0 += act[k] * wv; s1 += act[1024 + k] * wv; s2 += act[2048 + k] * wv; s3 += act[3072 + k] * wv; s4 += act[4096 + k] * wv;
                s5 += act[5120 + k] * wv; s6 += act[6144 + k] * wv; s7 += act[7168 + k] * wv; s8 += act[8192 + k] * wv; }
            LAS float* rp = red + wave * 576 + lane;
            rp[0] = s0; rp[64] = s1; rp[128] = s2; rp[192] = s3; rp[256] = s4; rp[320] = s5; rp[384] = s6; rp[448] = s7; rp[512] = s8;
            __syncthreads();
            for (int i = tid; i < 576; i += 512) { float s = 0.f;
#pragma unroll
                for (int ww = 0; ww < 8; ++ww) s += red[ww * 576 + i];
                const int b = i >> 6, l = i & 63; MOD[((size_t)layer * 9 + b) * 6144 + n0 + l] = s + ada_b[layer * 6144 + n0 + l]; }
            __syncthreads();
        }
        __syncthreads();
        LAS float* scr = (LAS float*)(lds + wave * 16384);
        int base = 0;
#define TR(Wsrc, K_, N_, dst, gsc) do { const int n_ = ((K_) / 64) * ((N_) / 32); \
            for (int it_ = (gw + NGW - (base % NGW)) % NGW; it_ < n_; it_ += NGW) transpose_item((Wsrc), (K_), (N_), (dst), (gsc), scr, it_, lane); base += n_; } while (0)
        for (int L = 0; L < 4; ++L) {
            TR(a.in[9] + (size_t)L * DM * FF, DM, FF, (bf16_t*)(ws + WS_W1T + (size_t)L * 8 * MiB), (const float*)nullptr);
            TR(a.in[10] + (size_t)L * FF * DM, FF, DM, (bf16_t*)(ws + WS_W2T + (size_t)L * 8 * MiB), (const float*)nullptr);
        }
        for (int j = 0; j < 2; ++j) {
            unsigned char* mb = ws + WS_MLA + (size_t)j * 5 * MiB;
            TR(a.in[11] + (size_t)j * DM * 416, DM, 416, (bf16_t*)mb, (const float*)nullptr);
            TR(a.in[13] + (size_t)j * 256 * 1536, 256, 1536, (bf16_t*)(mb + 1 * MiB), a.in[12] + j * 256);
            TR(a.in[15] + (size_t)j * 128 * 2048, 128, 2048, (bf16_t*)(mb + 1 * MiB + 768 * 1024), a.in[14] + j * 128);
            TR(a.in[16] + (size_t)j * DM * DM, DM, DM, (bf16_t*)(mb + 3 * MiB), (const float*)nullptr);
            u32x4* z = (u32x4*)(mb + (size_t)416 * 1024 * 2);
            for (int i = gw * 64 + lane; i < 96 * 1024 * 2 / 16; i += NGW * 64) z[i] = (u32x4){0u, 0u, 0u, 0u};
        }
        TR(a.in[17], DM, 1536, (bf16_t*)(ws + WS_SWA), (const float*)nullptr);
        TR(a.in[19], DM, DM, (bf16_t*)(ws + WS_SWA + 3 * MiB), (const float*)nullptr);
        TR(a.in[20], DM, 3072, (bf16_t*)(ws + WS_NA), (const float*)nullptr);
        TR(a.in[22], DM, DM, (bf16_t*)(ws + WS_NA + 6 * MiB), (const float*)nullptr);
#undef TR
        for (int i = gw * 64 + lane; i < 8192 * 16; i += NGW * 64) { const int t = i >> 4, p = i & 15; const int f = p & 7; const float pos = (float)(p < 8 ? (t >> 6) : (t & 63));
            const float ang = pos * __builtin_amdgcn_exp2f(-(float)f * (13.287712379549449f / 8.f)); float sn, cs; sincos_red(ang, sn, cs); ROPE16[2 * i] = cs; ROPE16[2 * i + 1] = sn; }
        for (int i = gw * 64 + lane; i < 8192 * 32; i += NGW * 64) { const int t = i >> 5, p = i & 31; const int f = p & 15; const float pos = (float)(p < 16 ? (t >> 6) : (t & 63));
            const float ang = pos * __builtin_amdgcn_exp2f(-(float)f * (13.287712379549449f / 16.f)); float sn, cs; sincos_red(ang, sn, cs); ROPE32[2 * i] = cs; ROPE32[2 * i + 1] = sn; }
        for (int i = gw * 64 + lane; i < 4 * MT; i += NGW * 64) SSQ[i] = 0.f;
        for (int i = gw * 64 + lane; i < 8 * MT; i += NGW * 64) SSQN[i] = 0.f;
    }
    grid.sync();
    {
        const int lane = lane_id();
        for (int it = bid; it < 8 + 24 + 48 + 8 + 256; it += G) {
            int r = it; const float* W; int N, L, which, blk;
            if (r < 8) { W = a.in[11]; N = 416; L = 0; which = 0; blk = r; }
            else if ((r -= 8) < 24) { W = a.in[17]; N = 1536; L = 1; which = 0; blk = r; }
            else if ((r -= 24) < 48) { W = a.in[20]; N = 3072; L = 2; which = 0; blk = r; }
            else if ((r -= 48) < 8) { W = a.in[11] + (size_t)DM * 416; N = 416; L = 3; which = 0; blk = r; }
            else { r -= 8; L = r >> 6; blk = r & 63; W = a.in[9] + (size_t)L * DM * FF; N = FF; which = 1; }
            nbias_item(lds, W, N, blk * 64, MOD + (size_t)L * 9 * 6144, which ? 3072 : 0, NBIAS + (size_t)(L * 2 + which) * 9 * 4096, wave, lane);
        }
        norm_pass0(x_in, ctx_in, norm_mix_g, MOD, 1024, H, SSQN, gw, NGW);
    }
    GRID_BAR();

    for (int L = 0; L < 4; ++L) {
        const int kind = L % 3, jl = L / 3; const bool last = (L == 3);
        const float* modL = MOD + (size_t)L * 9 * 6144;
        const float* xl = (L == 0) ? x_in : X; const float* xc = (L == 0) ? ctx_in : XC;
        const float* ssqn1 = SSQN + (size_t)(2 * L) * MT; const float* nbias1 = NBIAS + (size_t)(L * 2) * 9 * 4096;
        if (kind == 0) {
            unsigned char* mb = ws + WS_MLA + (size_t)jl * 5 * MiB;
            float* ssq_q = SSQ + (size_t)jl * 2 * MT; float* ssq_kv = ssq_q + MT;
            {
                pg8::Gemm g{H, (const bf16_t*)mb, MT, 512, DM, DM, DM}; pg8::StaticOrder S; S.init(MT, 512, G, bid);
                EpiLat E{LAT, ssq_q, ssq_kv, KPE, ROPE16, ssqn1, nbias1};
                pg8::gemm_phase<EpiLat, pg8::StaticOrder, true>(lds, g, S, E, wave);
            }
            GRID_BAR();
            {
                pg8::Gemm g{LAT, (const bf16_t*)(mb + 1 * MiB), MT, 1536, 256, 512, 256}; pg8::StaticOrder S; S.init(MT, 1536, G, bid);
                EpiProj<0> E{Qb, nullptr, nullptr, ROPE16, ssq_q, 0.10206207261596577f * LOG2E, nullptr};
                pg8::gemm_phase<EpiProj<0>, pg8::StaticOrder, true>(lds, g, S, E, wave);
            }
            {
                pg8::Gemm g{LAT + 256, (const bf16_t*)(mb + 1 * MiB + 768 * 1024), MT, 2048, 128, 512, 128}; pg8::StaticOrder S; S.init(MT, 2048, G, bid);
                EpiProj<1> E{nullptr, Kb, VTb, nullptr, ssq_kv, 1.f, nullptr};
                pg8::gemm_phase<EpiProj<1>, pg8::StaticOrder, true>(lds, g, S, E, wave);
            }
        } else if (kind == 1) {
            pg8::Gemm g{H, (const bf16_t*)(ws + WS_SWA), MT, 1536, DM, DM, DM}; pg8::StaticOrder S; S.init(MT, 1536, G, bid);
            EpiProj<2> E{Qb, Kb, VTb, ROPE32, ssqn1, 0.125f * LOG2E, nbias1};
            pg8::gemm_phase<EpiProj<2>, pg8::StaticOrder, true>(lds, g, S, E, wave);
        } else {
            pg8::Gemm g{H, (const bf16_t*)(ws + WS_NA), MT, 3072, DM, DM, DM}; pg8::StaticOrder S; S.init(MT, 3072, G, bid);
            EpiProj<3> E{Qb, Kb, VTb, nullptr, ssqn1, 0.125f * LOG2E, nbias1};
            pg8::gemm_phase<EpiProj<3>, pg8::StaticOrder, true>(lds, g, S, E, wave);
        }
        GRID_BAR();
        {
            AttnP P{Qb, Kb, KPE, VTb, Ob, a.in[18], a.in[21], last ? 4096 : 4096 + 128};
            if (kind == 0) attn_phase<0>(lds, P, vcu, G, wave);
            else if (kind == 1) attn_phase<1>(lds, P, vcu, G, wave);
            else attn_phase<2>(lds, P, vcu, G, wave);
        }
        GRID_BAR();
        const int Mres = last ? ML : MT;
        {
            const bf16_t* wo = (const bf16_t*)(kind == 0 ? ws + WS_MLA + (size_t)jl * 5 * MiB + 3 * MiB : (kind == 1 ? ws + WS_SWA + 3 * MiB : ws + WS_NA + 6 * MiB));
            pg8::Gemm g{Ob, wo, Mres, DM, DM, DM, DM}; pg8::StaticOrder S; S.init(Mres, DM, G, bid);
            EpiResid E{xl, xc, X, XC, modL + 2048, H, norm_mlp_g + L * DM, modL + 4096, SSQN + (size_t)(2 * L + 1) * MT};
            pg8::gemm_phase<EpiResid, pg8::StaticOrder, true>(lds, g, S, E, wave);
        }
        GRID_BAR();
        {
            pg8::Gemm g{H, (const bf16_t*)(ws + WS_W1T + (size_t)L * 8 * MiB), Mres, FF, DM, DM, DM}; pg8::StaticOrder S; S.init(Mres, FF, G, bid);
            EpiSqRelu E{HID, FF, SSQN + (size_t)(2 * L + 1) * MT, NBIAS + (size_t)(L * 2 + 1) * 9 * 4096};
            pg8::gemm_phase<EpiSqRelu, pg8::StaticOrder, true>(lds, g, S, E, wave);
        }
        GRID_BAR();
        {
            pg8::Gemm g{HID, (const bf16_t*)(ws + WS_W2T + (size_t)L * 8 * MiB), Mres, DM, FF, FF, FF}; pg8::StaticOrder S; S.init(Mres, DM, G, bid);
            EpiResid E{X, XC, X, XC, modL + 5120, last ? nullptr : H, norm_mix_g + (L + 1) * DM, MOD + (size_t)(L + 1) * 9 * 6144 + 1024, SSQN + (size_t)(2 * L + 2) * MT};
            pg8::gemm_phase<EpiResid, pg8::StaticOrder, true>(lds, g, S, E, wave);
        }
        GRID_BAR();
    }
    int lane = lane_id(); asm volatile("" : "+v"(lane));
    for (int row = gw; row < ML; row += NGW) {
        float* xr = X + (size_t)row * DM;
        f32x4 v[4]; float ss = 0.f;
#pragma unroll
        for (int j = 0; j < 4; ++j) { v[j] = *(const f32x4*)(xr + 4 * lane + 256 * j); ss += (v[j][0] * v[j][0] + v[j][1] * v[j][1]) + (v[j][2] * v[j][2] + v[j][3] * v[j][3]); }
        const float rstd = rsqrtf(wave_sum(ss, lane) * (1.f / DM) + EPS);
#pragma unroll
        for (int j = 0; j < 4; ++j) { const int col = 4 * lane + 256 * j; const f32x4 gg = *(const f32x4*)(norm_out_g + col); *(f32x4*)(xr + col) = v[j] * rstd * gg; }
    }
}

constexpr int LDS_BYTES = 147456;
extern "C" void kernel_launch(void* const* d_in, const int* in_sizes, int n_in, void* d_out, int out_size, void* d_ws, size_t ws_size, hipStream_t stream) {
    static int grid = 0;
    if (grid == 0) {
        if (n_in != 23 || out_size != ML * DM || ws_size < WS_END) { fprintf(stderr, "kernel_launch: unexpected shapes (n_in %d out %d ws %zu)\n", n_in, out_size, ws_size); grid = -1; return; }
        int dev = 0, cus = 0, per_cu = 0;
        hipGetDevice(&dev); hipDeviceGetAttribute(&cus, hipDeviceAttributeMultiprocessorCount, dev);
        if (hipFuncSetAttribute((const void*)fwd_megakernel, hipFuncAttributeMaxDynamicSharedMemorySize, LDS_BYTES) != hipSuccess) { fprintf(stderr, "kernel_launch: hipFuncSetAttribute failed\n"); grid = -1; return; }
        if (hipOccupancyMaxActiveBlocksPerMultiprocessor(&per_cu, (const void*)fwd_megakernel, 512, LDS_BYTES) != hipSuccess || per_cu < 1) { fprintf(stderr, "kernel_launch: occupancy query gave %d\n", per_cu); per_cu = 1; }
        (void)hipGetLastError();
        grid = cus * per_cu;
    }
    if (grid < 0) return;
    if (hipMemsetAsync((char*)d_ws + WS_BAR, 0, XCD_BAR_WORDS * 4, stream) != hipSuccess) { fprintf(stderr, "kernel_launch: memset of the barrier words failed\n"); return; }
    Args a{};
    for (int i = 0; i < 23; ++i) a.in[i] = (const float*)d_in[i];
    a.out = (float*)d_out; a.ws = (unsigned char*)d_ws;
    void* args[] = {&a};
    hipError_t e = hipLaunchCooperativeKernel((const void*)fwd_megakernel, dim3(grid), dim3(512), args, LDS_BYTES, stream);
    if (e != hipSuccess) fprintf(stderr, "cooperative launch failed: %s (grid %d)\n", hipGetErrorString(e), grid);
}
```

```cpp
#include <hip/hip_runtime.h>
#include <hip/hip_cooperative_groups.h>
#include <cstdio>
#include <cstdint>
namespace cg = cooperative_groups;

#define LAS __attribute__((address_space(3)))
typedef unsigned short bf16_t;
typedef short bf16x8 __attribute__((ext_vector_type(8)));
typedef float f32x4 __attribute__((ext_vector_type(4)));
typedef float f32x16 __attribute__((ext_vector_type(16)));
typedef unsigned u32x4 __attribute__((ext_vector_type(4)));
typedef unsigned u32x2 __attribute__((ext_vector_type(2)));

constexpr int NB = 8, SEQ = 8192, DM = 1024, CTX = 256, FF = 4096;
constexpr int ML = NB * SEQ;
constexpr int MC = NB * CTX;
constexpr int MT = ML + MC;
constexpr int KVLEN = CTX + SEQ;
constexpr float EPS = 1e-6f;
constexpr float LOG2E = 1.4426950408889634f;

__device__ __forceinline__ unsigned cvtpk(float lo, float hi) {
    typedef float f2 __attribute__((ext_vector_type(2))); typedef __bf16 b2 __attribute__((ext_vector_type(2)));
    f2 v = {lo, hi}; b2 b = __builtin_convertvector(v, b2); return __builtin_bit_cast(unsigned, b);
}
__device__ __forceinline__ int lane_id() { int l; asm volatile("v_mbcnt_lo_u32_b32 %0, -1, 0\n\tv_mbcnt_hi_u32_b32 %0, -1, %0" : "=v"(l)); return l; }
__device__ __forceinline__ float shfl_xor_l(float v, int mask, int lane) { return __int_as_float(__builtin_amdgcn_ds_bpermute((lane ^ mask) << 2, __float_as_int(v))); }
__device__ __forceinline__ int perm16(int x) { return 8 * ((x >> 2) & 1) + (x & 3) + 4 * (x >> 3); }

namespace pg8 {
constexpr int BM = 256, BK = 64, HALF = 128, HTB = HALF * BK * 2, STAGE_BYTES = 8 * HTB, NXCD = 8, WGM = 8;
__host__ __device__ __forceinline__ int lds_byte(int r, int c) { const int st = (r >> 4) * 2 + (c >> 5), rr = r & 15, cc = c & 31, ob = rr * 64 + cc * 2; return st * 1024 + (ob ^ (((ob >> 9) & 1) << 5)); }
__host__ __device__ __forceinline__ void stage_rc(int b, int& R, int& C) { const int st = b / 1024, sb = b % 1024, swz = sb ^ (((sb >> 9) & 1) << 5); R = (st >> 1) * 16 + swz / 64; C = (st & 1) * 32 + (swz % 64) / 2; }
__host__ __device__ __forceinline__ int perm32(int rho) { const int n = rho >> 4, i = rho & 15; return 8 * (i >> 2) + 4 * n + (i & 3); }

struct Unit { int pm, pn, koff; };
struct Gemm { const bf16_t* A; const bf16_t* Bt; int M, N, K, lda, ldb; };

struct StaticOrder {
    int nM, nN, nwg, G, c;
    __device__ void init(int M, int N, int G_, int c_) { nM = M / BM; nN = N / BM; nwg = nM * nN; G = G_; c = c_; }
    __device__ bool next(int i, Unit& u) const {
        const long L = (long)i * G + c; if (L >= nwg) return false;
        int wgid = (int)L; { const int q = nwg / NXCD, r = nwg % NXCD, xcd = wgid % NXCD, off = wgid / NXCD; wgid = (xcd < r ? xcd * (q + 1) : r * (q + 1) + (xcd - r) * q) + off; }
        const int nig = WGM * nN, gid = wgid / nig, fm = gid * WGM, gsz = (nM - fm) < WGM ? (nM - fm) : WGM;
        u.pm = fm + ((wgid % nig) % gsz); u.pn = (wgid % nig) / gsz; u.koff = 0; return true;
    }
};

struct CtxSplitOrder {
    int c, G, kchunk;
    __device__ bool next(int i, Unit& u) const { const int L = i * G + c; if (L >= 256) return false; u.pm = 256 + (L >> 5); u.pn = (L >> 3) & 3; u.koff = (L & 7) * kchunk; return true; }
};

template <class Epi, class Sched, bool ALIGN_EPI>
__device__ __forceinline__ void gemm_phase(LAS unsigned char* lds, const Gemm g, const Sched& S, const Epi& E, int wave_s) {
    int tid_l = wave_s * 64 + lane_id(); asm volatile("" : "+v"(tid_l));
    const int tid = tid_l, wid = __builtin_amdgcn_readfirstlane(tid >> 6), lane = tid & 63, wr = wid >> 2, wc = wid & 3, fr = lane & 15, fq = lane >> 4;
    const int K = g.K, nt = K / BK;
    unsigned voffA[2], voffB[2];
#pragma unroll
    for (int i = 0; i < 2; ++i) { int R, C; stage_rc(tid * 16 + i * 8192, R, C); const int Rb = Epi::PERM ? ((R & ~31) + perm32(R & 31)) : R;
        voffA[i] = (unsigned)(R * g.lda + C) * 2u; voffB[i] = (unsigned)(Rb * g.ldb + C) * 2u; }
    const size_t kstep = (size_t)(BK * 2);
    const size_t hstepA = (size_t)HALF * g.lda * 2, hstepB = (size_t)HALF * g.ldb * 2;
    const size_t tstepA = 2 * hstepA, tstepB = 2 * hstepB;
    const unsigned ldsw = (unsigned)wid * 1024u;
    const int aoff = lds_byte(wr * 64 + fr, fq * 8), boff = lds_byte(wc * 32 + fr, fq * 8);
#define PG8_SA(b, h) (((b) * 2 + (h)) * HTB)
#define PG8_SB(b, h) ((4 + (b) * 2 + (h)) * HTB)
#define PG8_STAGE(bufoff, gbase, voff) do { _Pragma("unroll") for (int _i = 0; _i < 2; ++_i) \
        __builtin_amdgcn_global_load_lds((const unsigned*)((const char*)(gbase) + (voff)[_i]), (LAS unsigned*)(lds + (bufoff) + ldsw + _i * 8192), 16, 0, 0); } while (0)
#define PG8_LDA(dst, b, h) do { _Pragma("unroll") for (int m = 0; m < 4; ++m) _Pragma("unroll") for (int k = 0; k < 2; ++k) dst[m][k] = *(const LAS bf16x8*)(lds + PG8_SA(b, h) + aoff + m * 2048 + k * 1024); } while (0)
#define PG8_LDB(dst, b, h) do { _Pragma("unroll") for (int n = 0; n < 2; ++n) _Pragma("unroll") for (int k = 0; k < 2; ++k) dst[n][k] = *(const LAS bf16x8*)(lds + PG8_SB(b, h) + boff + n * 2048 + k * 1024); } while (0)
#define PG8_MMA(ai, bj, At, Bt) do { __builtin_amdgcn_s_setprio(1); _Pragma("unroll") for (int m = 0; m < 4; ++m) _Pragma("unroll") for (int n = 0; n < 2; ++n) _Pragma("unroll") for (int k = 0; k < 2; ++k) \
        acc[ai][bj][m][n] = __builtin_amdgcn_mfma_f32_16x16x32_bf16(Bt[n][k], At[m][k], acc[ai][bj][m][n], 0, 0, 0); __builtin_amdgcn_s_setprio(0); } while (0)
#define PG8_WAIT_V(n) asm volatile("s_waitcnt vmcnt(" #n ")" ::: "memory")
#define PG8_WAIT_L(n) asm volatile("s_waitcnt lgkmcnt(" #n ")" ::: "memory")
#define PG8_BAR __builtin_amdgcn_s_barrier()
#define PG8_SCHED __builtin_amdgcn_sched_barrier(0)
    Unit cur, nxt; int ui = 0;
    if (!S.next(0, cur)) return;
    f32x4 acc[2][2][4][2];
#pragma unroll
    for (int a = 0; a < 2; ++a)
#pragma unroll
        for (int b = 0; b < 2; ++b)
#pragma unroll
            for (int m = 0; m < 4; ++m)
#pragma unroll
                for (int n = 0; n < 2; ++n) acc[a][b][m][n] = (f32x4){0.f, 0.f, 0.f, 0.f};
    bf16x8 At[4][2], B0[2][2], B1[2][2];
    const char* cA = (const char*)g.A + (size_t)cur.pm * tstepA + (size_t)cur.koff * 2; const char* cB = (const char*)g.Bt + (size_t)cur.pn * tstepB + (size_t)cur.koff * 2;
    PG8_STAGE(PG8_SB(0, 0), cB, voffB); PG8_STAGE(PG8_SB(0, 1), cB + hstepB, voffB); PG8_STAGE(PG8_SA(0, 0), cA, voffA); PG8_STAGE(PG8_SA(0, 1), cA + hstepA, voffA);
    if (wr == 1) PG8_BAR;
    PG8_WAIT_V(2); PG8_BAR;
    PG8_STAGE(PG8_SB(1, 0), cB + kstep, voffB); PG8_STAGE(PG8_SA(1, 0), cA + kstep, voffA); PG8_STAGE(PG8_SB(1, 1), cB + hstepB + kstep, voffB);
    PG8_WAIT_V(6); PG8_BAR;
    for (;;) {
        const bool has_next = S.next(ui + 1, nxt);
        const char* nA = has_next ? (const char*)g.A + (size_t)nxt.pm * tstepA + (size_t)nxt.koff * 2 : cA; const char* nB = has_next ? (const char*)g.Bt + (size_t)nxt.pn * tstepB + (size_t)nxt.koff * 2 : cB;
        for (int t = 0; t < nt; t += 2) {
            const bool last = (t == nt - 2);
            const char* a1 = cA + (size_t)(t + 1) * kstep;
            const char* a2 = last ? nA : cA + (size_t)(t + 2) * kstep; const char* b2 = last ? nB : cB + (size_t)(t + 2) * kstep;
            const char* a3 = a2 + kstep; const char* b3 = b2 + kstep;
            PG8_LDB(B0, 0, 0); PG8_LDB(B1, 0, 1); PG8_SCHED; PG8_LDA(At, 0, 0); PG8_STAGE(PG8_SA(1, 1), a1 + hstepA, voffA);
            PG8_WAIT_V(8); PG8_WAIT_L(0); PG8_BAR; PG8_MMA(0, 0, At, B0); PG8_MMA(0, 1, At, B1); PG8_BAR; PG8_SCHED;
            PG8_LDA(At, 0, 1); PG8_STAGE(PG8_SB(0, 0), b2, voffB); PG8_STAGE(PG8_SB(0, 1), b2 + hstepB, voffB); PG8_STAGE(PG8_SA(0, 0), a2, voffA);
            PG8_WAIT_V(8); PG8_WAIT_L(0); PG8_BAR; PG8_MMA(1, 0, At, B0); PG8_MMA(1, 1, At, B1); PG8_BAR; PG8_SCHED;
            PG8_LDB(B0, 1, 0); PG8_LDB(B1, 1, 1); PG8_SCHED; PG8_LDA(At, 1, 0); PG8_STAGE(PG8_SA(0, 1), a2 + hstepA, voffA);
            PG8_WAIT_V(8); PG8_WAIT_L(0); PG8_BAR; PG8_MMA(0, 0, At, B0); PG8_MMA(0, 1, At, B1); PG8_BAR; PG8_SCHED;
            PG8_LDA(At, 1, 1); PG8_STAGE(PG8_SB(1, 0), b3, voffB); PG8_STAGE(PG8_SB(1, 1), b3 + hstepB, voffB); PG8_STAGE(PG8_SA(1, 0), a3, voffA);
            PG8_WAIT_V(8); PG8_WAIT_L(0); PG8_BAR; PG8_MMA(1, 0, At, B0); PG8_MMA(1, 1, At, B1); PG8_BAR; PG8_SCHED;
        }
        if constexpr (ALIGN_EPI) { if (wr == 0) PG8_BAR; }
        E(acc, cur, wr, wc, fr, fq);
        if (!has_next) break;
#pragma unroll
        for (int a = 0; a < 2; ++a)
#pragma unroll
            for (int b = 0; b < 2; ++b)
#pragma unroll
                for (int m = 0; m < 4; ++m)
#pragma unroll
                    for (int n = 0; n < 2; ++n) acc[a][b][m][n] = (f32x4){0.f, 0.f, 0.f, 0.f};
        cur = nxt; cA = nA; cB = nB; ++ui;
        if constexpr (ALIGN_EPI) { if (wr == 1) PG8_BAR; }
    }
    PG8_WAIT_V(0);
    if constexpr (!ALIGN_EPI) { if (wr == 0) PG8_BAR; }
    PG8_BAR;
#undef PG8_SA
#undef PG8_SB
#undef PG8_STAGE
#undef PG8_LDA
#undef PG8_LDB
#undef PG8_MMA
#undef PG8_WAIT_V
#undef PG8_WAIT_L
#undef PG8_BAR
#undef PG8_SCHED
}
}

typedef const f32x4 (&AccRef)[2][2][4][2];

__device__ __forceinline__ void rope8(float (&v)[8], const float* tab) {
    const f32x4 t0 = *(const f32x4*)tab, t1 = *(const f32x4*)(tab + 4);
    float x1, x2;
    x1 = v[0]; x2 = v[1]; v[0] = x1 * t0[0] - x2 * t0[1]; v[1] = x1 * t0[1] + x2 * t0[0];
    x1 = v[2]; x2 = v[3]; v[2] = x1 * t0[2] - x2 * t0[3]; v[3] = x1 * t0[3] + x2 * t0[2];
    x1 = v[4]; x2 = v[5]; v[4] = x1 * t1[0] - x2 * t1[1]; v[5] = x1 * t1[1] + x2 * t1[0];
    x1 = v[6]; x2 = v[7]; v[6] = x1 * t1[2] - x2 * t1[3]; v[7] = x1 * t1[3] + x2 * t1[2];
}
__device__ __forceinline__ u32x4 pack8(const float (&v)[8]) { u32x4 w; w.x = cvtpk(v[0], v[1]); w.y = cvtpk(v[2], v[3]); w.z = cvtpk(v[4], v[5]); w.w = cvtpk(v[6], v[7]); return w; }

template <int MODE> struct EpiProj {
    static constexpr bool PERM = true;
    bf16_t* Q; bf16_t* K; bf16_t* VT; const float* rope; const float* ssq; float qscale; const float* nbias;
    __device__ __forceinline__ void operator()(AccRef acc, const pg8::Unit& u, int wr, int wc, int fr_, int fq_) const {
        int lane_e = lane_id(); asm volatile("" : "+v"(lane_e)); const int fr = lane_e & 15, fq = lane_e >> 4; (void)fr_; (void)fq_;
        constexpr int LDQ = (MODE == 0) ? 1536 : 1024, NQ = (MODE == 0) ? 1536 : (MODE == 1 ? 0 : 1024);
        constexpr int LDK = (MODE == 2) ? 256 : 1024, NK = LDK, VCOLS = LDK;
#pragma unroll
        for (int ai = 0; ai < 2; ++ai)
#pragma unroll
            for (int m = 0; m < 4; ++m) {
                const int row = u.pm * 256 + ai * 128 + wr * 64 + m * 16 + fr;
                const bool isctx = row >= ML; const int rc = row - ML;
                const int b = isctx ? (rc >> 8) : (row >> 13);
                const int tok = row & 8191;
                const int kpos = isctx ? (rc & 255) : 256 + tok;
                const size_t kvrow = (size_t)b * KVLEN + kpos;
                const int vpos = (kpos & ~15) | perm16(kpos & 15);
                const float rs = rsqrtf(ssq[row] * (MODE == 0 ? 1.f / 256.f : (MODE == 1 ? 1.f / 128.f : 1.f / 1024.f)) + EPS);
                const float* nb = nbias + (isctx ? 8 : b) * 4096;
#pragma unroll
                for (int bj = 0; bj < 2; ++bj) {
                    const int col = u.pn * 256 + bj * 128 + wc * 32 + 8 * fq;
                    float v[8];
#pragma unroll
                    for (int j = 0; j < 4; ++j) { v[j] = acc[ai][bj][m][0][j] * rs; v[4 + j] = acc[ai][bj][m][1][j] * rs; }
                    if (MODE >= 2) { const f32x4 b0 = *(const f32x4*)(nb + col), b1 = *(const f32x4*)(nb + col + 4);
#pragma unroll
                        for (int j = 0; j < 4; ++j) { v[j] += b0[j]; v[4 + j] += b1[j]; } }
                    if (MODE == 2) { if (!isctx && col < 1280) rope8(v, rope + ((size_t)tok * 32 + ((col & 63) >> 1)) * 2); }
                    if (MODE == 0) { const int c96 = col % 96; if (!isctx && c96 >= 64) rope8(v, rope + ((size_t)tok * 16 + ((c96 - 64) >> 1)) * 2); }
                    bool isv; int kc;
                    if (MODE == 1) { const int within = col & 127; isv = within >= 64; kc = (col >> 7) * 64 + (within & 63); }
                    else { isv = col >= NQ + NK; kc = isv ? col - NQ - NK : col - NQ; }
                    if (MODE != 1 && col < NQ) {
#pragma unroll
                        for (int j = 0; j < 8; ++j) v[j] *= qscale;
                        *(u32x4*)(Q + (size_t)row * LDQ + col) = pack8(v);
                    } else if (MODE != 0 && !isv) {
                        *(u32x4*)(K + kvrow * LDK + kc) = pack8(v);
                    } else if (MODE != 0) {
                        bf16_t* vp = VT + ((size_t)(b * VCOLS + kc)) * KVLEN + vpos;
#pragma unroll
                        for (int j = 0; j < 8; ++j) vp[(size_t)j * KVLEN] = (bf16_t)(cvtpk(v[j], 0.f) & 0xffffu);
                    }
                }
            }
    }
};

struct EpiLat {
    static constexpr bool PERM = true;
    bf16_t* lat; float* ssq_q; float* ssq_kv; bf16_t* KPE; const float* rope; const float* ssqn; const float* nbias;
    __device__ __forceinline__ void operator()(AccRef acc, const pg8::Unit& u, int wr, int wc, int fr_, int fq_) const {
        int lane_e = lane_id(); asm volatile("" : "+v"(lane_e)); const int fr = lane_e & 15, fq = lane_e >> 4; (void)fr_; (void)fq_;
#pragma unroll
        for (int ai = 0; ai < 2; ++ai)
#pragma unroll
            for (int m = 0; m < 4; ++m) {
                const int row = u.pm * 256 + ai * 128 + wr * 64 + m * 16 + fr;
                const bool isctx = row >= ML; const int rc = row - ML;
                const int b = isctx ? (rc >> 8) : (row >> 13);
                const int tok = row & 8191;
                const int kpos = isctx ? (rc & 255) : 256 + tok;
                const size_t kvrow = (size_t)b * KVLEN + kpos;
                const float rs = rsqrtf(ssqn[row] * (1.f / 1024.f) + EPS); const float* nb = nbias + (isctx ? 8 : b) * 4096;
                float ss = 0.f;
#pragma unroll
                for (int bj = 0; bj < 2; ++bj) {
                    const int col = u.pn * 256 + bj * 128 + wc * 32 + 8 * fq;
                    float v[8];
#pragma unroll
                    for (int j = 0; j < 4; ++j) { v[j] = acc[ai][bj][m][0][j] * rs; v[4 + j] = acc[ai][bj][m][1][j] * rs; }
                    { const f32x4 b0 = *(const f32x4*)(nb + col), b1 = *(const f32x4*)(nb + col + 4);
#pragma unroll
                      for (int j = 0; j < 4; ++j) { v[j] += b0[j]; v[4 + j] += b1[j]; } }
                    if (col < 384) {
#pragma unroll
                        for (int j = 0; j < 8; ++j) ss += v[j] * v[j];
                        *(u32x4*)(lat + (size_t)row * 512 + col) = pack8(v);
                    } else if (col < 416) {
                        if (!isctx) rope8(v, rope + ((size_t)tok * 16 + ((col - 384) >> 1)) * 2);
                        *(u32x4*)(KPE + kvrow * 32 + (col - 384)) = pack8(v);
                    }
                }
                ss += shfl_xor_l(ss, 16, lane_e); ss += shfl_xor_l(ss, 32, lane_e);
                if (fq == 0 && (u.pn == 0 || wc < 4)) unsafeAtomicAdd((u.pn == 0 ? ssq_q : ssq_kv) + row, ss);
            }
    }
};

struct EpiResid {
    static constexpr bool PERM = false;
    const float* xin_l; const float* xin_c; float* xout_l; float* xout_c; const float* gate;
    bf16_t* xa; const float* gn; const float* scn; float* ssqn;
    __device__ __forceinline__ void operator()(AccRef acc, const pg8::Unit& u, int wr, int wc, int fr_, int fq_) const {
        int lane_e = lane_id(); asm volatile("" : "+v"(lane_e)); const int fr = lane_e & 15, fq = lane_e >> 4; (void)fr_; (void)fq_;
#pragma unroll
        for (int ai = 0; ai < 2; ++ai)
#pragma unroll
            for (int m = 0; m < 4; ++m) {
                const int row = u.pm * 256 + ai * 128 + wr * 64 + m * 16 + fr;
                const bool isctx = row >= ML;
                const float* xi = isctx ? xin_c + (size_t)(row - ML) * DM : xin_l + (size_t)row * DM;
                float* xo = isctx ? xout_c + (size_t)(row - ML) * DM : xout_l + (size_t)row * DM;
                const int bsel = isctx ? 8 : (row >> 13);
                const float* gp = gate + bsel * 6144;
                float ss = 0.f;
#pragma unroll
                for (int bj = 0; bj < 2; ++bj)
#pragma unroll
                    for (int n = 0; n < 2; ++n) {
                        const int col = u.pn * 256 + bj * 128 + wc * 32 + 16 * n + 4 * fq;
                        const f32x4 x = *(const f32x4*)(xi + col), gv = *(const f32x4*)(gp + col);
                        const f32x4 y = x + gv * acc[ai][bj][m][n];
                        *(f32x4*)(xo + col) = y;
                        if (xa) { const f32x4 g4 = *(const f32x4*)(gn + col), s4 = *(const f32x4*)(scn + bsel * 6144 + col); const f32x4 z = y * g4 * (s4 + 1.f);
                            ss += (y[0] * y[0] + y[1] * y[1]) + (y[2] * y[2] + y[3] * y[3]);
                            u32x2 o; o.x = cvtpk(z[0], z[1]); o.y = cvtpk(z[2], z[3]); *(u32x2*)(xa + (size_t)row * DM + col) = o; }
                    }
                if (xa) { ss += shfl_xor_l(ss, 16, lane_e); ss += shfl_xor_l(ss, 32, lane_e); if (fq == 0) unsafeAtomicAdd(ssqn + row, ss); }
            }
    }
};

struct EpiCtxPartial {
    static constexpr bool PERM = false;
    float* part; int kchunk;
    __device__ __forceinline__ void operator()(AccRef acc, const pg8::Unit& u, int wr, int wc, int fr_, int fq_) const {
        int lane_e = lane_id(); asm volatile("" : "+v"(lane_e)); const int fr = lane_e & 15, fq = lane_e >> 4; (void)fr_; (void)fq_;
        float* pb = part + (size_t)(u.koff / kchunk) * MC * DM;
#pragma unroll
        for (int ai = 0; ai < 2; ++ai)
#pragma unroll
            for (int m = 0; m < 4; ++m) {
                const int row = u.pm * 256 + ai * 128 + wr * 64 + m * 16 + fr - ML;
                float* xr = pb + (size_t)row * DM;
#pragma unroll
                for (int bj = 0; bj < 2; ++bj)
#pragma unroll
                    for (int n = 0; n < 2; ++n) {
                        const int col = u.pn * 256 + bj * 128 + wc * 32 + 16 * n + 4 * fq;
                        *(f32x4*)(xr + col) = acc[ai][bj][m][n];
                    }
            }
    }
};

struct EpiSqRelu {
    static constexpr bool PERM = true;
    bf16_t* O; int ldc; const float* ssqn; const float* nbias;
    __device__ __forceinline__ void operator()(AccRef acc, const pg8::Unit& u, int wr, int wc, int fr_, int fq_) const {
        int lane_e = lane_id(); asm volatile("" : "+v"(lane_e)); const int fr = lane_e & 15, fq = lane_e >> 4; (void)fr_; (void)fq_;
#pragma unroll
        for (int ai = 0; ai < 2; ++ai)
#pragma unroll
            for (int m = 0; m < 4; ++m) {
                const int row = u.pm * 256 + ai * 128 + wr * 64 + m * 16 + fr;
                const float rs = rsqrtf(ssqn[row] * (1.f / 1024.f) + EPS); const float* nb = nbias + (row >= ML ? 8 : (row >> 13)) * 4096;
#pragma unroll
                for (int bj = 0; bj < 2; ++bj) {
                    const int col = u.pn * 256 + bj * 128 + wc * 32 + 8 * fq;
                    const f32x4 b0 = *(const f32x4*)(nb + col), b1 = *(const f32x4*)(nb + col + 4);
                    float v[8];
#pragma unroll
                    for (int j = 0; j < 4; ++j) { float a = fmaxf(acc[ai][bj][m][0][j] * rs + b0[j], 0.f), c = fmaxf(acc[ai][bj][m][1][j] * rs + b1[j], 0.f); v[j] = a * a; v[4 + j] = c * c; }
                    *(u32x4*)(O + (size_t)row * ldc + col) = pack8(v);
                }
            }
    }
};

constexpr int KP = 208, VP = 144;
constexpr int KT_BYTES = 64 * KP, VT_BYTES = 64 * VP, ABUF = KT_BYTES + VT_BYTES;
constexpr int ATT_BIAS_OFF = 2 * ABUF;
struct AttnP { const bf16_t* Q; const bf16_t* K; const bf16_t* KPE; const bf16_t* VT; bf16_t* O; const float* sink; const float* bias; int nunits; };

__device__ __forceinline__ float rowmax32(const f32x16& a, const f32x16& b) {
    float x = __builtin_fmaxf(__builtin_fmaxf(a[0], a[1]), b[0]), y = __builtin_fmaxf(__builtin_fmaxf(a[2], a[3]), b[1]); x = __builtin_fmaxf(__builtin_fmaxf(x, b[2]), b[3]);
#pragma unroll
    for (int r = 4; r < 16; r += 4) { x = __builtin_fmaxf(__builtin_fmaxf(x, a[r]), a[r + 1]); y = __builtin_fmaxf(__builtin_fmaxf(y, a[r + 2]), a[r + 3]); x = __builtin_fmaxf(__builtin_fmaxf(x, b[r]), b[r + 1]); y = __builtin_fmaxf(__builtin_fmaxf(y, b[r + 2]), b[r + 3]); }
    const float m = __builtin_fmaxf(x, y);
    auto rr = __builtin_amdgcn_permlane32_swap(__float_as_uint(m), __float_as_uint(m), false, false);
    return __builtin_fmaxf(__uint_as_float(rr[0]), __uint_as_float(rr[1]));
}

template <int VAR>
__device__ __forceinline__ void attn_phase(LAS unsigned char* lds, const AttnP P, int vcu, int G, int wave_s) {
    constexpr int ND0 = (VAR == 0) ? 6 : 4;
    constexpr int QPITCH = (VAR == 0) ? 1536 : 1024, QH = (VAR == 0) ? 96 : 64;
    constexpr int KPITCH = (VAR == 1) ? 256 : 1024, VCOLS = (VAR == 1) ? 256 : 1024;
    constexpr bool USE_NEGM = (VAR != 2);
    constexpr float THR = 8.f;
    int tid_l = wave_s * 64 + lane_id(); asm volatile("" : "+v"(tid_l));
    const int tid = tid_l, lane = tid & 63, r32 = lane & 31, hi = lane >> 5;
    const int w = __builtin_amdgcn_readfirstlane(tid >> 6);
    LAS float* bias_lds = (LAS float*)(lds + ATT_BIAS_OFF);
    for (int it = 0;; ++it) {
        int u;
        if (VAR == 0 && G == 256) { u = (it < 16) ? ((it * 8 + (vcu >> 5)) * 32 + (vcu & 31)) : (4096 + (it - 16) * 256 + vcu); }
        else u = it * G + vcu;
        if (u >= P.nunits) break;
        const bool isctx = u >= 4096;
        int b, hq, hk, qrow, nt; int p_a = 0, p_b = 0;
        if (VAR == 0) {
            if (!isctx) { const int bh = u >> 5, qb = u & 31; b = bh >> 4; hq = bh & 15; qrow = b * SEQ + qb * 256 + 32 * w; nt = 132; }
            else { const int cu = u - 4096; b = cu >> 4; hq = cu & 15; qrow = ML + b * 256 + 32 * w; nt = 4; }
            hk = hq;
        } else if (VAR == 1) {
            if (!isctx) { const int blk = u & 63, hp = (u >> 6) & 7; b = u >> 9; hq = 2 * hp + (w >> 2); hk = hp >> 1; qrow = b * SEQ + blk * 128 + 32 * (w & 3);
                          const int jlo = blk == 0 ? 2 : 0, jhi = blk == 63 ? 4 : 6; nt = 4 + jhi - jlo; p_a = blk * 128 - 128 + 64 * jlo; p_b = blk * 128 + 32 * (w & 3); }
            else { const int cu = u - 4096, half = cu & 1, hp = (cu >> 1) & 7; b = cu >> 4; hq = 2 * hp + (w >> 2); hk = hp >> 1; qrow = ML + b * 256 + half * 128 + 32 * (w & 3); nt = 4; }
        } else {
            if (!isctx) { const int rq = u & 31; hq = (u >> 5) & 15; b = u >> 9; const int r0 = 4 * rq; qrow = b * SEQ + (r0 + (w >> 1)) * 64 + 32 * (w & 1);
                          int lo = r0 - 4; lo = lo < 0 ? 0 : (lo > 120 ? 120 : lo); int h2 = r0 - 1; h2 = h2 < 0 ? 0 : (h2 > 120 ? 120 : h2); nt = 4 + (h2 + 8 - lo); p_a = lo; p_b = r0 + (w >> 1); }
            else { const int cu = u - 4096; b = cu >> 4; hq = cu & 15; qrow = ML + b * 256 + 32 * w; nt = 4; }
            hk = hq;
        }
        if (VAR == 2 && !isctx) { if (tid < 465) bias_lds[tid] = P.bias[hq * 465 + tid] * LOG2E; }
        bf16x8 qf[ND0];
        { const bf16_t* qp = P.Q + (size_t)(qrow + r32) * QPITCH + hq * QH + hi * 8;
#pragma unroll
          for (int d0 = 0; d0 < ND0; ++d0) qf[d0] = *(const bf16x8*)(qp + d0 * 16); }
        f32x16 o0 = {}, o1 = {};
        const unsigned koff = (unsigned)(((b * KVLEN + (tid >> 3)) * KPITCH + hk * 64 + (tid & 7) * 8) * 2);
        const unsigned peoff = (unsigned)(((b * KVLEN + (tid >> 2)) * 32 + (tid & 3) * 8) * 2);
        const unsigned voff = (unsigned)(((b * VCOLS + hk * 64 + (tid >> 3)) * KVLEN + (tid & 7) * 8) * 2);
        u32x4 kreg, pereg = {}, vreg;
#define TILE_KPOS(t) (VAR == 0 ? 64 * (((t) + rot >= nt) ? (t) + rot - nt : (t) + rot) : ((t) < 4 ? 64 * (t) : (VAR == 1 ? 256 + p_a + 64 * ((t) - 4) : 256 + 64 * (p_a + (t) - 4))))
#define LOADK(t) do { const int kp_ = TILE_KPOS(t); kreg = *(const u32x4*)((const char*)P.K + (size_t)(koff + (unsigned)(kp_ * KPITCH * 2))); if (VAR == 0 && tid < 256) pereg = *(const u32x4*)((const char*)P.KPE + (size_t)(peoff + (unsigned)(kp_ * 64))); } while (0)
#define LOADV(t) do { const int kp_ = TILE_KPOS(t); vreg = *(const u32x4*)((const char*)P.VT + (size_t)(voff + (unsigned)(kp_ * 2))); } while (0)
#define STOREK(buf) do { LAS unsigned char* kb_ = lds + (buf) * ABUF; *(LAS u32x4*)(kb_ + (tid >> 3) * KP + (tid & 7) * 16) = kreg; \
        if (VAR == 0 && tid < 256) *(LAS u32x4*)(kb_ + (tid >> 2) * KP + 128 + (tid & 3) * 16) = pereg; } while (0)
#define STOREV(buf) do { *(LAS u32x4*)(lds + (buf) * ABUF + KT_BYTES + (tid >> 3) * VP + (tid & 7) * 16) = vreg; } while (0)
#define NEED(t) (((t) < 4) ? true : (VAR == 1 ? ((p_a + 64 * ((t) - 4) + 63 >= p_b - 128) && (p_a + 64 * ((t) - 4) <= p_b + 31 + 128)) : (VAR == 2 ? ((p_a + (t) - 4 >= na_rs) && (p_a + (t) - 4 < na_rs + 8)) : true)))
#define QK_TILE(P0, P1, buf, CINIT) do { const LAS unsigned char* kt_ = lds + (buf) * ABUF; P0 = (CINIT); P1 = (CINIT); \
        _Pragma("unroll") for (int d0 = 0; d0 < ND0; ++d0) { \
            const bf16x8 k0_ = *(const LAS bf16x8*)(kt_ + r32 * KP + d0 * 32 + hi * 16); const bf16x8 k1_ = *(const LAS bf16x8*)(kt_ + (32 + r32) * KP + d0 * 32 + hi * 16); \
            P0 = __builtin_amdgcn_mfma_f32_32x32x16_bf16(k0_, qf[d0], P0, 0, 0, 0); P1 = __builtin_amdgcn_mfma_f32_32x32x16_bf16(k1_, qf[d0], P1, 0, 0, 0); } } while (0)
#define MASK_TILE(P0, P1, t) do { \
        if (VAR == 1 && (t) >= 4) { const int d0_ = p_a + 64 * ((t) - 4) - (p_b + r32) + 4 * hi + 128; \
            _Pragma("unroll") for (int r = 0; r < 16; ++r) { const int dd = d0_ + (r & 3) + 8 * (r >> 2); if ((unsigned)dd > 256u) P0[r] = -1e30f; if ((unsigned)(dd + 32) > 256u) P1[r] = -1e30f; } } \
        if (VAR == 2 && (t) >= 4) { int c = (qrow & 63) + r32; asm volatile("" : "+v"(c)); const int kr = p_a + (t) - 4; int cs = c - 8; cs = cs < 0 ? 0 : (cs > 48 ? 48 : cs); const LAS float* brow = bias_lds + (kr - p_b + 7) * 31; \
            _Pragma("unroll") for (int r = 0; r < 16; ++r) { const int kc = 4 * hi + (r & 3) + 8 * (r >> 2); \
                { int bi = kc - c + 15; bi = bi < 0 ? 0 : (bi > 30 ? 30 : bi); P0[r] = ((unsigned)(kc - cs) < 16u) ? P0[r] + brow[bi] : -1e30f; } \
                { int bi = kc + 32 - c + 15; bi = bi < 0 ? 0 : (bi > 30 ? 30 : bi); P1[r] = ((unsigned)(kc + 32 - cs) < 16u) ? P1[r] + brow[bi] : -1e30f; } } } } while (0)
        const int rot = (VAR == 0 && !isctx) ? ((vcu & 31) * 4 + (vcu >> 5)) % 132 : 0;
        int na_rs = 0; if (VAR == 2) { na_rs = p_b - 4; na_rs = na_rs < 0 ? 0 : (na_rs > 120 ? 120 : na_rs); }
        LOADK(0); LOADV(0); STOREK(0); STOREV(0);
        if (nt > 1) { LOADK(1); STOREK(1); }
        __syncthreads();
        f32x16 pc0, pc1; const f32x16 zero16 = {};
        QK_TILE(pc0, pc1, 0, zero16);
        float mref = rowmax32(pc0, pc1), lrun = 0.f;
        if (VAR == 1) { const float sk = P.sink[hq] * LOG2E; mref = __builtin_fmaxf(mref, sk); lrun = (hi == 0) ? __builtin_amdgcn_exp2f(sk - mref) : 0.f; }
        f32x16 negm = {};
        if (USE_NEGM) {
#pragma unroll
            for (int r = 0; r < 16; ++r) { pc0[r] -= mref; pc1[r] -= mref; negm[r] = -mref; }
        }
        float rmc = 0.f;
        bool need_c = true;
        __syncthreads();
        for (int t = 0; t < nt; ++t) {
            const bool hn = (t + 1 < nt);
            if (hn) { const int t2 = (t + 2 < nt) ? t + 2 : nt - 1; LOADK(t2); LOADV(t + 1); }
            const bool need_n = hn && NEED(t + 1);
            if (need_c && __any(rmc > THR)) {
                const float dl = __builtin_fmaxf(rmc, 0.f), f = __builtin_amdgcn_exp2f(-dl);
                mref += dl; lrun *= f;
#pragma unroll
                for (int r = 0; r < 16; ++r) { if (USE_NEGM) { pc0[r] -= dl; pc1[r] -= dl; negm[r] = -mref; } o0[r] *= f; o1[r] *= f; }
            }
            f32x16 pn0 = {}, pn1 = {};
            float rmn = -1e30f;
            if (VAR != 2 && need_c && need_n) {
                const LAS unsigned char* kt_ = lds + ((t + 1) & 1) * ABUF; const LAS unsigned char* vt_ = lds + (t & 1) * ABUF + KT_BYTES;
                bf16x8 kf[2 * ND0], vf[8]; u32x4 w0, w1, w2, w3; float sacc = 0.f;
#define KRD(d0) do { kf[2 * (d0)] = *(const LAS bf16x8*)(kt_ + r32 * KP + (d0) * 32 + hi * 16); kf[2 * (d0) + 1] = *(const LAS bf16x8*)(kt_ + (32 + r32) * KP + (d0) * 32 + hi * 16); } while (0)
#define VRD(kk) do { vf[2 * (kk)] = *(const LAS bf16x8*)(vt_ + r32 * VP + (kk) * 32 + hi * 16); vf[2 * (kk) + 1] = *(const LAS bf16x8*)(vt_ + (32 + r32) * VP + (kk) * 32 + hi * 16); } while (0)
#define EX4(Pv, a, W, lo) do { if (!USE_NEGM) { Pv[a] -= mref; Pv[a + 1] -= mref; Pv[a + 2] -= mref; Pv[a + 3] -= mref; } Pv[a] = __builtin_amdgcn_exp2f(Pv[a]); Pv[a + 1] = __builtin_amdgcn_exp2f(Pv[a + 1]); Pv[a + 2] = __builtin_amdgcn_exp2f(Pv[a + 2]); Pv[a + 3] = __builtin_amdgcn_exp2f(Pv[a + 3]); \
        sacc += Pv[a]; sacc += Pv[a + 1]; sacc += Pv[a + 2]; sacc += Pv[a + 3]; if (lo) { W.x = cvtpk(Pv[a], Pv[a + 1]); W.y = cvtpk(Pv[a + 2], Pv[a + 3]); } else { W.z = cvtpk(Pv[a], Pv[a + 1]); W.w = cvtpk(Pv[a + 2], Pv[a + 3]); } } while (0)
#define SB() __builtin_amdgcn_sched_barrier(0)
#define QKP(d0, C0, C1) do { pn0 = __builtin_amdgcn_mfma_f32_32x32x16_bf16(kf[2 * (d0)], qf[d0], C0, 0, 0, 0); pn1 = __builtin_amdgcn_mfma_f32_32x32x16_bf16(kf[2 * (d0) + 1], qf[d0], C1, 0, 0, 0); } while (0)
#define PVP(kk, W) do { const bf16x8 pb_ = __builtin_bit_cast(bf16x8, W); o0 = __builtin_amdgcn_mfma_f32_32x32x16_bf16(vf[2 * (kk)], pb_, o0, 0, 0, 0); o1 = __builtin_amdgcn_mfma_f32_32x32x16_bf16(vf[2 * (kk) + 1], pb_, o1, 0, 0, 0); } while (0)
#define KR1(j) (kf[j] = *(const LAS bf16x8*)(kt_ + (32 * ((j) & 1) + r32) * KP + ((j) >> 1) * 32 + hi * 16))
#define VR1(i) (vf[i] = *(const LAS bf16x8*)(vt_ + (32 * ((i) & 1) + r32) * VP + ((i) >> 1) * 32 + hi * 16))
#define EX2(Pv, a, Wd) do { Pv[a] = __builtin_amdgcn_exp2f(Pv[a]); Pv[a + 1] = __builtin_amdgcn_exp2f(Pv[a + 1]); sacc += Pv[a]; sacc += Pv[a + 1]; Wd = cvtpk(Pv[a], Pv[a + 1]); } while (0)
#define QK1(j, C) do { if ((j) & 1) pn1 = __builtin_amdgcn_mfma_f32_32x32x16_bf16(kf[j], qf[(j) >> 1], C, 0, 0, 0); else pn0 = __builtin_amdgcn_mfma_f32_32x32x16_bf16(kf[j], qf[(j) >> 1], C, 0, 0, 0); } while (0)
#define PV1(i, W) do { const bf16x8 pb_ = __builtin_bit_cast(bf16x8, W); if ((i) & 1) o1 = __builtin_amdgcn_mfma_f32_32x32x16_bf16(vf[i], pb_, o1, 0, 0, 0); else o0 = __builtin_amdgcn_mfma_f32_32x32x16_bf16(vf[i], pb_, o0, 0, 0, 0); } while (0)
                if (ND0 == 6) {
                    KR1(0); KR1(1); KR1(2); KR1(3); SB();
                    QK1(0, negm); EX2(pc0, 0, w0.x); KR1(4); SB();
                    QK1(1, negm); EX2(pc0, 2, w0.y); KR1(5); SB();
                    QK1(2, pn0); EX2(pc0, 4, w0.z); KR1(6); SB();
                    QK1(3, pn1); EX2(pc0, 6, w0.w); KR1(7); SB();
                    QK1(4, pn0); EX2(pc0, 8, w1.x); KR1(8); SB();
                    QK1(5, pn1); EX2(pc0, 10, w1.y); KR1(9); SB();
                    QK1(6, pn0); EX2(pc0, 12, w1.z); KR1(10); SB();
                    QK1(7, pn1); EX2(pc0, 14, w1.w); KR1(11); SB();
                    QK1(8, pn0); EX2(pc1, 0, w2.x); VR1(0); SB();
                    QK1(9, pn1); EX2(pc1, 2, w2.y); VR1(1); SB();
                    QK1(10, pn0); EX2(pc1, 4, w2.z); VR1(2); SB();
                    QK1(11, pn1); EX2(pc1, 6, w2.w); VR1(3); SB();
                } else {
                    KR1(0); KR1(1); KR1(2); KR1(3); SB();
                    QK1(0, negm); EX2(pc0, 0, w0.x); EX2(pc0, 2, w0.y); KR1(4); SB();
                    QK1(1, negm); EX2(pc0, 4, w0.z); EX2(pc0, 6, w0.w); KR1(5); SB();
                    QK1(2, pn0); EX2(pc0, 8, w1.x); EX2(pc0, 10, w1.y); KR1(6); SB();
                    QK1(3, pn1); EX2(pc0, 12, w1.z); EX2(pc0, 14, w1.w); KR1(7); SB();
                    QK1(4, pn0); EX2(pc1, 0, w2.x); VR1(0); SB();
                    QK1(5, pn1); EX2(pc1, 2, w2.y); VR1(1); SB();
                    QK1(6, pn0); EX2(pc1, 4, w2.z); VR1(2); SB();
                    QK1(7, pn1); EX2(pc1, 6, w2.w); VR1(3); SB();
                }
                PV1(0, w0); EX2(pc1, 8, w3.x); VR1(4); SB();
                PV1(1, w0); EX2(pc1, 10, w3.y); VR1(5); SB();
                PV1(2, w1); EX2(pc1, 12, w3.z); VR1(6); SB();
                PV1(3, w1); EX2(pc1, 14, w3.w); VR1(7); SB();
                lrun += sacc;
                PV1(4, w2); MASK_TILE(pn0, pn1, t + 1); SB();
                PV1(5, w2); SB();
                PV1(6, w3); SB();
                PV1(7, w3); rmn = rowmax32(pn0, pn1); if (!USE_NEGM) rmn -= mref; SB();
#undef KR1
#undef VR1
#undef EX2
#undef QK1
#undef PV1
#undef KRD
#undef VRD
#undef EX4
#undef SB
#undef QKP
#undef PVP
            } else {
            if (need_n) QK_TILE(pn0, pn1, (t + 1) & 1, negm);
            if (need_c) {
                float sum = 0.f;
#pragma unroll
                for (int r = 0; r < 16; ++r) { if (!USE_NEGM) { pc0[r] -= mref; pc1[r] -= mref; } pc0[r] = __builtin_amdgcn_exp2f(pc0[r]); pc1[r] = __builtin_amdgcn_exp2f(pc1[r]); sum += pc0[r]; sum += pc1[r]; }
                lrun += sum;
                bf16x8 pk[4];
                { u32x4 a; a.x = cvtpk(pc0[0], pc0[1]); a.y = cvtpk(pc0[2], pc0[3]); a.z = cvtpk(pc0[4], pc0[5]); a.w = cvtpk(pc0[6], pc0[7]); pk[0] = __builtin_bit_cast(bf16x8, a); }
                { u32x4 a; a.x = cvtpk(pc0[8], pc0[9]); a.y = cvtpk(pc0[10], pc0[11]); a.z = cvtpk(pc0[12], pc0[13]); a.w = cvtpk(pc0[14], pc0[15]); pk[1] = __builtin_bit_cast(bf16x8, a); }
                { u32x4 a; a.x = cvtpk(pc1[0], pc1[1]); a.y = cvtpk(pc1[2], pc1[3]); a.z = cvtpk(pc1[4], pc1[5]); a.w = cvtpk(pc1[6], pc1[7]); pk[2] = __builtin_bit_cast(bf16x8, a); }
                { u32x4 a; a.x = cvtpk(pc1[8], pc1[9]); a.y = cvtpk(pc1[10], pc1[11]); a.z = cvtpk(pc1[12], pc1[13]); a.w = cvtpk(pc1[14], pc1[15]); pk[3] = __builtin_bit_cast(bf16x8, a); }
                const LAS unsigned char* vt = lds + (t & 1) * ABUF + KT_BYTES;
#pragma unroll
                for (int kk = 0; kk < 4; ++kk) {
                    const bf16x8 v0 = *(const LAS bf16x8*)(vt + r32 * VP + kk * 32 + hi * 16);
                    const bf16x8 v1 = *(const LAS bf16x8*)(vt + (32 + r32) * VP + kk * 32 + hi * 16);
                    o0 = __builtin_amdgcn_mfma_f32_32x32x16_bf16(v0, pk[kk], o0, 0, 0, 0);
                    o1 = __builtin_amdgcn_mfma_f32_32x32x16_bf16(v1, pk[kk], o1, 0, 0, 0);
                }
            }
            if (need_n) { MASK_TILE(pn0, pn1, t + 1); rmn = rowmax32(pn0, pn1); if (!USE_NEGM) rmn -= mref; }
            }
            if (hn) { STOREK(t & 1); STOREV((t + 1) & 1); }
            __syncthreads();
            pc0 = pn0; pc1 = pn1; rmc = rmn; need_c = need_n;
        }
#undef TILE_KPOS
#undef LOADK
#undef LOADV
#undef STOREK
#undef STOREV
#undef NEED
#undef QK_TILE
#undef MASK_TILE
        const float lt = lrun + shfl_xor_l(lrun, 32, lane), inv = 1.f / lt;
        bf16_t* op = P.O + (size_t)(qrow + r32) * DM + hq * 64 + 4 * hi;
#pragma unroll
        for (int g = 0; g < 4; ++g) {
            u32x2 a; a.x = cvtpk(o0[4 * g] * inv, o0[4 * g + 1] * inv); a.y = cvtpk(o0[4 * g + 2] * inv, o0[4 * g + 3] * inv); *(u32x2*)(op + 8 * g) = a;
            u32x2 c; c.x = cvtpk(o1[4 * g] * inv, o1[4 * g + 1] * inv); c.y = cvtpk(o1[4 * g + 2] * inv, o1[4 * g + 3] * inv); *(u32x2*)(op + 32 + 8 * g) = c;
        }
    }
}

constexpr size_t MiB = 1u << 20;
constexpr size_t WS_BAR = 983040  ;
constexpr size_t WS_MOD = 0, WS_SSQ = 1 * MiB, WS_ROPE16 = 3 * MiB, WS_ROPE32 = 4 * MiB, WS_KPE = 6 * MiB, WS_XC = 12 * MiB;
constexpr size_t WS_W1T = 20 * MiB, WS_W2T = 52 * MiB, WS_MLA = 84 * MiB  , WS_SWA = 94 * MiB  , WS_NA = 99 * MiB  ;
constexpr size_t WS_H = 108 * MiB, WS_Q = 240 * MiB, WS_K = 438 * MiB, WS_VT = 570 * MiB, WS_O = 702 * MiB, WS_LAT = 702 * MiB, WS_HID = 240 * MiB, WS_NBIAS = 834 * MiB  , WS_SSQN = 836 * MiB  , WS_PART = 840 * MiB  , WS_END = 904 * MiB;

#define XB_TMO      128
#define XB_XCNT(j)  (256  + 64 * (j))
#define XB_XSUB(j)  (1280 + 64 * (j))
#define XB_XGEN(j)  (2304 + 64 * (j))
#define XB_TOP      3328
#define XB_TOPGEN   3392
#define XCD_BAR_WORDS 3456
#define XB_SPIN_CAP (1u << 18)
__device__ __forceinline__ unsigned xb_ld(unsigned* p)              { return __hip_atomic_load(p, __ATOMIC_RELAXED, __HIP_MEMORY_SCOPE_AGENT); }
__device__ __forceinline__ unsigned xb_add(unsigned* p, unsigned v) { return __hip_atomic_fetch_add(p, v, __ATOMIC_RELAXED, __HIP_MEMORY_SCOPE_AGENT); }
__device__ __forceinline__ unsigned xb_xcc_id() { return (unsigned)__builtin_amdgcn_s_getreg((3 << 11) | 20) & 0xFu; }
#define XB_SPIN(cond, bar) do { unsigned _sp = 0; while (cond) { __builtin_amdgcn_s_sleep(1); \
    if ((++_sp & 255u) == 0u) { if (xb_ld(&(bar)[XB_TMO])) break; if (_sp > XB_SPIN_CAP) { atomicAdd(&(bar)[XB_TMO], 1u); break; } } } } while (0)
struct XcdBarrier { unsigned* bar; unsigned x; volatile LAS unsigned* st; };
__device__ __forceinline__ XcdBarrier xcd_barrier_post(unsigned* bar, volatile LAS unsigned* st, bool t0) {
    XcdBarrier b; b.bar = bar; b.x = xb_xcc_id(); b.st = st;
    if (t0) (void)xb_add(&bar[XB_XCNT(b.x)], 1u);
    return b;
}
__device__ __forceinline__ void xcd_barrier_complete(unsigned* bar, unsigned x, unsigned& nloc, unsigned& nx) {
    const unsigned G = gridDim.x * gridDim.y * gridDim.z;
    unsigned sum, cnt, mine, sp = 0u;
    for (;;) {
        sum = 0u; cnt = 0u; mine = 0u;
#pragma unroll
        for (unsigned j = 0; j < 16; ++j) { const unsigned c = xb_ld(&bar[XB_XCNT(j)]); sum += c; cnt += (c > 0u) ? 1u : 0u; mine = (j == x) ? c : mine; }
        if (sum == G) break;
        __builtin_amdgcn_s_sleep(1);
        if ((++sp & 255u) == 0u) { if (xb_ld(&bar[XB_TMO])) break; if (sp > XB_SPIN_CAP) { atomicAdd(&bar[XB_TMO], 1u); break; } }
    }
    nloc = mine > 0u ? mine : 1u; nx = cnt > 0u ? cnt : 1u;
}
__device__ __forceinline__ void xcd_barrier(const XcdBarrier& b, bool t0) {
    asm volatile("s_waitcnt vmcnt(0)" ::: "memory");
    __syncthreads();
    if (t0) {
        unsigned* bar = b.bar; unsigned bx = b.x; asm volatile("" : "+s"(bar), "+s"(bx));
        __builtin_amdgcn_s_waitcnt(0);
        unsigned nloc = b.st[0], nx = b.st[1];
        if (nloc == 0u) { xcd_barrier_complete(bar, bx, nloc, nx); b.st[0] = nloc; b.st[1] = nx; }
        const unsigned old = xb_add(&bar[XB_XSUB(bx)], 1u);
        const unsigned gen = old / nloc;
        if (old + 1u == (gen + 1u) * nloc) {
            __builtin_amdgcn_fence(__ATOMIC_RELEASE, "agent");
            asm volatile("s_waitcnt vmcnt(0)" ::: "memory");
            const unsigned og = xb_add(&bar[XB_TOP], 1u);
            const unsigned tg = og / nx;
            if (og + 1u == (tg + 1u) * nx) xb_add(&bar[XB_TOPGEN], 1u);
            else XB_SPIN(xb_ld(&bar[XB_TOPGEN]) == tg, bar);
            __builtin_amdgcn_fence(__ATOMIC_ACQUIRE, "agent");
            xb_add(&bar[XB_XGEN(bx)], 1u);
            asm volatile("s_waitcnt vmcnt(0)" ::: "memory");
        } else {
            XB_SPIN(xb_ld(&bar[XB_XGEN(bx)]) == gen, bar);
            __builtin_amdgcn_fence(__ATOMIC_ACQUIRE, "agent");
            asm volatile("s_waitcnt vmcnt(0)" ::: "memory");
        }
    }
    __syncthreads();
}

__device__ __forceinline__ float wave_sum(float v, int lane) {
#pragma unroll
    for (int o = 1; o < 64; o <<= 1) v += shfl_xor_l(v, o, lane);
    return v;
}
__device__ __forceinline__ void sincos_red(float x, float& sn, float& cs) {
    const float n = rintf(x * 0.15915494309189535f);
    float r = fmaf(-n, 6.2831854820251465f, x); r = fmaf(-n, -1.7484555e-7f, r);
    const float rev = r * 0.15915494309189535f;
    sn = __builtin_amdgcn_sinf(rev); cs = __builtin_amdgcn_cosf(rev);
}
__device__ __forceinline__ void transpose_item(const float* W, int K, int N, bf16_t* WT, const float* g, LAS float* scr, int item, int lane) {
    const int nblk = N / 32, kb = item / nblk, nb = item % nblk, k0 = 64 * kb, n0 = 32 * nb;
#pragma unroll 8
    for (int i = 0; i < 32; ++i) { const int kk = 2 * i + (lane >> 5); float v = W[(size_t)(k0 + kk) * N + n0 + (lane & 31)]; if (g) v *= g[k0 + kk]; scr[kk * 33 + (lane & 31)] = v; }
    asm volatile("s_waitcnt lgkmcnt(0)" ::: "memory");
    const int c = lane & 7;
#pragma unroll
    for (int j = 0; j < 4; ++j) { const int n = (lane >> 3) + 8 * j; const LAS float* s = scr + (8 * c) * 33 + n;
        u32x4 o; o.x = cvtpk(s[0 * 33], s[1 * 33]); o.y = cvtpk(s[2 * 33], s[3 * 33]); o.z = cvtpk(s[4 * 33], s[5 * 33]); o.w = cvtpk(s[6 * 33], s[7 * 33]);
        *(u32x4*)(WT + (size_t)(n0 + n) * K + k0 + 8 * c) = o; }
    asm volatile("s_waitcnt lgkmcnt(0)" ::: "memory");
}

struct Args { const float* in[23]; float* out; unsigned char* ws; };

__device__ __forceinline__ void norm_pass0(const float* xl, const float* xc, const float* g, const float* mod, int sc_off, bf16_t* H, float* ssq, int gw, int NGW) {
    int lane = lane_id(); asm volatile("" : "+v"(lane));
    for (int row = gw; row < MT; row += NGW) {
        const bool isctx = row >= ML;
        const float* xr = isctx ? xc + (size_t)(row - ML) * DM : xl + (size_t)row * DM;
        const float* mp = mod + (isctx ? 8 : (row >> 13)) * 6144;
        f32x4 v[4]; float ss = 0.f;
#pragma unroll
        for (int j = 0; j < 4; ++j) { v[j] = *(const f32x4*)(xr + 4 * lane + 256 * j); ss += (v[j][0] * v[j][0] + v[j][1] * v[j][1]) + (v[j][2] * v[j][2] + v[j][3] * v[j][3]); }
        ss = wave_sum(ss, lane);
        if (lane == 0) ssq[row] = ss;
#pragma unroll
        for (int j = 0; j < 4; ++j) { const int col = 4 * lane + 256 * j;
            const f32x4 gg = *(const f32x4*)(g + col), sc = *(const f32x4*)(mp + sc_off + col);
            const f32x4 y = v[j] * gg * (sc + 1.f);
            u32x2 o; o.x = cvtpk(y[0], y[1]); o.y = cvtpk(y[2], y[3]); *(u32x2*)(H + (size_t)row * DM + col) = o; }
    }
}
__device__ __forceinline__ void norm_ctx(float* xc, const float* part, const float* gate8, const float* g, const float* sc, bf16_t* Hc, float* ssqc, int gw, int NGW) {
    int lane = lane_id(); asm volatile("" : "+v"(lane));
    for (int row = gw; row < MC; row += NGW) {
        float* xr = xc + (size_t)row * DM;
        f32x4 v[4]; float ss = 0.f;
#pragma unroll
        for (int j = 0; j < 4; ++j) { const int col = 4 * lane + 256 * j;
            f32x4 p = *(const f32x4*)(part + (size_t)row * DM + col);
#pragma unroll
            for (int kc = 1; kc < 8; ++kc) p += *(const f32x4*)(part + ((size_t)kc * MC + row) * DM + col);
            v[j] = *(const f32x4*)(xr + col) + *(const f32x4*)(gate8 + col) * p;
            *(f32x4*)(xr + col) = v[j];
            ss += (v[j][0] * v[j][0] + v[j][1] * v[j][1]) + (v[j][2] * v[j][2] + v[j][3] * v[j][3]); }
        ss = wave_sum(ss, lane);
        if (lane == 0) ssqc[row] = ss;
#pragma unroll
        for (int j = 0; j < 4; ++j) { const int col = 4 * lane + 256 * j;
            const f32x4 gg = *(const f32x4*)(g + col), s4 = *(const f32x4*)(sc + col);
            const f32x4 y = v[j] * gg * (s4 + 1.f);
            u32x2 o; o.x = cvtpk(y[0], y[1]); o.y = cvtpk(y[2], y[3]); *(u32x2*)(Hc + (size_t)row * DM + col) = o; }
    }
}
__device__ __forceinline__ void nbias_item(LAS unsigned char* lds, const float* W, int N, int n0, const float* mod, int sh_off, float* out, int wave, int lane) {
    LAS float* shl = (LAS float*)(lds + 65536); LAS float* red = (LAS float*)(lds + 102400);
    const int tid = wave * 64 + lane;
    for (int i = tid; i < 9 * 1024; i += 512) shl[i] = mod[(i >> 10) * 6144 + sh_off + (i & 1023)];
    __syncthreads();
    const int n = n0 + lane; const bool ok = n < N;
    const float* Wp = W + (ok ? n : 0);
    float s0 = 0, s1 = 0, s2 = 0, s3 = 0, s4 = 0, s5 = 0, s6 = 0, s7 = 0, s8 = 0;
#pragma unroll 8
    for (int k = wave * 128; k < wave * 128 + 128; ++k) { const float wv = Wp[(size_t)k * N];
        s0 += shl[k] * wv; s1 += shl[1024 + k] * wv; s2 += shl[2048 + k] * wv; s3 += shl[3072 + k] * wv; s4 += shl[4096 + k] * wv;
        s5 += shl[5120 + k] * wv; s6 += shl[6144 + k] * wv; s7 += shl[7168 + k] * wv; s8 += shl[8192 + k] * wv; }
    LAS float* rp = red + wave * 576 + lane;
    rp[0] = s0; rp[64] = s1; rp[128] = s2; rp[192] = s3; rp[256] = s4; rp[320] = s5; rp[384] = s6; rp[448] = s7; rp[512] = s8;
    __syncthreads();
    for (int i = tid; i < 576; i += 512) { float sum = 0.f;
#pragma unroll
        for (int ww = 0; ww < 8; ++ww) sum += red[ww * 576 + i];
        const int b = i >> 6, l = i & 63; if (n0 + l < N) out[b * 4096 + n0 + l] = sum; else if (n0 + l < 4096) out[b * 4096 + n0 + l] = 0.f; }
    __syncthreads();
}

__global__ void __launch_bounds__(512, 2) fwd_megakernel(Args a) {
    extern __shared__ __attribute__((aligned(16))) unsigned char lds_raw[];
    LAS unsigned char* lds = (LAS unsigned char*)lds_raw;
    cg::grid_group grid = cg::this_grid();
    const int wave = __builtin_amdgcn_readfirstlane((int)threadIdx.x >> 6);
    const int G = gridDim.x, bid = blockIdx.x;
    const int vcu = (G % 8 == 0) ? (bid % 8) * (G / 8) + bid / 8 : bid;
    const int gw = vcu * 8 + wave, NGW = G * 8;
    unsigned char* ws = a.ws;
    volatile LAS unsigned* bar_st = (volatile LAS unsigned*)(lds + 131072 + 64);
    if (wave == 0 && lane_id() < 2) bar_st[lane_id()] = 0u;
    __syncthreads();
    XcdBarrier xbar = xcd_barrier_post((unsigned*)(ws + WS_BAR), bar_st, wave == 0 && lane_id() == 0);
#define GRID_BAR() xcd_barrier(xbar, wave == 0 && lane_id() == 0)
    const float* x_in = a.in[0]; const float* c_in = a.in[1]; const float* ctx_in = a.in[2]; const float* cctx_in = a.in[3];
    const float* ada_w = a.in[4]; const float* ada_b = a.in[5]; const float* norm_mix_g = a.in[6]; const float* norm_mlp_g = a.in[7]; const float* norm_out_g = a.in[8];
    float* MOD = (float*)(ws + WS_MOD); float* SSQ = (float*)(ws + WS_SSQ);
    float* ROPE16 = (float*)(ws + WS_ROPE16); float* ROPE32 = (float*)(ws + WS_ROPE32);
    bf16_t* KPE = (bf16_t*)(ws + WS_KPE); float* XC = (float*)(ws + WS_XC);
    bf16_t* H = (bf16_t*)(ws + WS_H); bf16_t* Qb = (bf16_t*)(ws + WS_Q); bf16_t* Kb = (bf16_t*)(ws + WS_K); bf16_t* VTb = (bf16_t*)(ws + WS_VT);
    bf16_t* Ob = (bf16_t*)(ws + WS_O); bf16_t* LAT = (bf16_t*)(ws + WS_LAT); bf16_t* HID = (bf16_t*)(ws + WS_HID);
    float* X = a.out;
    float* NBIAS = (float*)(ws + WS_NBIAS); float* SSQN = (float*)(ws + WS_SSQN); float* PART = (float*)(ws + WS_PART);

    {
        const int lane = lane_id(), tid = wave * 64 + lane;
        LAS float* act = (LAS float*)(lds + 65536); LAS float* red = (LAS float*)(lds + 102400);
        for (int i = tid; i < 9 * 1024; i += 512) { const int b = i >> 10, k = i & 1023; const float v = b < 8 ? c_in[b * 1024 + k] : cctx_in[k]; act[i] = v / (1.f + __builtin_amdgcn_exp2f(-v * LOG2E)); }
        __syncthreads();
        for (int it = bid; it < 384; it += G) {
            const int layer = it / 96, n0 = (it % 96) * 64;
            const float* W = ada_w + (size_t)layer * 1024 * 6144 + n0 + lane;
            float s0 = 0, s1 = 0, s2 = 0, s3 = 0, s4 = 0, s5 = 0, s6 = 0, s7 = 0, s8 = 0;
#pragma unroll 8
            for (int k = wave * 128; k < wave * 128 + 128; ++k) { const float wv = W[(size_t)k * 6144];
                s0 += act[k] * wv; s1 += act[1024 + k] * wv; s2 += act[2048 + k] * wv; s3 += act[3072 + k] * wv; s4 += act[4096 + k] * wv;
                s5 += act[5120 + k] * wv; s6 += act[6144 + k] * wv; s7 += act[7168 + k] * wv; s8 += act[8192 + k] * wv; }
            LAS float* rp = red + wave * 576 + lane;
            rp[0] = s0; rp[64] = s1; rp[128] = s2; rp[192] = s3; rp[256] = s4; rp[320] = s5; rp[384] = s6; rp[448] = s7; rp[512] = s8;
            __syncthreads();
            for (int i = tid; i < 576; i += 512) { float s = 0.f;
#pragma unroll
                for (int ww = 0; ww < 8; ++ww) s += red[ww * 576 + i];
                const int b = i >> 6, l = i & 63; MOD[((size_t)layer * 9 + b) * 6144 + n0 + l] = s + ada_b[layer * 6144 + n0 + l]; }
            __syncthreads();
        }
        __syncthreads();
        LAS float* scr = (LAS float*)(lds + wave * 16384);
        int base = 0;
#define TR(Wsrc, K_, N_, dst, gsc) do { const int n_ = ((K_) / 64) * ((N_) / 32); \
            for (int it_ = (gw + NGW - (base % NGW)) % NGW; it_ < n_; it_ += NGW) transpose_item((Wsrc), (K_), (N_), (dst), (gsc), scr, it_, lane); base += n_; } while (0)
        for (int L = 0; L < 4; ++L) {
            TR(a.in[9] + (size_t)L * DM * FF, DM, FF, (bf16_t*)(ws + WS_W1T + (size_t)L * 8 * MiB), (const float*)nullptr);
            TR(a.in[10] + (size_t)L * FF * DM, FF, DM, (bf16_t*)(ws + WS_W2T + (size_t)L * 8 * MiB), (const float*)nullptr);
        }
        for (int j = 0; j < 2; ++j) {
            unsigned char* mb = ws + WS_MLA + (size_t)j * 5 * MiB;
            TR(a.in[11] + (size_t)j * DM * 416, DM, 416, (bf16_t*)mb, (const float*)nullptr);
            TR(a.in[13] + (size_t)j * 256 * 1536, 256, 1536, (bf16_t*)(mb + 1 * MiB), a.in[12] + j * 256);
            TR(a.in[15] + (size_t)j * 128 * 2048, 128, 2048, (bf16_t*)(mb + 1 * MiB + 768 * 1024), a.in[14] + j * 128);
            TR(a.in[16] + (size_t)j * DM * DM, DM, DM, (bf16_t*)(mb + 3 * MiB), (const float*)nullptr);
            u32x4* z = (u32x4*)(mb + (size_t)416 * 1024 * 2);
            for (int i = gw * 64 + lane; i < 96 * 1024 * 2 / 16; i += NGW * 64) z[i] = (u32x4){0u, 0u, 0u, 0u};
        }
        TR(a.in[17], DM, 1536, (bf16_t*)(ws + WS_SWA), (const float*)nullptr);
        TR(a.in[19], DM, DM, (bf16_t*)(ws + WS_SWA + 3 * MiB), (const float*)nullptr);
        TR(a.in[20], DM, 3072, (bf16_t*)(ws + WS_NA), (const float*)nullptr);
        TR(a.in[22], DM, DM, (bf16_t*)(ws + WS_NA + 6 * MiB), (const float*)nullptr);
#undef TR
        for (int i = gw * 64 + lane; i < 8192 * 16; i += NGW * 64) { const int t = i >> 4, p = i & 15; const int f = p & 7; const float pos = (float)(p < 8 ? (t >> 6) : (t & 63));
            const float ang = pos * __builtin_amdgcn_exp2f(-(float)f * (13.287712379549449f / 8.f)); float sn, cs; sincos_red(ang, sn, cs); ROPE16[2 * i] = cs; ROPE16[2 * i + 1] = sn; }
        for (int i = gw * 64 + lane; i < 8192 * 32; i += NGW * 64) { const int t = i >> 5, p = i & 31; const int f = p & 15; const float pos = (float)(p < 16 ? (t >> 6) : (t & 63));
            const float ang = pos * __builtin_amdgcn_exp2f(-(float)f * (13.287712379549449f / 16.f)); float sn, cs; sincos_red(ang, sn, cs); ROPE32[2 * i] = cs; ROPE32[2 * i + 1] = sn; }
        for (int i = gw * 64 + lane; i < 4 * MT; i += NGW * 64) SSQ[i] = 0.f;
        for (int i = gw * 64 + lane; i < 8 * MT; i += NGW * 64) SSQN[i] = 0.f;
    }
    grid.sync();
    {
        const int lane = lane_id();
        for (int it = bid; it < 8 + 24 + 48 + 8 + 256; it += G) {
            int r = it; const float* W; int N, L, which, blk;
            if (r < 8) { W = a.in[11]; N = 416; L = 0; which = 0; blk = r; }
            else if ((r -= 8) < 24) { W = a.in[17]; N = 1536; L = 1; which = 0; blk = r; }
            else if ((r -= 24) < 48) { W = a.in[20]; N = 3072; L = 2; which = 0; blk = r; }
            else if ((r -= 48) < 8) { W = a.in[11] + (size_t)DM * 416; N = 416; L = 3; which = 0; blk = r; }
            else { r -= 8; L = r >> 6; blk = r & 63; W = a.in[9] + (size_t)L * DM * FF; N = FF; which = 1; }
            nbias_item(lds, W, N, blk * 64, MOD + (size_t)L * 9 * 6144, which ? 3072 : 0, NBIAS + (size_t)(L * 2 + which) * 9 * 4096, wave, lane);
        }
        norm_pass0(x_in, ctx_in, norm_mix_g, MOD, 1024, H, SSQN, gw, NGW);
        for (int i = gw * 64 + lane; i < MC * DM / 4; i += NGW * 64) ((f32x4*)XC)[i] = ((const f32x4*)ctx_in)[i];
    }
    GRID_BAR();

    for (int L = 0; L < 4; ++L) {
        const int kind = L % 3, jl = L / 3; const bool last = (L == 3);
        const float* modL = MOD + (size_t)L * 9 * 6144;
        const float* xl = (L == 0) ? x_in : X; const float* xc = (L == 0) ? ctx_in : XC;
        const float* ssqn1 = SSQN + (size_t)(2 * L) * MT; const float* nbias1 = NBIAS + (size_t)(L * 2) * 9 * 4096;
        if (kind == 0) {
            unsigned char* mb = ws + WS_MLA + (size_t)jl * 5 * MiB;
            float* ssq_q = SSQ + (size_t)jl * 2 * MT; float* ssq_kv = ssq_q + MT;
            {
                pg8::Gemm g{H, (const bf16_t*)mb, MT, 512, DM, DM, DM}; pg8::StaticOrder S; S.init(MT, 512, G, bid);
                EpiLat E{LAT, ssq_q, ssq_kv, KPE, ROPE16, ssqn1, nbias1};
                pg8::gemm_phase<EpiLat, pg8::StaticOrder, true>(lds, g, S, E, wave);
            }
            GRID_BAR();
            {
                pg8::Gemm g{LAT, (const bf16_t*)(mb + 1 * MiB), MT, 1536, 256, 512, 256}; pg8::StaticOrder S; S.init(MT, 1536, G, bid);
                EpiProj<0> E{Qb, nullptr, nullptr, ROPE16, ssq_q, 0.10206207261596577f * LOG2E, nullptr};
                pg8::gemm_phase<EpiProj<0>, pg8::StaticOrder, true>(lds, g, S, E, wave);
            }
            {
                pg8::Gemm g{LAT + 256, (const bf16_t*)(mb + 1 * MiB + 768 * 1024), MT, 2048, 128, 512, 128}; pg8::StaticOrder S; S.init(MT, 2048, G, bid);
                EpiProj<1> E{nullptr, Kb, VTb, nullptr, ssq_kv, 1.f, nullptr};
                pg8::gemm_phase<EpiProj<1>, pg8::StaticOrder, true>(lds, g, S, E, wave);
            }
        } else if (kind == 1) {
            pg8::Gemm g{H, (const bf16_t*)(ws + WS_SWA), MT, 1536, DM, DM, DM}; pg8::StaticOrder S; S.init(MT, 1536, G, bid);
            EpiProj<2> E{Qb, Kb, VTb, ROPE32, ssqn1, 0.125f * LOG2E, nbias1};
            pg8::gemm_phase<EpiProj<2>, pg8::StaticOrder, true>(lds, g, S, E, wave);
        } else {
            pg8::Gemm g{H, (const bf16_t*)(ws + WS_NA), MT, 3072, DM, DM, DM}; pg8::StaticOrder S; S.init(MT, 3072, G, bid);
            EpiProj<3> E{Qb, Kb, VTb, nullptr, ssqn1, 0.125f * LOG2E, nbias1};
            pg8::gemm_phase<EpiProj<3>, pg8::StaticOrder, true>(lds, g, S, E, wave);
        }
        GRID_BAR();
        {
            AttnP P{Qb, Kb, KPE, VTb, Ob, a.in[18], a.in[21], last ? 4096 : 4096 + 128};
            if (kind == 0) attn_phase<0>(lds, P, vcu, G, wave);
            else if (kind == 1) attn_phase<1>(lds, P, vcu, G, wave);
            else attn_phase<2>(lds, P, vcu, G, wave);
        }
        GRID_BAR();
        const int Mres = last ? ML : MT;
        {
            const bf16_t* wo = (const bf16_t*)(kind == 0 ? ws + WS_MLA + (size_t)jl * 5 * MiB + 3 * MiB : (kind == 1 ? ws + WS_SWA + 3 * MiB : ws + WS_NA + 6 * MiB));
            {
                pg8::Gemm g{Ob, wo, ML, DM, DM, DM, DM}; pg8::StaticOrder S; S.init(ML, DM, G, bid);
                EpiResid E{xl, XC, X, XC, modL + 2048, H, norm_mlp_g + L * DM, modL + 4096, SSQN + (size_t)(2 * L + 1) * MT};
                pg8::gemm_phase<EpiResid, pg8::StaticOrder, true>(lds, g, S, E, wave);
            }
            if (!last) {
                pg8::Gemm g{Ob, wo, MT, DM, 128, DM, DM}; pg8::CtxSplitOrder S{bid, G, 128};
                EpiCtxPartial E{PART, 128};
                pg8::gemm_phase<EpiCtxPartial, pg8::CtxSplitOrder, true>(lds, g, S, E, wave);
            }
        }
        GRID_BAR();
        if (!last) { norm_ctx(XC, PART, modL + 2048 + 8 * 6144, norm_mlp_g + L * DM, modL + 8 * 6144 + 4096, H + (size_t)ML * DM, SSQN + (size_t)(2 * L + 1) * MT + ML, gw, NGW); GRID_BAR(); }
        {
            pg8::Gemm g{H, (const bf16_t*)(ws + WS_W1T + (size_t)L * 8 * MiB), Mres, FF, DM, DM, DM}; pg8::StaticOrder S; S.init(Mres, FF, G, bid);
            EpiSqRelu E{HID, FF, SSQN + (size_t)(2 * L + 1) * MT, NBIAS + (size_t)(L * 2 + 1) * 9 * 4096};
            pg8::gemm_phase<EpiSqRelu, pg8::StaticOrder, true>(lds, g, S, E, wave);
        }
        GRID_BAR();
        {
            const bf16_t* w2t = (const bf16_t*)(ws + WS_W2T + (size_t)L * 8 * MiB);
            {
                pg8::Gemm g{HID, w2t, ML, DM, FF, FF, FF}; pg8::StaticOrder S; S.init(ML, DM, G, bid);
                EpiResid E{X, XC, X, XC, modL + 5120, last ? nullptr : H, norm_mix_g + (L + 1) * DM, MOD + (size_t)(L + 1) * 9 * 6144 + 1024, SSQN + (size_t)(2 * L + 2) * MT};
                pg8::gemm_phase<EpiResid, pg8::StaticOrder, true>(lds, g, S, E, wave);
            }
            if (!last) {
                pg8::Gemm g{HID, w2t, MT, DM, 512, FF, FF}; pg8::CtxSplitOrder S{bid, G, 512};
                EpiCtxPartial E{PART, 512};
                pg8::gemm_phase<EpiCtxPartial, pg8::CtxSplitOrder, true>(lds, g, S, E, wave);
            }
        }
        GRID_BAR();
        if (!last) { norm_ctx(XC, PART, modL + 5120 + 8 * 6144, norm_mix_g + (L + 1) * DM, MOD + (size_t)(L + 1) * 9 * 6144 + 8 * 6144 + 1024, H + (size_t)ML * DM, SSQN + (size_t)(2 * L + 2) * MT + ML, gw, NGW); GRID_BAR(); }
    }
    int lane = lane_id(); asm volatile("" : "+v"(lane));
    for (int row = gw; row < ML; row += NGW) {
        float* xr = X + (size_t)row * DM;
        f32x4 v[4]; float ss = 0.f;
#pragma unroll
        for (int j = 0; j < 4; ++j) { v[j] = *(const f32x4*)(xr + 4 * lane + 256 * j); ss += (v[j][0] * v[j][0] + v[j][1] * v[j][1]) + (v[j][2] * v[j][2] + v[j][3] * v[j][3]); }
        const float rstd = rsqrtf(wave_sum(ss, lane) * (1.f / DM) + EPS);
#pragma unroll
        for (int j = 0; j < 4; ++j) { const int col = 4 * lane + 256 * j; const f32x4 gg = *(const f32x4*)(norm_out_g + col); *(f32x4*)(xr + col) = v[j] * rstd * gg; }
    }
}

constexpr int LDS_BYTES = 147456;
extern "C" void kernel_launch(void* const* d_in, const int* in_sizes, int n_in, void* d_out, int out_size, void* d_ws, size_t ws_size, hipStream_t stream) {
    static int grid = 0;
    if (grid == 0) {
        if (n_in != 23 || out_size != ML * DM || ws_size < WS_END) { fprintf(stderr, "kernel_launch: unexpected shapes (n_in %d out %d ws %zu)\n", n_in, out_size, ws_size); grid = -1; return; }
        int dev = 0, cus = 0, per_cu = 0;
        hipGetDevice(&dev); hipDeviceGetAttribute(&cus, hipDeviceAttributeMultiprocessorCount, dev);
        if (hipFuncSetAttribute((const void*)fwd_megakernel, hipFuncAttributeMaxDynamicSharedMemorySize, LDS_BYTES) != hipSuccess) { fprintf(stderr, "kernel_launch: hipFuncSetAttribute failed\n"); grid = -1; return; }
        if (hipOccupancyMaxActiveBlocksPerMultiprocessor(&per_cu, (const void*)fwd_megakernel, 512, LDS_BYTES) != hipSuccess || per_cu < 1) { fprintf(stderr, "kernel_launch: occupancy query gave %d\n", per_cu); per_cu = 1; }
        (void)hipGetLastError();
        grid = cus * per_cu;
    }
    if (grid < 0) return;
    if (hipMemsetAsync((char*)d_ws + WS_BAR, 0, XCD_BAR_WORDS * 4, stream) != hipSuccess) { fprintf(stderr, "kernel_launch: memset of the barrier words failed\n"); return; }
    Args a{};
    for (int i = 0; i < 23; ++i) a.in[i] = (const float*)d_in[i];
    a.out = (float*)d_out; a.ws = (unsigned char*)d_ws;
    void* args[] = {&a};
    hipError_t e = hipLaunchCooperativeKernel((const void*)fwd_megakernel, dim3(grid), dim3(512), args, LDS_BYTES, stream);
    if (e != hipSuccess) fprintf(stderr, "cooperative launch failed: %s (grid %d)\n", hipGetErrorString(e), grid);
}
```

```cpp
#include <hip/hip_runtime.h>
#include <hip/hip_cooperative_groups.h>
#include <cstdio>
#include <cstdint>
namespace cg = cooperative_groups;

#define LAS __attribute__((address_space(3)))
typedef unsigned short bf16_t;
typedef short bf16x8 __attribute__((ext_vector_type(8)));
typedef float f32x4 __attribute__((ext_vector_type(4)));
typedef float f32x16 __attribute__((ext_vector_type(16)));
typedef unsigned u32x4 __attribute__((ext_vector_type(4)));
typedef unsigned u32x2 __attribute__((ext_vector_type(2)));

constexpr int NB = 8, SEQ = 8192, DM = 1024, CTX = 256, FF = 4096;
constexpr int ML = NB * SEQ;
constexpr int MC = NB * CTX;
constexpr int MT = ML + MC;
constexpr int KVLEN = CTX + SEQ;
constexpr float EPS = 1e-6f;
constexpr float LOG2E = 1.4426950408889634f;

__device__ __forceinline__ unsigned cvtpk(float lo, float hi) {
    typedef float f2 __attribute__((ext_vector_type(2))); typedef __bf16 b2 __attribute__((ext_vector_type(2)));
    f2 v = {lo, hi}; b2 b = __builtin_convertvector(v, b2); return __builtin_bit_cast(unsigned, b);
}
__device__ __forceinline__ int lane_id() { int l; asm volatile("v_mbcnt_lo_u32_b32 %0, -1, 0\n\tv_mbcnt_hi_u32_b32 %0, -1, %0" : "=v"(l)); return l; }
__device__ __forceinline__ float shfl_xor_l(float v, int mask, int lane) { return __int_as_float(__builtin_amdgcn_ds_bpermute((lane ^ mask) << 2, __float_as_int(v))); }
__device__ __forceinline__ int perm16(int x) { return 8 * ((x >> 2) & 1) + (x & 3) + 4 * (x >> 3); }

namespace pg8 {
constexpr int BM = 256, BK = 64, HALF = 128, HTB = HALF * BK * 2, STAGE_BYTES = 8 * HTB, NXCD = 8, WGM = 8;
__host__ __device__ __forceinline__ int lds_byte(int r, int c) { const int st = (r >> 4) * 2 + (c >> 5), rr = r & 15, cc = c & 31, ob = rr * 64 + cc * 2; return st * 1024 + (ob ^ (((ob >> 9) & 1) << 5)); }
__host__ __device__ __forceinline__ void stage_rc(int b, int& R, int& C) { const int st = b / 1024, sb = b % 1024, swz = sb ^ (((sb >> 9) & 1) << 5); R = (st >> 1) * 16 + swz / 64; C = (st & 1) * 32 + (swz % 64) / 2; }
__host__ __device__ __forceinline__ int perm32(int rho) { const int n = rho >> 4, i = rho & 15; return 8 * (i >> 2) + 4 * n + (i & 3); }

struct Unit { int pm, pn, koff; };
struct Gemm { const bf16_t* A; const bf16_t* Bt; int M, N, K, lda, ldb; };

struct StaticOrder {
    int nM, nN, nwg, G, c;
    __device__ void init(int M, int N, int G_, int c_) { nM = M / BM; nN = N / BM; nwg = nM * nN; G = G_; c = c_; }
    __device__ bool next(int i, Unit& u) const {
        const long L = (long)i * G + c; if (L >= nwg) return false;
        int wgid = (int)L; { const int q = nwg / NXCD, r = nwg % NXCD, xcd = wgid % NXCD, off = wgid / NXCD; wgid = (xcd < r ? xcd * (q + 1) : r * (q + 1) + (xcd - r) * q) + off; }
        const int nig = WGM * nN, gid = wgid / nig, fm = gid * WGM, gsz = (nM - fm) < WGM ? (nM - fm) : WGM;
        u.pm = fm + ((wgid % nig) % gsz); u.pn = (wgid % nig) / gsz; u.koff = 0; return true;
    }
};

struct CtxSplitOrder {
    int c, G, kchunk;
    __device__ bool next(int i, Unit& u) const { const int L = i * G + c; if (L >= 256) return false; u.pm = 256 + (L >> 5); u.pn = (L >> 3) & 3; u.koff = (L & 7) * kchunk; return true; }
};

template <class Epi, class Sched, bool ALIGN_EPI>
__device__ __forceinline__ void gemm_phase(LAS unsigned char* lds, const Gemm g, const Sched& S, const Epi& E, int wave_s) {
    int tid_l = wave_s * 64 + lane_id(); asm volatile("" : "+v"(tid_l));
    const int tid = tid_l, wid = __builtin_amdgcn_readfirstlane(tid >> 6), lane = tid & 63, wr = wid >> 2, wc = wid & 3, fr = lane & 15, fq = lane >> 4;
    const int K = g.K, nt = K / BK;
    unsigned voffA[2], voffB[2];
#pragma unroll
    for (int i = 0; i < 2; ++i) { int R, C; stage_rc(tid * 16 + i * 8192, R, C); const int Rb = Epi::PERM ? ((R & ~31) + perm32(R & 31)) : R;
        voffA[i] = (unsigned)(R * g.lda + C) * 2u; voffB[i] = (unsigned)(Rb * g.ldb + C) * 2u; }
    const size_t kstep = (size_t)(BK * 2);
    const size_t hstepA = (size_t)HALF * g.lda * 2, hstepB = (size_t)HALF * g.ldb * 2;
    const size_t tstepA = 2 * hstepA, tstepB = 2 * hstepB;
    const unsigned ldsw = (unsigned)wid * 1024u;
    const int aoff = lds_byte(wr * 64 + fr, fq * 8), boff = lds_byte(wc * 32 + fr, fq * 8);
#define PG8_SA(b, h) (((b) * 2 + (h)) * HTB)
#define PG8_SB(b, h) ((4 + (b) * 2 + (h)) * HTB)
#define PG8_STAGE(bufoff, gbase, voff) do { _Pragma("unroll") for (int _i = 0; _i < 2; ++_i) \
        __builtin_amdgcn_global_load_lds((const unsigned*)((const char*)(gbase) + (voff)[_i]), (LAS unsigned*)(lds + (bufoff) + ldsw + _i * 8192), 16, 0, 0); } while (0)
#define PG8_LDA(dst, b, h) do { _Pragma("unroll") for (int m = 0; m < 4; ++m) _Pragma("unroll") for (int k = 0; k < 2; ++k) dst[m][k] = *(const LAS bf16x8*)(lds + PG8_SA(b, h) + aoff + m * 2048 + k * 1024); } while (0)
#define PG8_LDB(dst, b, h) do { _Pragma("unroll") for (int n = 0; n < 2; ++n) _Pragma("unroll") for (int k = 0; k < 2; ++k) dst[n][k] = *(const LAS bf16x8*)(lds + PG8_SB(b, h) + boff + n * 2048 + k * 1024); } while (0)
#define PG8_MMA(ai, bj, At, Bt) do { __builtin_amdgcn_s_setprio(1); _Pragma("unroll") for (int m = 0; m < 4; ++m) _Pragma("unroll") for (int n = 0; n < 2; ++n) _Pragma("unroll") for (int k = 0; k < 2; ++k) \
        acc[ai][bj][m][n] = __builtin_amdgcn_mfma_f32_16x16x32_bf16(Bt[n][k], At[m][k], acc[ai][bj][m][n], 0, 0, 0); __builtin_amdgcn_s_setprio(0); } while (0)
#define PG8_WAIT_V(n) asm volatile("s_waitcnt vmcnt(" #n ")" ::: "memory")
#define PG8_WAIT_L(n) asm volatile("s_waitcnt lgkmcnt(" #n ")" ::: "memory")
#define PG8_BAR __builtin_amdgcn_s_barrier()
#define PG8_SCHED __builtin_amdgcn_sched_barrier(0)
    Unit cur, nxt; int ui = 0;
    if (!S.next(0, cur)) return;
    f32x4 acc[2][2][4][2];
#pragma unroll
    for (int a = 0; a < 2; ++a)
#pragma unroll
        for (int b = 0; b < 2; ++b)
#pragma unroll
            for (int m = 0; m < 4; ++m)
#pragma unroll
                for (int n = 0; n < 2; ++n) acc[a][b][m][n] = (f32x4){0.f, 0.f, 0.f, 0.f};
    bf16x8 At[4][2], B0[2][2], B1[2][2];
    const char* cA = (const char*)g.A + (size_t)cur.pm * tstepA + (size_t)cur.koff * 2; const char* cB = (const char*)g.Bt + (size_t)cur.pn * tstepB + (size_t)cur.koff * 2;
    PG8_STAGE(PG8_SB(0, 0), cB, voffB); PG8_STAGE(PG8_SB(0, 1), cB + hstepB, voffB); PG8_STAGE(PG8_SA(0, 0), cA, voffA); PG8_STAGE(PG8_SA(0, 1), cA + hstepA, voffA);
    if (wr == 1) PG8_BAR;
    PG8_WAIT_V(2); PG8_BAR;
    PG8_STAGE(PG8_SB(1, 0), cB + kstep, voffB); PG8_STAGE(PG8_SA(1, 0), cA + kstep, voffA); PG8_STAGE(PG8_SB(1, 1), cB + hstepB + kstep, voffB);
    PG8_WAIT_V(6); PG8_BAR;
    for (;;) {
        const bool has_next = S.next(ui + 1, nxt);
        const char* nA = has_next ? (const char*)g.A + (size_t)nxt.pm * tstepA + (size_t)nxt.koff * 2 : cA; const char* nB = has_next ? (const char*)g.Bt + (size_t)nxt.pn * tstepB + (size_t)nxt.koff * 2 : cB;
        for (int t = 0; t < nt; t += 2) {
            const bool last = (t == nt - 2);
            const char* a1 = cA + (size_t)(t + 1) * kstep;
            const char* a2 = last ? nA : cA + (size_t)(t + 2) * kstep; const char* b2 = last ? nB : cB + (size_t)(t + 2) * kstep;
            const char* a3 = a2 + kstep; const char* b3 = b2 + kstep;
            PG8_LDB(B0, 0, 0); PG8_LDB(B1, 0, 1); PG8_SCHED; PG8_LDA(At, 0, 0); PG8_STAGE(PG8_SA(1, 1), a1 + hstepA, voffA);
            PG8_WAIT_V(8); PG8_WAIT_L(0); PG8_BAR; PG8_MMA(0, 0, At, B0); PG8_MMA(0, 1, At, B1); PG8_BAR; PG8_SCHED;
            PG8_LDA(At, 0, 1); PG8_STAGE(PG8_SB(0, 0), b2, voffB); PG8_STAGE(PG8_SB(0, 1), b2 + hstepB, voffB); PG8_STAGE(PG8_SA(0, 0), a2, voffA);
            PG8_WAIT_V(8); PG8_WAIT_L(0); PG8_BAR; PG8_MMA(1, 0, At, B0); PG8_MMA(1, 1, At, B1); PG8_BAR; PG8_SCHED;
            PG8_LDB(B0, 1, 0); PG8_LDB(B1, 1, 1); PG8_SCHED; PG8_LDA(At, 1, 0); PG8_STAGE(PG8_SA(0, 1), a2 + hstepA, voffA);
            PG8_WAIT_V(8); PG8_WAIT_L(0); PG8_BAR; PG8_MMA(0, 0, At, B0); PG8_MMA(0, 1, At, B1); PG8_BAR; PG8_SCHED;
            PG8_LDA(At, 1, 1); PG8_STAGE(PG8_SB(1, 0), b3, voffB); PG8_STAGE(PG8_SB(1, 1), b3 + hstepB, voffB); PG8_STAGE(PG8_SA(1, 0), a3, voffA);
            PG8_WAIT_V(8); PG8_WAIT_L(0); PG8_BAR; PG8_MMA(1, 0, At, B0); PG8_MMA(1, 1, At, B1); PG8_BAR; PG8_SCHED;
        }
        if constexpr (ALIGN_EPI) { if (wr == 0) PG8_BAR; }
        E(acc, cur, wr, wc, fr, fq);
        if (!has_next) break;
#pragma unroll
        for (int a = 0; a < 2; ++a)
#pragma unroll
            for (int b = 0; b < 2; ++b)
#pragma unroll
                for (int m = 0; m < 4; ++m)
#pragma unroll
                    for (int n = 0; n < 2; ++n) acc[a][b][m][n] = (f32x4){0.f, 0.f, 0.f, 0.f};
        cur = nxt; cA = nA; cB = nB; ++ui;
        if constexpr (ALIGN_EPI) { if (wr == 1) PG8_BAR; }
    }
    PG8_WAIT_V(0);
    if constexpr (!ALIGN_EPI) { if (wr == 0) PG8_BAR; }
    PG8_BAR;
#undef PG8_SA
#undef PG8_SB
#undef PG8_STAGE
#undef PG8_LDA
#undef PG8_LDB
#undef PG8_MMA
#undef PG8_WAIT_V
#undef PG8_WAIT_L
#undef PG8_BAR
#undef PG8_SCHED
}
}

typedef const f32x4 (&AccRef)[2][2][4][2];

__device__ __forceinline__ void rope8(float (&v)[8], const float* tab) {
    const f32x4 t0 = *(const f32x4*)tab, t1 = *(const f32x4*)(tab + 4);
    float x1, x2;
    x1 = v[0]; x2 = v[1]; v[0] = x1 * t0[0] - x2 * t0[1]; v[1] = x1 * t0[1] + x2 * t0[0];
    x1 = v[2]; x2 = v[3]; v[2] = x1 * t0[2] - x2 * t0[3]; v[3] = x1 * t0[3] + x2 * t0[2];
    x1 = v[4]; x2 = v[5]; v[4] = x1 * t1[0] - x2 * t1[1]; v[5] = x1 * t1[1] + x2 * t1[0];
    x1 = v[6]; x2 = v[7]; v[6] = x1 * t1[2] - x2 * t1[3]; v[7] = x1 * t1[3] + x2 * t1[2];
}
__device__ __forceinline__ void rope8v(float (&v)[8], const f32x4 t0, const f32x4 t1) {
    float x1, x2;
    x1 = v[0]; x2 = v[1]; v[0] = x1 * t0[0] - x2 * t0[1]; v[1] = x1 * t0[1] + x2 * t0[0];
    x1 = v[2]; x2 = v[3]; v[2] = x1 * t0[2] - x2 * t0[3]; v[3] = x1 * t0[3] + x2 * t0[2];
    x1 = v[4]; x2 = v[5]; v[4] = x1 * t1[0] - x2 * t1[1]; v[5] = x1 * t1[1] + x2 * t1[0];
    x1 = v[6]; x2 = v[7]; v[6] = x1 * t1[2] - x2 * t1[3]; v[7] = x1 * t1[3] + x2 * t1[2];
}
__device__ __forceinline__ u32x4 pack8(const float (&v)[8]) { u32x4 w; w.x = cvtpk(v[0], v[1]); w.y = cvtpk(v[2], v[3]); w.z = cvtpk(v[4], v[5]); w.w = cvtpk(v[6], v[7]); return w; }

template <int MODE> struct EpiProj {
    static constexpr bool PERM = true;
    bf16_t* Q; bf16_t* K; bf16_t* VT; const float* rope; const float* ssq; float qscale; const float* nbias;
    __device__ __forceinline__ void operator()(AccRef acc, const pg8::Unit& u, int wr, int wc, int fr_, int fq_) const {
        int lane_e = lane_id(); asm volatile("" : "+v"(lane_e)); const int fr = lane_e & 15, fq = lane_e >> 4; (void)fr_; (void)fq_;
        constexpr int LDQ = (MODE == 0) ? 1536 : 1024, NQ = (MODE == 0) ? 1536 : (MODE == 1 ? 0 : 1024);
        constexpr int LDK = (MODE == 2) ? 256 : 1024, NK = LDK, VCOLS = LDK;
        constexpr int TS = (MODE == 2) ? 64 : 32;
        const bool isctx = u.pm >= 256;
        const int row0 = u.pm * 256 + wr * 64 + fr, col0 = u.pn * 256 + wc * 32 + 8 * fq;
        f32x4 nbv[2][2]; float rs[4];
#pragma unroll
        for (int bj = 0; bj < 2; ++bj) {
            const int col = col0 + 128 * bj;
            if (MODE >= 2) { const float* nb = nbias + (isctx ? 8 : (u.pm >> 5)) * 4096 + col; nbv[bj][0] = *(const f32x4*)nb; nbv[bj][1] = *(const f32x4*)(nb + 4); }
            else { nbv[bj][0] = (f32x4){0.f, 0.f, 0.f, 0.f}; nbv[bj][1] = nbv[bj][0]; }
        }
#pragma unroll
        for (int r = 0; r < 8; ++r) {
            const int ai = r >> 2, m = r & 3; const int row = row0 + 128 * ai + 16 * m;
            if (m == 0) {
#pragma unroll
                for (int q = 0; q < 4; ++q) rs[q] = ssq[row0 + 128 * ai + 16 * q];
#pragma unroll
                for (int q = 0; q < 4; ++q) rs[q] = rsqrtf(rs[q] * (MODE == 0 ? 1.f / 256.f : (MODE == 1 ? 1.f / 128.f : 1.f / 1024.f)) + EPS);
            }
            const int rc = row - ML;
            const int b = isctx ? (rc >> 8) : (u.pm >> 5);
            const int kpos = isctx ? (rc & 255) : 256 + (row & 8191);
            const size_t kvrow = (size_t)b * KVLEN + kpos;
            const int vpos = (kpos & ~15) | perm16(kpos & 15);
            f32x4 tc[2][2] = {}; bool rp[2] = {false, false}; int roff[2] = {0, 0};
#pragma unroll
            for (int bj = 0; bj < 2; ++bj) { const int col = col0 + 128 * bj;
                if (MODE == 2) { rp[bj] = !isctx && col < 1280; roff[bj] = ((col & 63) >> 1) * 2; }
                else if (MODE == 0) { const int c96 = col % 96; rp[bj] = !isctx && c96 >= 64; roff[bj] = rp[bj] ? ((c96 - 64) >> 1) * 2 : 0; } }
            if (MODE == 2) {
#pragma unroll
                for (int bj = 0; bj < 2; ++bj) if (rp[bj]) { const float* tp = rope + (size_t)(row & 8191) * TS + roff[bj]; tc[bj][0] = *(const f32x4*)tp; tc[bj][1] = *(const f32x4*)(tp + 4); }
            }
#pragma unroll
            for (int bj = 0; bj < 2; ++bj) {
                const int col = col0 + 128 * bj;
                float v[8];
#pragma unroll
                for (int j = 0; j < 4; ++j) { v[j] = acc[ai][bj][m][0][j] * rs[m] + nbv[bj][0][j]; v[4 + j] = acc[ai][bj][m][1][j] * rs[m] + nbv[bj][1][j]; }
                if (MODE == 0 && rp[bj]) { const float* tp = rope + (size_t)(row & 8191) * TS + roff[bj]; tc[bj][0] = *(const f32x4*)tp; tc[bj][1] = *(const f32x4*)(tp + 4); }
                if ((MODE == 0 || MODE == 2) && rp[bj]) rope8v(v, tc[bj][0], tc[bj][1]);
                bool isv; int kc;
                if (MODE == 1) { const int within = col & 127; isv = within >= 64; kc = (col >> 7) * 64 + (within & 63); }
                else { isv = col >= NQ + NK; kc = isv ? col - NQ - NK : col - NQ; }
                if (MODE != 1 && col < NQ) {
#pragma unroll
                    for (int j = 0; j < 8; ++j) v[j] *= qscale;
                    *(u32x4*)(Q + (size_t)row * LDQ + col) = pack8(v);
                } else if (MODE != 0 && !isv) {
                    *(u32x4*)(K + kvrow * LDK + kc) = pack8(v);
                } else if (MODE != 0) {
                    bf16_t* vp = VT + ((size_t)(b * VCOLS + kc)) * KVLEN + vpos;
#pragma unroll
                    for (int j = 0; j < 8; ++j) vp[(size_t)j * KVLEN] = (bf16_t)(cvtpk(v[j], 0.f) & 0xffffu);
                }
            }
        }
    }
};

struct EpiLat {
    static constexpr bool PERM = true;
    bf16_t* lat; float* ssq_q; float* ssq_kv; bf16_t* KPE; const float* rope; const float* ssqn; const float* nbias;
    __device__ __forceinline__ void operator()(AccRef acc, const pg8::Unit& u, int wr, int wc, int fr_, int fq_) const {
        int lane_e = lane_id(); asm volatile("" : "+v"(lane_e)); const int fr = lane_e & 15, fq = lane_e >> 4; (void)fr_; (void)fq_;
        float rsv[8]; f32x4 nbv[2][2];
        { const int row0 = u.pm * 256 + wr * 64 + fr; const float* nb = nbias + (u.pm >= 256 ? 8 : (u.pm >> 5)) * 4096 + u.pn * 256 + wc * 32 + 8 * fq;
#pragma unroll
          for (int bj = 0; bj < 2; ++bj) { nbv[bj][0] = *(const f32x4*)(nb + 128 * bj); nbv[bj][1] = *(const f32x4*)(nb + 128 * bj + 4); }
#pragma unroll
          for (int r = 0; r < 8; ++r) rsv[r] = ssqn[row0 + 128 * (r >> 2) + 16 * (r & 3)];
#pragma unroll
          for (int r = 0; r < 8; ++r) rsv[r] = rsqrtf(rsv[r] * (1.f / 1024.f) + EPS); }
#pragma unroll
        for (int ai = 0; ai < 2; ++ai)
#pragma unroll
            for (int m = 0; m < 4; ++m) {
                const int row = u.pm * 256 + ai * 128 + wr * 64 + m * 16 + fr;
                const bool isctx = row >= ML; const int rc = row - ML;
                const int b = isctx ? (rc >> 8) : (row >> 13);
                const int tok = row & 8191;
                const int kpos = isctx ? (rc & 255) : 256 + tok;
                const size_t kvrow = (size_t)b * KVLEN + kpos;
                const float rs = rsv[ai * 4 + m];
                float ss = 0.f;
#pragma unroll
                for (int bj = 0; bj < 2; ++bj) {
                    const int col = u.pn * 256 + bj * 128 + wc * 32 + 8 * fq;
                    float v[8];
#pragma unroll
                    for (int j = 0; j < 4; ++j) { v[j] = acc[ai][bj][m][0][j] * rs; v[4 + j] = acc[ai][bj][m][1][j] * rs; }
                    {
#pragma unroll
                      for (int j = 0; j < 4; ++j) { v[j] += nbv[bj][0][j]; v[4 + j] += nbv[bj][1][j]; } }
                    if (col < 384) {
#pragma unroll
                        for (int j = 0; j < 8; ++j) ss += v[j] * v[j];
                        *(u32x4*)(lat + (size_t)row * 512 + col) = pack8(v);
                    } else if (col < 416) {
                        if (!isctx) rope8(v, rope + ((size_t)tok * 16 + ((col - 384) >> 1)) * 2);
                        *(u32x4*)(KPE + kvrow * 32 + (col - 384)) = pack8(v);
                    }
                }
                ss += shfl_xor_l(ss, 16, lane_e); ss += shfl_xor_l(ss, 32, lane_e);
                if (fq == 0 && (u.pn == 0 || wc < 4)) unsafeAtomicAdd((u.pn == 0 ? ssq_q : ssq_kv) + row, ss);
            }
    }
};

struct EpiResid {
    static constexpr bool PERM = false;
    const float* xin_l; const float* xin_c; float* xout_l; float* xout_c; const float* gate;
    bf16_t* xa; const float* gn; const float* scn; float* ssqn;
    __device__ __forceinline__ void operator()(AccRef acc, const pg8::Unit& u, int wr, int wc, int fr_, int fq_) const {
        int lane_e = lane_id(); asm volatile("" : "+v"(lane_e)); const int fr = lane_e & 15, fq = lane_e >> 4; (void)fr_; (void)fq_;
        const int bsel = u.pm >> 5;
        const int col0 = u.pn * 256 + wc * 32 + 4 * fq;
        const int row0 = u.pm * 256 + wr * 64 + fr;
        f32x4 gv[4], av[4];
#pragma unroll
        for (int c = 0; c < 4; ++c) { const int col = col0 + 128 * (c >> 1) + 16 * (c & 1);
            gv[c] = *(const f32x4*)(gate + bsel * 6144 + col);
            if (xa) { const f32x4 g4 = *(const f32x4*)(gn + col), s4 = *(const f32x4*)(scn + bsel * 6144 + col); av[c] = g4 * (s4 + 1.f); } else av[c] = (f32x4){0.f, 0.f, 0.f, 0.f}; }
        f32x4 xc[4], xn[4]; float ssr[8];
        { const float* xi = xin_l + (size_t)row0 * DM + col0;
#pragma unroll
          for (int c = 0; c < 4; ++c) xc[c] = *(const f32x4*)(xi + 128 * (c >> 1) + 16 * (c & 1)); }
#pragma unroll
        for (int r = 0; r < 8; ++r) {
            const int ai = r >> 2, m = r & 3; const int row = row0 + 128 * ai + 16 * m;
            if (r < 7) { const int rown = row0 + 128 * ((r + 1) >> 2) + 16 * ((r + 1) & 3); const float* xi = xin_l + (size_t)rown * DM + col0;
#pragma unroll
                for (int c = 0; c < 4; ++c) xn[c] = *(const f32x4*)(xi + 128 * (c >> 1) + 16 * (c & 1)); }
            float* xo = xout_l + (size_t)row * DM + col0; float ss = 0.f;
#pragma unroll
            for (int c = 0; c < 4; ++c) {
                const f32x4 y = xc[c] + gv[c] * acc[ai][c >> 1][m][c & 1];
                *(f32x4*)(xo + 128 * (c >> 1) + 16 * (c & 1)) = y;
                if (xa) { const f32x4 z = y * av[c]; ss += (y[0] * y[0] + y[1] * y[1]) + (y[2] * y[2] + y[3] * y[3]);
                    u32x2 o; o.x = cvtpk(z[0], z[1]); o.y = cvtpk(z[2], z[3]); *(u32x2*)(xa + (size_t)row * DM + col0 + 128 * (c >> 1) + 16 * (c & 1)) = o; }
            }
            ssr[r] = ss;
#pragma unroll
            for (int c = 0; c < 4; ++c) xc[c] = xn[c];
        }
        if (xa) {
#pragma unroll
            for (int r = 0; r < 8; ++r) { float ss = ssr[r]; ss += shfl_xor_l(ss, 16, lane_e); ss += shfl_xor_l(ss, 32, lane_e); ssr[r] = ss; }
            if (fq == 0) {
#pragma unroll
                for (int r = 0; r < 8; ++r) unsafeAtomicAdd(ssqn + row0 + 128 * (r >> 2) + 16 * (r & 3), ssr[r]);
            }
        }
    }
};

struct EpiCtxPartial {
    static constexpr bool PERM = false;
    float* part; int kchunk;
    __device__ __forceinline__ void operator()(AccRef acc, const pg8::Unit& u, int wr, int wc, int fr_, int fq_) const {
        int lane_e = lane_id(); asm volatile("" : "+v"(lane_e)); const int fr = lane_e & 15, fq = lane_e >> 4; (void)fr_; (void)fq_;
        float* pb = part + (size_t)(u.koff / kchunk) * MC * DM;
#pragma unroll
        for (int ai = 0; ai < 2; ++ai)
#pragma unroll
            for (int m = 0; m < 4; ++m) {
                const int row = u.pm * 256 + ai * 128 + wr * 64 + m * 16 + fr - ML;
                float* xr = pb + (size_t)row * DM;
#pragma unroll
                for (int bj = 0; bj < 2; ++bj)
#pragma unroll
                    for (int n = 0; n < 2; ++n) {
                        const int col = u.pn * 256 + bj * 128 + wc * 32 + 16 * n + 4 * fq;
                        *(f32x4*)(xr + col) = acc[ai][bj][m][n];
                    }
            }
    }
};

struct EpiSqRelu {
    static constexpr bool PERM = true;
    bf16_t* O; int ldc; const float* ssqn; const float* nbias;
    __device__ __forceinline__ void operator()(AccRef acc, const pg8::Unit& u, int wr, int wc, int fr_, int fq_) const {
        int lane_e = lane_id(); asm volatile("" : "+v"(lane_e)); const int fr = lane_e & 15, fq = lane_e >> 4; (void)fr_; (void)fq_;
        const int row0 = u.pm * 256 + wr * 64 + fr, col0 = u.pn * 256 + wc * 32 + 8 * fq;
        const float* nb = nbias + (u.pm >= 256 ? 8 : (u.pm >> 5)) * 4096 + col0;
        f32x4 bv[2][2]; float rs[8];
#pragma unroll
        for (int bj = 0; bj < 2; ++bj) { bv[bj][0] = *(const f32x4*)(nb + bj * 128); bv[bj][1] = *(const f32x4*)(nb + bj * 128 + 4); }
#pragma unroll
        for (int r = 0; r < 8; ++r) rs[r] = ssqn[row0 + 128 * (r >> 2) + 16 * (r & 3)];
#pragma unroll
        for (int r = 0; r < 8; ++r) rs[r] = rsqrtf(rs[r] * (1.f / 1024.f) + EPS);
#pragma unroll
        for (int r = 0; r < 8; ++r) {
            const int ai = r >> 2, m = r & 3; const int row = row0 + 128 * ai + 16 * m;
#pragma unroll
            for (int bj = 0; bj < 2; ++bj) {
                float v[8];
#pragma unroll
                for (int j = 0; j < 4; ++j) { float a = fmaxf(acc[ai][bj][m][0][j] * rs[r] + bv[bj][0][j], 0.f), c = fmaxf(acc[ai][bj][m][1][j] * rs[r] + bv[bj][1][j], 0.f); v[j] = a * a; v[4 + j] = c * c; }
                *(u32x4*)(O + (size_t)row * ldc + col0 + bj * 128) = pack8(v);
            }
        }
    }
};

constexpr int KP = 208, VP = 144;
constexpr int KT_BYTES = 64 * KP, VT_BYTES = 64 * VP, ABUF = KT_BYTES + VT_BYTES;
constexpr int ATT_BIAS_OFF = 2 * ABUF;
struct AttnP { const bf16_t* Q; const bf16_t* K; const bf16_t* KPE; const bf16_t* VT; bf16_t* O; const float* sink; const float* bias; int nunits; };

__device__ __forceinline__ float rowmax32(const f32x16& a, const f32x16& b) {
    float x = __builtin_fmaxf(__builtin_fmaxf(a[0], a[1]), b[0]), y = __builtin_fmaxf(__builtin_fmaxf(a[2], a[3]), b[1]); x = __builtin_fmaxf(__builtin_fmaxf(x, b[2]), b[3]);
#pragma unroll
    for (int r = 4; r < 16; r += 4) { x = __builtin_fmaxf(__builtin_fmaxf(x, a[r]), a[r + 1]); y = __builtin_fmaxf(__builtin_fmaxf(y, a[r + 2]), a[r + 3]); x = __builtin_fmaxf(__builtin_fmaxf(x, b[r]), b[r + 1]); y = __builtin_fmaxf(__builtin_fmaxf(y, b[r + 2]), b[r + 3]); }
    const float m = __builtin_fmaxf(x, y);
    auto rr = __builtin_amdgcn_permlane32_swap(__float_as_uint(m), __float_as_uint(m), false, false);
    return __builtin_fmaxf(__uint_as_float(rr[0]), __uint_as_float(rr[1]));
}

template <int VAR>
__device__ __forceinline__ void attn_phase(LAS unsigned char* lds, const AttnP P, int vcu, int G, int wave_s) {
    constexpr int ND0 = (VAR == 0) ? 6 : 4;
    constexpr int QPITCH = (VAR == 0) ? 1536 : 1024, QH = (VAR == 0) ? 96 : 64;
    constexpr int KPITCH = (VAR == 1) ? 256 : 1024, VCOLS = (VAR == 1) ? 256 : 1024;
    constexpr bool USE_NEGM = (VAR != 2);
    constexpr float THR = 8.f;
    int tid_l = wave_s * 64 + lane_id(); asm volatile("" : "+v"(tid_l));
    const int tid = tid_l, lane = tid & 63, r32 = lane & 31, hi = lane >> 5;
    const int w = __builtin_amdgcn_readfirstlane(tid >> 6);
    LAS float* bias_lds = (LAS float*)(lds + ATT_BIAS_OFF);
    for (int it = 0;; ++it) {
        int u;
        if (VAR == 0 && G == 256) { u = (it < 16) ? ((it * 8 + (vcu >> 5)) * 32 + (vcu & 31)) : (4096 + (it - 16) * 256 + vcu); }
        else u = it * G + vcu;
        if (u >= P.nunits) break;
        const bool isctx = u >= 4096;
        int b, hq, hk, qrow, nt; int p_a = 0, p_b = 0;
        if (VAR == 0) {
            if (!isctx) { const int bh = u >> 5, qb = u & 31; b = bh >> 4; hq = bh & 15; qrow = b * SEQ + qb * 256 + 32 * w; nt = 132; }
            else { const int cu = u - 4096; b = cu >> 4; hq = cu & 15; qrow = ML + b * 256 + 32 * w; nt = 4; }
            hk = hq;
        } else if (VAR == 1) {
            if (!isctx) { const int blk = u & 63, hp = (u >> 6) & 7; b = u >> 9; hq = 2 * hp + (w >> 2); hk = hp >> 1; qrow = b * SEQ + blk * 128 + 32 * (w & 3);
                          const int jlo = blk == 0 ? 2 : 0, jhi = blk == 63 ? 4 : 6; nt = 4 + jhi - jlo; p_a = blk * 128 - 128 + 64 * jlo; p_b = blk * 128 + 32 * (w & 3); }
            else { const int cu = u - 4096, half = cu & 1, hp = (cu >> 1) & 7; b = cu >> 4; hq = 2 * hp + (w >> 2); hk = hp >> 1; qrow = ML + b * 256 + half * 128 + 32 * (w & 3); nt = 4; }
        } else {
            if (!isctx) { const int rq = u & 31; hq = (u >> 5) & 15; b = u >> 9; const int r0 = 4 * rq; qrow = b * SEQ + (r0 + (w >> 1)) * 64 + 32 * (w & 1);
                          int lo = r0 - 4; lo = lo < 0 ? 0 : (lo > 120 ? 120 : lo); int h2 = r0 - 1; h2 = h2 < 0 ? 0 : (h2 > 120 ? 120 : h2); nt = 4 + (h2 + 8 - lo); p_a = lo; p_b = r0 + (w >> 1); }
            else { const int cu = u - 4096; b = cu >> 4; hq = cu & 15; qrow = ML + b * 256 + 32 * w; nt = 4; }
            hk = hq;
        }
        if (VAR == 2 && !isctx) { if (tid < 465) bias_lds[tid] = P.bias[hq * 465 + tid] * LOG2E; }
        bf16x8 qf[ND0];
        { const bf16_t* qp = P.Q + (size_t)(qrow + r32) * QPITCH + hq * QH + hi * 8;
#pragma unroll
          for (int d0 = 0; d0 < ND0; ++d0) qf[d0] = *(const bf16x8*)(qp + d0 * 16); }
        f32x16 o0 = {}, o1 = {};
        const unsigned koff = (unsigned)(((b * KVLEN + (tid >> 3)) * KPITCH + hk * 64 + (tid & 7) * 8) * 2);
        const unsigned peoff = (unsigned)(((b * KVLEN + (tid >> 2)) * 32 + (tid & 3) * 8) * 2);
        const unsigned voff = (unsigned)(((b * VCOLS + hk * 64 + (tid >> 3)) * KVLEN + (tid & 7) * 8) * 2);
        u32x4 kreg, pereg = {}, vreg;
#define TILE_KPOS(t) (VAR == 0 ? 64 * (((t) + rot >= nt) ? (t) + rot - nt : (t) + rot) : ((t) < 4 ? 64 * (t) : (VAR == 1 ? 256 + p_a + 64 * ((t) - 4) : 256 + 64 * (p_a + (t) - 4))))
#define LOADK(t) do { const int kp_ = TILE_KPOS(t); kreg = *(const u32x4*)((const char*)P.K + (size_t)(koff + (unsigned)(kp_ * KPITCH * 2))); if (VAR == 0 && tid < 256) pereg = *(const u32x4*)((const char*)P.KPE + (size_t)(peoff + (unsigned)(kp_ * 64))); } while (0)
#define LOADV(t) do { const int kp_ = TILE_KPOS(t); vreg = *(const u32x4*)((const char*)P.VT + (size_t)(voff + (unsigned)(kp_ * 2))); } while (0)
#define STOREK(buf) do { LAS unsigned char* kb_ = lds + (buf) * ABUF; *(LAS u32x4*)(kb_ + (tid >> 3) * KP + (tid & 7) * 16) = kreg; \
        if (VAR == 0 && tid < 256) *(LAS u32x4*)(kb_ + (tid >> 2) * KP + 128 + (tid & 3) * 16) = pereg; } while (0)
#define STOREV(buf) do { *(LAS u32x4*)(lds + (buf) * ABUF + KT_BYTES + (tid >> 3) * VP + (tid & 7) * 16) = vreg; } while (0)
#define NEED(t) (((t) < 4) ? true : (VAR == 1 ? ((p_a + 64 * ((t) - 4) + 63 >= p_b - 128) && (p_a + 64 * ((t) - 4) <= p_b + 31 + 128)) : (VAR == 2 ? ((p_a + (t) - 4 >= na_rs) && (p_a + (t) - 4 < na_rs + 8)) : true)))
#define QK_TILE(P0, P1, buf, CINIT) do { const LAS unsigned char* kt_ = lds + (buf) * ABUF; P0 = (CINIT); P1 = (CINIT); \
        _Pragma("unroll") for (int d0 = 0; d0 < ND0; ++d0) { \
            const bf16x8 k0_ = *(const LAS bf16x8*)(kt_ + r32 * KP + d0 * 32 + hi * 16); const bf16x8 k1_ = *(const LAS bf16x8*)(kt_ + (32 + r32) * KP + d0 * 32 + hi * 16); \
            P0 = __builtin_amdgcn_mfma_f32_32x32x16_bf16(k0_, qf[d0], P0, 0, 0, 0); P1 = __builtin_amdgcn_mfma_f32_32x32x16_bf16(k1_, qf[d0], P1, 0, 0, 0); } } while (0)
#define MASK_TILE(P0, P1, t) do { \
        if (VAR == 1 && (t) >= 4) { const int d0_ = p_a + 64 * ((t) - 4) - (p_b + r32) + 4 * hi + 128; \
            _Pragma("unroll") for (int r = 0; r < 16; ++r) { const int dd = d0_ + (r & 3) + 8 * (r >> 2); if ((unsigned)dd > 256u) P0[r] = -1e30f; if ((unsigned)(dd + 32) > 256u) P1[r] = -1e30f; } } \
        if (VAR == 2 && (t) >= 4) { int c = (qrow & 63) + r32; asm volatile("" : "+v"(c)); const int kr = p_a + (t) - 4; int cs = c - 8; cs = cs < 0 ? 0 : (cs > 48 ? 48 : cs); const LAS float* brow = bias_lds + (kr - p_b + 7) * 31; \
            _Pragma("unroll") for (int r = 0; r < 16; ++r) { const int kc = 4 * hi + (r & 3) + 8 * (r >> 2); \
                { int bi = kc - c + 15; bi = bi < 0 ? 0 : (bi > 30 ? 30 : bi); P0[r] = ((unsigned)(kc - cs) < 16u) ? P0[r] + brow[bi] : -1e30f; } \
                { int bi = kc + 32 - c + 15; bi = bi < 0 ? 0 : (bi > 30 ? 30 : bi); P1[r] = ((unsigned)(kc + 32 - cs) < 16u) ? P1[r] + brow[bi] : -1e30f; } } } } while (0)
        const int rot = (VAR == 0 && !isctx) ? ((vcu & 31) * 4 + (vcu >> 5)) % 132 : 0;
        int na_rs = 0; if (VAR == 2) { na_rs = p_b - 4; na_rs = na_rs < 0 ? 0 : (na_rs > 120 ? 120 : na_rs); }
        LOADK(0); LOADV(0); STOREK(0); STOREV(0);
        if (nt > 1) { LOADK(1); STOREK(1); }
        __syncthreads();
        f32x16 pc0, pc1; const f32x16 zero16 = {};
        QK_TILE(pc0, pc1, 0, zero16);
        float mref = rowmax32(pc0, pc1), lrun = 0.f;
        if (VAR == 1) { const float sk = P.sink[hq] * LOG2E; mref = __builtin_fmaxf(mref, sk); lrun = (hi == 0) ? __builtin_amdgcn_exp2f(sk - mref) : 0.f; }
        f32x16 negm = {};
        if (USE_NEGM) {
#pragma unroll
            for (int r = 0; r < 16; ++r) { pc0[r] -= mref; pc1[r] -= mref; negm[r] = -mref; }
        }
        float rmc = 0.f;
        bool need_c = true;
        __syncthreads();
        for (int t = 0; t < nt; ++t) {
            const bool hn = (t + 1 < nt);
            if (hn) { const int t2 = (t + 2 < nt) ? t + 2 : nt - 1; LOADK(t2); LOADV(t + 1); }
            const bool need_n = hn && NEED(t + 1);
            if (need_c && __any(rmc > THR)) {
                const float dl = __builtin_fmaxf(rmc, 0.f), f = __builtin_amdgcn_exp2f(-dl);
                mref += dl; lrun *= f;
#pragma unroll
                for (int r = 0; r < 16; ++r) { if (USE_NEGM) { pc0[r] -= dl; pc1[r] -= dl; negm[r] = -mref; } o0[r] *= f; o1[r] *= f; }
            }
            f32x16 pn0 = {}, pn1 = {};
            float rmn = -1e30f;
            if (VAR != 2 && need_c && need_n) {
                const LAS unsigned char* kt_ = lds + ((t + 1) & 1) * ABUF; const LAS unsigned char* vt_ = lds + (t & 1) * ABUF + KT_BYTES;
                bf16x8 kf[2 * ND0], vf[8]; u32x4 w0, w1, w2, w3; float sacc = 0.f;
#define KRD(d0) do { kf[2 * (d0)] = *(const LAS bf16x8*)(kt_ + r32 * KP + (d0) * 32 + hi * 16); kf[2 * (d0) + 1] = *(const LAS bf16x8*)(kt_ + (32 + r32) * KP + (d0) * 32 + hi * 16); } while (0)
#define VRD(kk) do { vf[2 * (kk)] = *(const LAS bf16x8*)(vt_ + r32 * VP + (kk) * 32 + hi * 16); vf[2 * (kk) + 1] = *(const LAS bf16x8*)(vt_ + (32 + r32) * VP + (kk) * 32 + hi * 16); } while (0)
#define EX4(Pv, a, W, lo) do { if (!USE_NEGM) { Pv[a] -= mref; Pv[a + 1] -= mref; Pv[a + 2] -= mref; Pv[a + 3] -= mref; } Pv[a] = __builtin_amdgcn_exp2f(Pv[a]); Pv[a + 1] = __builtin_amdgcn_exp2f(Pv[a + 1]); Pv[a + 2] = __builtin_amdgcn_exp2f(Pv[a + 2]); Pv[a + 3] = __builtin_amdgcn_exp2f(Pv[a + 3]); \
        sacc += Pv[a]; sacc += Pv[a + 1]; sacc += Pv[a + 2]; sacc += Pv[a + 3]; if (lo) { W.x = cvtpk(Pv[a], Pv[a + 1]); W.y = cvtpk(Pv[a + 2], Pv[a + 3]); } else { W.z = cvtpk(Pv[a], Pv[a + 1]); W.w = cvtpk(Pv[a + 2], Pv[a + 3]); } } while (0)
#define SB() __builtin_amdgcn_sched_barrier(0)
#define QKP(d0, C0, C1) do { pn0 = __builtin_amdgcn_mfma_f32_32x32x16_bf16(kf[2 * (d0)], qf[d0], C0, 0, 0, 0); pn1 = __builtin_amdgcn_mfma_f32_32x32x16_bf16(kf[2 * (d0) + 1], qf[d0], C1, 0, 0, 0); } while (0)
#define PVP(kk, W) do { const bf16x8 pb_ = __builtin_bit_cast(bf16x8, W); o0 = __builtin_amdgcn_mfma_f32_32x32x16_bf16(vf[2 * (kk)], pb_, o0, 0, 0, 0); o1 = __builtin_amdgcn_mfma_f32_32x32x16_bf16(vf[2 * (kk) + 1], pb_, o1, 0, 0, 0); } while (0)
#define KR1(j) (kf[j] = *(const LAS bf16x8*)(kt_ + (32 * ((j) & 1) + r32) * KP + ((j) >> 1) * 32 + hi * 16))
#define VR1(i) (vf[i] = *(const LAS bf16x8*)(vt_ + (32 * ((i) & 1) + r32) * VP + ((i) >> 1) * 32 + hi * 16))
#define EX2(Pv, a, Wd) do { Pv[a] = __builtin_amdgcn_exp2f(Pv[a]); Pv[a + 1] = __builtin_amdgcn_exp2f(Pv[a + 1]); sacc += Pv[a]; sacc += Pv[a + 1]; Wd = cvtpk(Pv[a], Pv[a + 1]); } while (0)
#define QK1(j, C) do { if ((j) & 1) pn1 = __builtin_amdgcn_mfma_f32_32x32x16_bf16(kf[j], qf[(j) >> 1], C, 0, 0, 0); else pn0 = __builtin_amdgcn_mfma_f32_32x32x16_bf16(kf[j], qf[(j) >> 1], C, 0, 0, 0); } while (0)
#define PV1(i, W) do { const bf16x8 pb_ = __builtin_bit_cast(bf16x8, W); if ((i) & 1) o1 = __builtin_amdgcn_mfma_f32_32x32x16_bf16(vf[i], pb_, o1, 0, 0, 0); else o0 = __builtin_amdgcn_mfma_f32_32x32x16_bf16(vf[i], pb_, o0, 0, 0, 0); } while (0)
                if (ND0 == 6) {
                    KR1(0); KR1(1); KR1(2); KR1(3); SB();
                    QK1(0, negm); EX2(pc0, 0, w0.x); KR1(4); SB();
                    QK1(1, negm); EX2(pc0, 2, w0.y); KR1(5); SB();
                    QK1(2, pn0); EX2(pc0, 4, w0.z); KR1(6); SB();
                    QK1(3, pn1); EX2(pc0, 6, w0.w); KR1(7); SB();
                    QK1(4, pn0); EX2(pc0, 8, w1.x); KR1(8); SB();
                    QK1(5, pn1); EX2(pc0, 10, w1.y); KR1(9); SB();
                    QK1(6, pn0); EX2(pc0, 12, w1.z); KR1(10); SB();
                    QK1(7, pn1); EX2(pc0, 14, w1.w); KR1(11); SB();
                    QK1(8, pn0); EX2(pc1, 0, w2.x); VR1(0); SB();
                    QK1(9, pn1); EX2(pc1, 2, w2.y); VR1(1); SB();
                    QK1(10, pn0); EX2(pc1, 4, w2.z); VR1(2); SB();
                    QK1(11, pn1); EX2(pc1, 6, w2.w); VR1(3); SB();
                } else {
                    KR1(0); KR1(1); KR1(2); KR1(3); SB();
                    QK1(0, negm); EX2(pc0, 0, w0.x); EX2(pc0, 2, w0.y); KR1(4); SB();
                    QK1(1, negm); EX2(pc0, 4, w0.z); EX2(pc0, 6, w0.w); KR1(5); SB();
                    QK1(2, pn0); EX2(pc0, 8, w1.x); EX2(pc0, 10, w1.y); KR1(6); SB();
                    QK1(3, pn1); EX2(pc0, 12, w1.z); EX2(pc0, 14, w1.w); KR1(7); SB();
                    QK1(4, pn0); EX2(pc1, 0, w2.x); VR1(0); SB();
                    QK1(5, pn1); EX2(pc1, 2, w2.y); VR1(1); SB();
                    QK1(6, pn0); EX2(pc1, 4, w2.z); VR1(2); SB();
                    QK1(7, pn1); EX2(pc1, 6, w2.w); VR1(3); SB();
                }
                PV1(0, w0); EX2(pc1, 8, w3.x); VR1(4); SB();
                PV1(1, w0); EX2(pc1, 10, w3.y); VR1(5); SB();
                PV1(2, w1); EX2(pc1, 12, w3.z); VR1(6); SB();
                PV1(3, w1); EX2(pc1, 14, w3.w); VR1(7); SB();
                lrun += sacc;
                PV1(4, w2); MASK_TILE(pn0, pn1, t + 1); SB();
                PV1(5, w2); SB();
                PV1(6, w3); SB();
                PV1(7, w3); rmn = rowmax32(pn0, pn1); if (!USE_NEGM) rmn -= mref; SB();
#undef KR1
#undef VR1
#undef EX2
#undef QK1
#undef PV1
#undef KRD
#undef VRD
#undef EX4
#undef SB
#undef QKP
#undef PVP
            } else {
            if (need_n) QK_TILE(pn0, pn1, (t + 1) & 1, negm);
            if (need_c) {
                float sum = 0.f;
#pragma unroll
                for (int r = 0; r < 16; ++r) { if (!USE_NEGM) { pc0[r] -= mref; pc1[r] -= mref; } pc0[r] = __builtin_amdgcn_exp2f(pc0[r]); pc1[r] = __builtin_amdgcn_exp2f(pc1[r]); sum += pc0[r]; sum += pc1[r]; }
                lrun += sum;
                bf16x8 pk[4];
                { u32x4 a; a.x = cvtpk(pc0[0], pc0[1]); a.y = cvtpk(pc0[2], pc0[3]); a.z = cvtpk(pc0[4], pc0[5]); a.w = cvtpk(pc0[6], pc0[7]); pk[0] = __builtin_bit_cast(bf16x8, a); }
                { u32x4 a; a.x = cvtpk(pc0[8], pc0[9]); a.y = cvtpk(pc0[10], pc0[11]); a.z = cvtpk(pc0[12], pc0[13]); a.w = cvtpk(pc0[14], pc0[15]); pk[1] = __builtin_bit_cast(bf16x8, a); }
                { u32x4 a; a.x = cvtpk(pc1[0], pc1[1]); a.y = cvtpk(pc1[2], pc1[3]); a.z = cvtpk(pc1[4], pc1[5]); a.w = cvtpk(pc1[6], pc1[7]); pk[2] = __builtin_bit_cast(bf16x8, a); }
                { u32x4 a; a.x = cvtpk(pc1[8], pc1[9]); a.y = cvtpk(pc1[10], pc1[11]); a.z = cvtpk(pc1[12], pc1[13]); a.w = cvtpk(pc1[14], pc1[15]); pk[3] = __builtin_bit_cast(bf16x8, a); }
                const LAS unsigned char* vt = lds + (t & 1) * ABUF + KT_BYTES;
#pragma unroll
                for (int kk = 0; kk < 4; ++kk) {
                    const bf16x8 v0 = *(const LAS bf16x8*)(vt + r32 * VP + kk * 32 + hi * 16);
                    const bf16x8 v1 = *(const LAS bf16x8*)(vt + (32 + r32) * VP + kk * 32 + hi * 16);
                    o0 = __builtin_amdgcn_mfma_f32_32x32x16_bf16(v0, pk[kk], o0, 0, 0, 0);
                    o1 = __builtin_amdgcn_mfma_f32_32x32x16_bf16(v1, pk[kk], o1, 0, 0, 0);
                }
            }
            if (need_n) { MASK_TILE(pn0, pn1, t + 1); rmn = rowmax32(pn0, pn1); if (!USE_NEGM) rmn -= mref; }
            }
            if (hn) { STOREK(t & 1); STOREV((t + 1) & 1); }
            __syncthreads();
            pc0 = pn0; pc1 = pn1; rmc = rmn; need_c = need_n;
        }
#undef TILE_KPOS
#undef LOADK
#undef LOADV
#undef STOREK
#undef STOREV
#undef NEED
#undef QK_TILE
#undef MASK_TILE
        const float lt = lrun + shfl_xor_l(lrun, 32, lane), inv = 1.f / lt;
        bf16_t* op = P.O + (size_t)(qrow + r32) * DM + hq * 64 + 4 * hi;
#pragma unroll
        for (int g = 0; g < 4; ++g) {
            u32x2 a; a.x = cvtpk(o0[4 * g] * inv, o0[4 * g + 1] * inv); a.y = cvtpk(o0[4 * g + 2] * inv, o0[4 * g + 3] * inv); *(u32x2*)(op + 8 * g) = a;
            u32x2 c; c.x = cvtpk(o1[4 * g] * inv, o1[4 * g + 1] * inv); c.y = cvtpk(o1[4 * g + 2] * inv, o1[4 * g + 3] * inv); *(u32x2*)(op + 32 + 8 * g) = c;
        }
    }
}

constexpr size_t MiB = 1u << 20;
constexpr size_t WS_BAR = 983040  ;
constexpr size_t WS_MOD = 0, WS_SSQ = 1 * MiB, WS_ROPE16 = 3 * MiB, WS_ROPE32 = 4 * MiB, WS_KPE = 6 * MiB, WS_XC = 12 * MiB;
constexpr size_t WS_W1T = 20 * MiB, WS_W2T = 52 * MiB, WS_MLA = 84 * MiB  , WS_SWA = 94 * MiB  , WS_NA = 99 * MiB  ;
constexpr size_t WS_H = 108 * MiB, WS_Q = 240 * MiB, WS_K = 438 * MiB, WS_VT = 570 * MiB, WS_O = 702 * MiB, WS_LAT = 702 * MiB, WS_HID = 240 * MiB, WS_NBIAS = 834 * MiB  , WS_SSQN = 836 * MiB  , WS_PART = 840 * MiB  , WS_END = 904 * MiB;

#define XB_TMO      128
#define XB_XCNT(j)  (256  + 64 * (j))
#define XB_XSUB(j)  (1280 + 64 * (j))
#define XB_XGEN(j)  (2304 + 64 * (j))
#define XB_TOP      3328
#define XB_TOPGEN   3392
#define XCD_BAR_WORDS 3456
#define XB_SPIN_CAP (1u << 18)
__device__ __forceinline__ unsigned xb_ld(unsigned* p)              { return __hip_atomic_load(p, __ATOMIC_RELAXED, __HIP_MEMORY_SCOPE_AGENT); }
__device__ __forceinline__ unsigned xb_add(unsigned* p, unsigned v) { return __hip_atomic_fetch_add(p, v, __ATOMIC_RELAXED, __HIP_MEMORY_SCOPE_AGENT); }
__device__ __forceinline__ unsigned xb_xcc_id() { return (unsigned)__builtin_amdgcn_s_getreg((3 << 11) | 20) & 0xFu; }
#define XB_SPIN(cond, bar) do { unsigned _sp = 0; while (cond) { __builtin_amdgcn_s_sleep(1); \
    if ((++_sp & 255u) == 0u) { if (xb_ld(&(bar)[XB_TMO])) break; if (_sp > XB_SPIN_CAP) { atomicAdd(&(bar)[XB_TMO], 1u); break; } } } } while (0)
struct XcdBarrier { unsigned* bar; unsigned x; volatile LAS unsigned* st; };
__device__ __forceinline__ XcdBarrier xcd_barrier_post(unsigned* bar, volatile LAS unsigned* st, bool t0) {
    XcdBarrier b; b.bar = bar; b.x = xb_xcc_id(); b.st = st;
    if (t0) (void)xb_add(&bar[XB_XCNT(b.x)], 1u);
    return b;
}
__device__ __forceinline__ void xcd_barrier_complete(unsigned* bar, unsigned x, unsigned& nloc, unsigned& nx) {
    const unsigned G = gridDim.x * gridDim.y * gridDim.z;
    unsigned sum, cnt, mine, sp = 0u;
    for (;;) {
        sum = 0u; cnt = 0u; mine = 0u;
#pragma unroll
        for (unsigned j = 0; j < 16; ++j) { const unsigned c = xb_ld(&bar[XB_XCNT(j)]); sum += c; cnt += (c > 0u) ? 1u : 0u; mine = (j == x) ? c : mine; }
        if (sum == G) break;
        __builtin_amdgcn_s_sleep(1);
        if ((++sp & 255u) == 0u) { if (xb_ld(&bar[XB_TMO])) break; if (sp > XB_SPIN_CAP) { atomicAdd(&bar[XB_TMO], 1u); break; } }
    }
    nloc = mine > 0u ? mine : 1u; nx = cnt > 0u ? cnt : 1u;
}
__device__ __forceinline__ void xcd_barrier(const XcdBarrier& b, bool t0) {
    asm volatile("s_waitcnt vmcnt(0)" ::: "memory");
    __syncthreads();
    if (t0) {
        unsigned* bar = b.bar; unsigned bx = b.x; asm volatile("" : "+s"(bar), "+s"(bx));
        __builtin_amdgcn_s_waitcnt(0);
        unsigned nloc = b.st[0], nx = b.st[1];
        if (nloc == 0u) { xcd_barrier_complete(bar, bx, nloc, nx); b.st[0] = nloc; b.st[1] = nx; }
        const unsigned old = xb_add(&bar[XB_XSUB(bx)], 1u);
        const unsigned gen = old / nloc;
        if (old + 1u == (gen + 1u) * nloc) {
            __builtin_amdgcn_fence(__ATOMIC_RELEASE, "agent");
            asm volatile("s_waitcnt vmcnt(0)" ::: "memory");
            const unsigned og = xb_add(&bar[XB_TOP], 1u);
            const unsigned tg = og / nx;
            if (og + 1u == (tg + 1u) * nx) xb_add(&bar[XB_TOPGEN], 1u);
            else XB_SPIN(xb_ld(&bar[XB_TOPGEN]) == tg, bar);
            __builtin_amdgcn_fence(__ATOMIC_ACQUIRE, "agent");
            xb_add(&bar[XB_XGEN(bx)], 1u);
            asm volatile("s_waitcnt vmcnt(0)" ::: "memory");
        } else {
            XB_SPIN(xb_ld(&bar[XB_XGEN(bx)]) == gen, bar);
            __builtin_amdgcn_fence(__ATOMIC_ACQUIRE, "agent");
            asm volatile("s_waitcnt vmcnt(0)" ::: "memory");
        }
    }
    __syncthreads();
}

__device__ __forceinline__ float wave_sum(float v, int lane) {
#pragma unroll
    for (int o = 1; o < 64; o <<= 1) v += shfl_xor_l(v, o, lane);
    return v;
}
__device__ __forceinline__ void sincos_red(float x, float& sn, float& cs) {
    const float n = rintf(x * 0.15915494309189535f);
    float r = fmaf(-n, 6.2831854820251465f, x); r = fmaf(-n, -1.7484555e-7f, r);
    const float rev = r * 0.15915494309189535f;
    sn = __builtin_amdgcn_sinf(rev); cs = __builtin_amdgcn_cosf(rev);
}
__device__ __forceinline__ void transpose_item(const float* W, int K, int N, bf16_t* WT, const float* g, LAS float* scr, int item, int lane) {
    const int nblk = N / 32, kb = item / nblk, nb = item % nblk, k0 = 64 * kb, n0 = 32 * nb;
#pragma unroll 8
    for (int i = 0; i < 32; ++i) { const int kk = 2 * i + (lane >> 5); float v = W[(size_t)(k0 + kk) * N + n0 + (lane & 31)]; if (g) v *= g[k0 + kk]; scr[kk * 33 + (lane & 31)] = v; }
    asm volatile("s_waitcnt lgkmcnt(0)" ::: "memory");
    const int c = lane & 7;
#pragma unroll
    for (int j = 0; j < 4; ++j) { const int n = (lane >> 3) + 8 * j; const LAS float* s = scr + (8 * c) * 33 + n;
        u32x4 o; o.x = cvtpk(s[0 * 33], s[1 * 33]); o.y = cvtpk(s[2 * 33], s[3 * 33]); o.z = cvtpk(s[4 * 33], s[5 * 33]); o.w = cvtpk(s[6 * 33], s[7 * 33]);
        *(u32x4*)(WT + (size_t)(n0 + n) * K + k0 + 8 * c) = o; }
    asm volatile("s_waitcnt lgkmcnt(0)" ::: "memory");
}

struct Args { const float* in[23]; float* out; unsigned char* ws; };

__device__ __forceinline__ void norm_pass0(const float* xl, const float* xc, const float* g, const float* mod, int sc_off, bf16_t* H, float* ssq, int gw, int NGW) {
    int lane = lane_id(); asm volatile("" : "+v"(lane));
    for (int row = gw; row < MT; row += NGW) {
        const bool isctx = row >= ML;
        const float* xr = isctx ? xc + (size_t)(row - ML) * DM : xl + (size_t)row * DM;
        const float* mp = mod + (isctx ? 8 : (row >> 13)) * 6144;
        f32x4 v[4]; float ss = 0.f;
#pragma unroll
        for (int j = 0; j < 4; ++j) { v[j] = *(const f32x4*)(xr + 4 * lane + 256 * j); ss += (v[j][0] * v[j][0] + v[j][1] * v[j][1]) + (v[j][2] * v[j][2] + v[j][3] * v[j][3]); }
        ss = wave_sum(ss, lane);
        if (lane == 0) ssq[row] = ss;
#pragma unroll
        for (int j = 0; j < 4; ++j) { const int col = 4 * lane + 256 * j;
            const f32x4 gg = *(const f32x4*)(g + col), sc = *(const f32x4*)(mp + sc_off + col);
            const f32x4 y = v[j] * gg * (sc + 1.f);
            u32x2 o; o.x = cvtpk(y[0], y[1]); o.y = cvtpk(y[2], y[3]); *(u32x2*)(H + (size_t)row * DM + col) = o; }
    }
}
__device__ __forceinline__ void norm_ctx(float* xc, const float* part, const float* gate8, const float* g, const float* sc, bf16_t* Hc, float* ssqc, int gw, int NGW) {
    int lane = lane_id(); asm volatile("" : "+v"(lane));
    for (int row = gw; row < MC; row += NGW) {
        float* xr = xc + (size_t)row * DM;
        f32x4 v[4]; float ss = 0.f;
#pragma unroll
        for (int j = 0; j < 4; ++j) { const int col = 4 * lane + 256 * j;
            f32x4 p = *(const f32x4*)(part + (size_t)row * DM + col);
#pragma unroll
            for (int kc = 1; kc < 8; ++kc) p += *(const f32x4*)(part + ((size_t)kc * MC + row) * DM + col);
            v[j] = *(const f32x4*)(xr + col) + *(const f32x4*)(gate8 + col) * p;
            *(f32x4*)(xr + col) = v[j];
            ss += (v[j][0] * v[j][0] + v[j][1] * v[j][1]) + (v[j][2] * v[j][2] + v[j][3] * v[j][3]); }
        ss = wave_sum(ss, lane);
        if (lane == 0) ssqc[row] = ss;
#pragma unroll
        for (int j = 0; j < 4; ++j) { const int col = 4 * lane + 256 * j;
            const f32x4 gg = *(const f32x4*)(g + col), s4 = *(const f32x4*)(sc + col);
            const f32x4 y = v[j] * gg * (s4 + 1.f);
            u32x2 o; o.x = cvtpk(y[0], y[1]); o.y = cvtpk(y[2], y[3]); *(u32x2*)(Hc + (size_t)row * DM + col) = o; }
    }
}
__device__ __forceinline__ void nbias_item(LAS unsigned char* lds, const float* W, int N, int n0, const float* mod, int sh_off, float* out, int wave, int lane) {
    LAS float* shl = (LAS float*)(lds + 65536); LAS float* red = (LAS float*)(lds + 102400);
    const int tid = wave * 64 + lane;
    for (int i = tid; i < 9 * 1024; i += 512) shl[i] = mod[(i >> 10) * 6144 + sh_off + (i & 1023)];
    __syncthreads();
    const int n = n0 + lane; const bool ok = n < N;
    const float* Wp = W + (ok ? n : 0);
    float s0 = 0, s1 = 0, s2 = 0, s3 = 0, s4 = 0, s5 = 0, s6 = 0, s7 = 0, s8 = 0;
#pragma unroll 8
    for (int k = wave * 128; k < wave * 128 + 128; ++k) { const float wv = Wp[(size_t)k * N];
        s0 += shl[k] * wv; s1 += shl[1024 + k] * wv; s2 += shl[2048 + k] * wv; s3 += shl[3072 + k] * wv; s4 += shl[4096 + k] * wv;
        s5 += shl[5120 + k] * wv; s6 += shl[6144 + k] * wv; s7 += shl[7168 + k] * wv; s8 += shl[8192 + k] * wv; }
    LAS float* rp = red + wave * 576 + lane;
    rp[0] = s0; rp[64] = s1; rp[128] = s2; rp[192] = s3; rp[256] = s4; rp[320] = s5; rp[384] = s6; rp[448] = s7; rp[512] = s8;
    __syncthreads();
    for (int i = tid; i < 576; i += 512) { float sum = 0.f;
#pragma unroll
        for (int ww = 0; ww < 8; ++ww) sum += red[ww * 576 + i];
        const int b = i >> 6, l = i & 63; if (n0 + l < N) out[b * 4096 + n0 + l] = sum; else if (n0 + l < 4096) out[b * 4096 + n0 + l] = 0.f; }
    __syncthreads();
}

__global__ void __launch_bounds__(512, 2) fwd_megakernel(Args a) {
    extern __shared__ __attribute__((aligned(16))) unsigned char lds_raw[];
    LAS unsigned char* lds = (LAS unsigned char*)lds_raw;
    cg::grid_group grid = cg::this_grid();
    const int wave = __builtin_amdgcn_readfirstlane((int)threadIdx.x >> 6);
    const int G = gridDim.x, bid = blockIdx.x;
    const int vcu = (G % 8 == 0) ? (bid % 8) * (G / 8) + bid / 8 : bid;
    const int gw = vcu * 8 + wave, NGW = G * 8;
    unsigned char* ws = a.ws;
    volatile LAS unsigned* bar_st = (volatile LAS unsigned*)(lds + 131072 + 64);
    if (wave == 0 && lane_id() < 2) bar_st[lane_id()] = 0u;
    __syncthreads();
    XcdBarrier xbar = xcd_barrier_post((unsigned*)(ws + WS_BAR), bar_st, wave == 0 && lane_id() == 0);
#define GRID_BAR() xcd_barrier(xbar, wave == 0 && lane_id() == 0)
    const float* x_in = a.in[0]; const float* c_in = a.in[1]; const float* ctx_in = a.in[2]; const float* cctx_in = a.in[3];
    const float* ada_w = a.in[4]; const float* ada_b = a.in[5]; const float* norm_mix_g = a.in[6]; const float* norm_mlp_g = a.in[7]; const float* norm_out_g = a.in[8];
    float* MOD = (float*)(ws + WS_MOD); float* SSQ = (float*)(ws + WS_SSQ);
    float* ROPE16 = (float*)(ws + WS_ROPE16); float* ROPE32 = (float*)(ws + WS_ROPE32);
    bf16_t* KPE = (bf16_t*)(ws + WS_KPE); float* XC = (float*)(ws + WS_XC);
    bf16_t* H = (bf16_t*)(ws + WS_H); bf16_t* Qb = (bf16_t*)(ws + WS_Q); bf16_t* Kb = (bf16_t*)(ws + WS_K); bf16_t* VTb = (bf16_t*)(ws + WS_VT);
    bf16_t* Ob = (bf16_t*)(ws + WS_O); bf16_t* LAT = (bf16_t*)(ws + WS_LAT); bf16_t* HID = (bf16_t*)(ws + WS_HID);
    float* X = a.out;
    float* NBIAS = (float*)(ws + WS_NBIAS); float* SSQN = (float*)(ws + WS_SSQN); float* PART = (float*)(ws + WS_PART);

    {
        const int lane = lane_id(), tid = wave * 64 + lane;
        LAS float* act = (LAS float*)(lds + 65536); LAS float* red = (LAS float*)(lds + 102400);
        for (int i = tid; i < 9 * 1024; i += 512) { const int b = i >> 10, k = i & 1023; const float v = b < 8 ? c_in[b * 1024 + k] : cctx_in[k]; act[i] = v / (1.f + __builtin_amdgcn_exp2f(-v * LOG2E)); }
        __syncthreads();
        for (int it = bid; it < 384; it += G) {
            const int layer = it / 96, n0 = (it % 96) * 64;
            const float* W = ada_w + (size_t)layer * 1024 * 6144 + n0 + lane;
            float s0 = 0, s1 = 0, s2 = 0, s3 = 0, s4 = 0, s5 = 0, s6 = 0, s7 = 0, s8 = 0;
#pragma unroll 8
            for (int k = wave * 128; k < wave * 128 + 128; ++k) { const float wv = W[(size_t)k * 6144];
                s0 += act[k] * wv; s1 += act[1024 + k] * wv; s2 += act[2048 + k] * wv; s3 += act[3072 + k] * wv; s4 += act[4096 + k] * wv;
                s5 += act[5120 + k] * wv; s6 += act[6144 + k] * wv; s7 += act[7168 + k] * wv; s8 += act[8192 + k] * wv; }
            LAS float* rp = red + wave * 576 + lane;
            rp[0] = s0; rp[64] = s1; rp[128] = s2; rp[192] = s3; rp[256] = s4; rp[320] = s5; rp[384] = s6; rp[448] = s7; rp[512] = s8;
            __syncthreads();
            for (int i = tid; i < 576; i += 512) { float s = 0.f;
#pragma unroll
                for (int ww = 0; ww < 8; ++ww) s += red[ww * 576 + i];
                const int b = i >> 6, l = i & 63; MOD[((size_t)layer * 9 + b) * 6144 + n0 + l] = s + ada_b[layer * 6144 + n0 + l]; }
            __syncthreads();
        }
        __syncthreads();
        LAS float* scr = (LAS float*)(lds + wave * 16384);
        int base = 0;
#define TR(Wsrc, K_, N_, dst, gsc) do { const int n_ = ((K_) / 64) * ((N_) / 32); \
            for (int it_ = (gw + NGW - (base % NGW)) % NGW; it_ < n_; it_ += NGW) transpose_item((Wsrc), (K_), (N_), (dst), (gsc), scr, it_, lane); base += n_; } while (0)
        for (int L = 0; L < 4; ++L) {
            TR(a.in[9] + (size_t)L * DM * FF, DM, FF, (bf16_t*)(ws + WS_W1T + (size_t)L * 8 * MiB), (const float*)nullptr);
            TR(a.in[10] + (size_t)L * FF * DM, FF, DM, (bf16_t*)(ws + WS_W2T + (size_t)L * 8 * MiB), (const float*)nullptr);
        }
        for (int j = 0; j < 2; ++j) {
            unsigned char* mb = ws + WS_MLA + (size_t)j * 5 * MiB;
            TR(a.in[11] + (size_t)j * DM * 416, DM, 416, (bf16_t*)mb, (const float*)nullptr);
            TR(a.in[13] + (size_t)j * 256 * 1536, 256, 1536, (bf16_t*)(mb + 1 * MiB), a.in[12] + j * 256);
            TR(a.in[15] + (size_t)j * 128 * 2048, 128, 2048, (bf16_t*)(mb + 1 * MiB + 768 * 1024), a.in[14] + j * 128);
            TR(a.in[16] + (size_t)j * DM * DM, DM, DM, (bf16_t*)(mb + 3 * MiB), (const float*)nullptr);
            u32x4* z = (u32x4*)(mb + (size_t)416 * 1024 * 2);
            for (int i = gw * 64 + lane; i < 96 * 1024 * 2 / 16; i += NGW * 64) z[i] = (u32x4){0u, 0u, 0u, 0u};
        }
        TR(a.in[17], DM, 1536, (bf16_t*)(ws + WS_SWA), (const float*)nullptr);
        TR(a.in[19], DM, DM, (bf16_t*)(ws + WS_SWA + 3 * MiB), (const float*)nullptr);
        TR(a.in[20], DM, 3072, (bf16_t*)(ws + WS_NA), (const float*)nullptr);
        TR(a.in[22], DM, DM, (bf16_t*)(ws + WS_NA + 6 * MiB), (const float*)nullptr);
#undef TR
        for (int i = gw * 64 + lane; i < 8192 * 16; i += NGW * 64) { const int t = i >> 4, p = i & 15; const int f = p & 7; const float pos = (float)(p < 8 ? (t >> 6) : (t & 63));
            const float ang = pos * __builtin_amdgcn_exp2f(-(float)f * (13.287712379549449f / 8.f)); float sn, cs; sincos_red(ang, sn, cs); ROPE16[2 * i] = cs; ROPE16[2 * i + 1] = sn; }
        for (int i = gw * 64 + lane; i < 8192 * 32; i += NGW * 64) { const int t = i >> 5, p = i & 31; const int f = p & 15; const float pos = (float)(p < 16 ? (t >> 6) : (t & 63));
            const float ang = pos * __builtin_amdgcn_exp2f(-(float)f * (13.287712379549449f / 16.f)); float sn, cs; sincos_red(ang, sn, cs); ROPE32[2 * i] = cs; ROPE32[2 * i + 1] = sn; }
        for (int i = gw * 64 + lane; i < 4 * MT; i += NGW * 64) SSQ[i] = 0.f;
        for (int i = gw * 64 + lane; i < 8 * MT; i += NGW * 64) SSQN[i] = 0.f;
    }
    grid.sync();
    {
        const int lane = lane_id();
        for (int it = bid; it < 8 + 24 + 48 + 8 + 256; it += G) {
            int r = it; const float* W; int N, L, which, blk;
            if (r < 8) { W = a.in[11]; N = 416; L = 0; which = 0; blk = r; }
            else if ((r -= 8) < 24) { W = a.in[17]; N = 1536; L = 1; which = 0; blk = r; }
            else if ((r -= 24) < 48) { W = a.in[20]; N = 3072; L = 2; which = 0; blk = r; }
            else if ((r -= 48) < 8) { W = a.in[11] + (size_t)DM * 416; N = 416; L = 3; which = 0; blk = r; }
            else { r -= 8; L = r >> 6; blk = r & 63; W = a.in[9] + (size_t)L * DM * FF; N = FF; which = 1; }
            nbias_item(lds, W, N, blk * 64, MOD + (size_t)L * 9 * 6144, which ? 3072 : 0, NBIAS + (size_t)(L * 2 + which) * 9 * 4096, wave, lane);
        }
        norm_pass0(x_in, ctx_in, norm_mix_g, MOD, 1024, H, SSQN, gw, NGW);
        for (int i = gw * 64 + lane; i < MC * DM / 4; i += NGW * 64) ((f32x4*)XC)[i] = ((const f32x4*)ctx_in)[i];
    }
    GRID_BAR();

    for (int L = 0; L < 4; ++L) {
        const int kind = L % 3, jl = L / 3; const bool last = (L == 3);
        const float* modL = MOD + (size_t)L * 9 * 6144;
        const float* xl = (L == 0) ? x_in : X; const float* xc = (L == 0) ? ctx_in : XC;
        const float* ssqn1 = SSQN + (size_t)(2 * L) * MT; const float* nbias1 = NBIAS + (size_t)(L * 2) * 9 * 4096;
        if (kind == 0) {
            unsigned char* mb = ws + WS_MLA + (size_t)jl * 5 * MiB;
            float* ssq_q = SSQ + (size_t)jl * 2 * MT; float* ssq_kv = ssq_q + MT;
            {
                pg8::Gemm g{H, (const bf16_t*)mb, MT, 512, DM, DM, DM}; pg8::StaticOrder S; S.init(MT, 512, G, bid);
                EpiLat E{LAT, ssq_q, ssq_kv, KPE, ROPE16, ssqn1, nbias1};
                pg8::gemm_phase<EpiLat, pg8::StaticOrder, true>(lds, g, S, E, wave);
            }
            GRID_BAR();
            {
                pg8::Gemm g{LAT, (const bf16_t*)(mb + 1 * MiB), MT, 1536, 256, 512, 256}; pg8::StaticOrder S; S.init(MT, 1536, G, bid);
                EpiProj<0> E{Qb, nullptr, nullptr, ROPE16, ssq_q, 0.10206207261596577f * LOG2E, nullptr};
                pg8::gemm_phase<EpiProj<0>, pg8::StaticOrder, true>(lds, g, S, E, wave);
            }
            {
                pg8::Gemm g{LAT + 256, (const bf16_t*)(mb + 1 * MiB + 768 * 1024), MT, 2048, 128, 512, 128}; pg8::StaticOrder S; S.init(MT, 2048, G, bid);
                EpiProj<1> E{nullptr, Kb, VTb, nullptr, ssq_kv, 1.f, nullptr};
                pg8::gemm_phase<EpiProj<1>, pg8::StaticOrder, true>(lds, g, S, E, wave);
            }
        } else if (kind == 1) {
            pg8::Gemm g{H, (const bf16_t*)(ws + WS_SWA), MT, 1536, DM, DM, DM}; pg8::StaticOrder S; S.init(MT, 1536, G, bid);
            EpiProj<2> E{Qb, Kb, VTb, ROPE32, ssqn1, 0.125f * LOG2E, nbias1};
            pg8::gemm_phase<EpiProj<2>, pg8::StaticOrder, true>(lds, g, S, E, wave);
        } else {
            pg8::Gemm g{H, (const bf16_t*)(ws + WS_NA), MT, 3072, DM, DM, DM}; pg8::StaticOrder S; S.init(MT, 3072, G, bid);
            EpiProj<3> E{Qb, Kb, VTb, nullptr, ssqn1, 0.125f * LOG2E, nbias1};
            pg8::gemm_phase<EpiProj<3>, pg8::StaticOrder, true>(lds, g, S, E, wave);
        }
        GRID_BAR();
        {
            AttnP P{Qb, Kb, KPE, VTb, Ob, a.in[18], a.in[21], last ? 4096 : 4096 + 128};
            if (kind == 0) attn_phase<0>(lds, P, vcu, G, wave);
            else if (kind == 1) attn_phase<1>(lds, P, vcu, G, wave);
            else attn_phase<2>(lds, P, vcu, G, wave);
        }
        GRID_BAR();
        const int Mres = last ? ML : MT;
        {
            const bf16_t* wo = (const bf16_t*)(kind == 0 ? ws + WS_MLA + (size_t)jl * 5 * MiB + 3 * MiB : (kind == 1 ? ws + WS_SWA + 3 * MiB : ws + WS_NA + 6 * MiB));
            {
                pg8::Gemm g{Ob, wo, ML, DM, DM, DM, DM}; pg8::StaticOrder S; S.init(ML, DM, G, bid);
                EpiResid E{xl, XC, X, XC, modL + 2048, H, norm_mlp_g + L * DM, modL + 4096, SSQN + (size_t)(2 * L + 1) * MT};
                pg8::gemm_phase<EpiResid, pg8::StaticOrder, true>(lds, g, S, E, wave);
            }
            if (!last) {
                pg8::Gemm g{Ob, wo, MT, DM, 128, DM, DM}; pg8::CtxSplitOrder S{bid, G, 128};
                EpiCtxPartial E{PART, 128};
                pg8::gemm_phase<EpiCtxPartial, pg8::CtxSplitOrder, true>(lds, g, S, E, wave);
            }
        }
        GRID_BAR();
        if (!last) { norm_ctx(XC, PART, modL + 2048 + 8 * 6144, norm_mlp_g + L * DM, modL + 8 * 6144 + 4096, H + (size_t)ML * DM, SSQN + (size_t)(2 * L + 1) * MT + ML, gw, NGW); GRID_BAR(); }
        {
            pg8::Gemm g{H, (const bf16_t*)(ws + WS_W1T + (size_t)L * 8 * MiB), Mres, FF, DM, DM, DM}; pg8::StaticOrder S; S.init(Mres, FF, G, bid);
            EpiSqRelu E{HID, FF, SSQN + (size_t)(2 * L + 1) * MT, NBIAS + (size_t)(L * 2 + 1) * 9 * 4096};
            pg8::gemm_phase<EpiSqRelu, pg8::StaticOrder, true>(lds, g, S, E, wave);
        }
        GRID_BAR();
        {
            const bf16_t* w2t = (const bf16_t*)(ws + WS_W2T + (size_t)L * 8 * MiB);
            {
                pg8::Gemm g{HID, w2t, ML, DM, FF, FF, FF}; pg8::StaticOrder S; S.init(ML, DM, G, bid);
                EpiResid E{X, XC, X, XC, modL + 5120, last ? nullptr : H, norm_mix_g + (L + 1) * DM, MOD + (size_t)(L + 1) * 9 * 6144 + 1024, SSQN + (size_t)(2 * L + 2) * MT};
                pg8::gemm_phase<EpiResid, pg8::StaticOrder, true>(lds, g, S, E, wave);
            }
            if (!last) {
                pg8::Gemm g{HID, w2t, MT, DM, 512, FF, FF}; pg8::CtxSplitOrder S{bid, G, 512};
                EpiCtxPartial E{PART, 512};
                pg8::gemm_phase<EpiCtxPartial, pg8::CtxSplitOrder, true>(lds, g, S, E, wave);
            }
        }
        GRID_BAR();
        if (!last) { norm_ctx(XC, PART, modL + 5120 + 8 * 6144, norm_mix_g + (L + 1) * DM, MOD + (size_t)(L + 1) * 9 * 6144 + 8 * 6144 + 1024, H + (size_t)ML * DM, SSQN + (size_t)(2 * L + 2) * MT + ML, gw, NGW); GRID_BAR(); }
    }
    int lane = lane_id(); asm volatile("" : "+v"(lane));
    for (int row = gw; row < ML; row += NGW) {
        float* xr = X + (size_t)row * DM;
        f32x4 v[4]; float ss = 0.f;
#pragma unroll
        for (int j = 0; j < 4; ++j) { v[j] = *(const f32x4*)(xr + 4 * lane + 256 * j); ss += (v[j][0] * v[j][0] + v[j][1] * v[j][1]) + (v[j][2] * v[j][2] + v[j][3] * v[j][3]); }
        const float rstd = rsqrtf(wave_sum(ss, lane) * (1.f / DM) + EPS);
#pragma unroll
        for (int j = 0; j < 4; ++j) { const int col = 4 * lane + 256 * j; const f32x4 gg = *(const f32x4*)(norm_out_g + col); *(f32x4*)(xr + col) = v[j] * rstd * gg; }
    }
}

constexpr int LDS_BYTES = 147456;
extern "C" void kernel_launch(void* const* d_in, const int* in_sizes, int n_in, void* d_out, int out_size, void* d_ws, size_t ws_size, hipStream_t stream) {
    static int grid = 0;
    if (grid == 0) {
        if (n_in != 23 || out_size != ML * DM || ws_size < WS_END) { fprintf(stderr, "kernel_launch: unexpected shapes (n_in %d out %d ws %zu)\n", n_in, out_size, ws_size); grid = -1; return; }
        int dev = 0, cus = 0, per_cu = 0;
        hipGetDevice(&dev); hipDeviceGetAttribute(&cus, hipDeviceAttributeMultiprocessorCount, dev);
        if (hipFuncSetAttribute((const void*)fwd_megakernel, hipFuncAttributeMaxDynamicSharedMemorySize, LDS_BYTES) != hipSuccess) { fprintf(stderr, "kernel_launch: hipFuncSetAttribute failed\n"); grid = -1; return; }
        if (hipOccupancyMaxActiveBlocksPerMultiprocessor(&per_cu, (const void*)fwd_megakernel, 512, LDS_BYTES) != hipSuccess || per_cu < 1) { fprintf(stderr, "kernel_launch: occupancy query gave %d\n", per_cu); per_cu = 1; }
        (void)hipGetLastError();
        grid = cus * per_cu;
    }
    if (grid < 0) return;
    if (hipMemsetAsync((char*)d_ws + WS_BAR, 0, XCD_BAR_WORDS * 4, stream) != hipSuccess) { fprintf(stderr, "kernel_launch: memset of the barrier words failed\n"); return; }
    Args a{};
    for (int i = 0; i < 23; ++i) a.in[i] = (const float*)d_in[i];
    a.out = (float*)d_out; a.ws = (unsigned char*)d_ws;
    void* args[] = {&a};
    hipError_t e = hipLaunchCooperativeKernel((const void*)fwd_megakernel, dim3(grid), dim3(512), args, LDS_BYTES, stream);
    if (e != hipSuccess) fprintf(stderr, "cooperative launch failed: %s (grid %d)\n", hipGetErrorString(e), grid);
}
```

```cpp
#include <hip/hip_runtime.h>
#include <hip/hip_cooperative_groups.h>
#include <cstdio>
#include <cstdint>
namespace cg = cooperative_groups;

#define LAS __attribute__((address_space(3)))
typedef unsigned short bf16_t;
typedef short bf16x8 __attribute__((ext_vector_type(8)));
typedef float f32x4 __attribute__((ext_vector_type(4)));
typedef float f32x16 __attribute__((ext_vector_type(16)));
typedef unsigned u32x4 __attribute__((ext_vector_type(4)));
typedef unsigned u32x2 __attribute__((ext_vector_type(2)));

constexpr int NB = 8, SEQ = 8192, DM = 1024, CTX = 256, FF = 4096;
constexpr int ML = NB * SEQ;
constexpr int MC = NB * CTX;
constexpr int MT = ML + MC;
constexpr int KVLEN = CTX + SEQ;
constexpr float EPS = 1e-6f;
constexpr float LOG2E = 1.4426950408889634f;

__device__ __forceinline__ unsigned cvtpk(float lo, float hi) {
    typedef float f2 __attribute__((ext_vector_type(2))); typedef __bf16 b2 __attribute__((ext_vector_type(2)));
    f2 v = {lo, hi}; b2 b = __builtin_convertvector(v, b2); return __builtin_bit_cast(unsigned, b);
}
__device__ __forceinline__ int lane_id() { int l; asm volatile("v_mbcnt_lo_u32_b32 %0, -1, 0\n\tv_mbcnt_hi_u32_b32 %0, -1, %0" : "=v"(l)); return l; }
__device__ __forceinline__ float shfl_xor_l(float v, int mask, int lane) { return __int_as_float(__builtin_amdgcn_ds_bpermute((lane ^ mask) << 2, __float_as_int(v))); }
__device__ __forceinline__ int perm16(int x) { return 8 * ((x >> 2) & 1) + (x & 3) + 4 * (x >> 3); }

namespace pg8 {
constexpr int BM = 256, BK = 64, HALF = 128, HTB = HALF * BK * 2, STAGE_BYTES = 8 * HTB, NXCD = 8, WGM = 8;
__host__ __device__ __forceinline__ int lds_byte(int r, int c) { const int st = (r >> 4) * 2 + (c >> 5), rr = r & 15, cc = c & 31, ob = rr * 64 + cc * 2; return st * 1024 + (ob ^ (((ob >> 9) & 1) << 5)); }
__host__ __device__ __forceinline__ void stage_rc(int b, int& R, int& C) { const int st = b / 1024, sb = b % 1024, swz = sb ^ (((sb >> 9) & 1) << 5); R = (st >> 1) * 16 + swz / 64; C = (st & 1) * 32 + (swz % 64) / 2; }
__host__ __device__ __forceinline__ int perm32(int rho) { const int n = rho >> 4, i = rho & 15; return 8 * (i >> 2) + 4 * n + (i & 3); }

struct Unit { int pm, pn, koff; };
struct Gemm { const bf16_t* A; const bf16_t* Bt; int M, N, K, lda, ldb; };

struct StaticOrder {
    int nM, nN, nwg, G, c;
    __device__ void init(int M, int N, int G_, int c_) { nM = M / BM; nN = N / BM; nwg = nM * nN; G = G_; c = c_; }
    __device__ bool next(int i, Unit& u) const {
        const long L = (long)i * G + c; if (L >= nwg) return false;
        int wgid = (int)L; { const int q = nwg / NXCD, r = nwg % NXCD, xcd = wgid % NXCD, off = wgid / NXCD; wgid = (xcd < r ? xcd * (q + 1) : r * (q + 1) + (xcd - r) * q) + off; }
        const int nig = WGM * nN, gid = wgid / nig, fm = gid * WGM, gsz = (nM - fm) < WGM ? (nM - fm) : WGM;
        u.pm = fm + ((wgid % nig) % gsz); u.pn = (wgid % nig) / gsz; u.koff = 0; return true;
    }
};

struct CtxSplitOrder {
    int c, G, kchunk;
    __device__ bool next(int i, Unit& u) const { const int L = i * G + c; if (L >= 256) return false; u.pm = 256 + (L >> 5); u.pn = (L >> 3) & 3; u.koff = (L & 7) * kchunk; return true; }
};

template <class Epi, class Sched, bool ALIGN_EPI>
__device__ __forceinline__ void gemm_phase(LAS unsigned char* lds, const Gemm g, const Sched& S, const Epi& E, int wave_s) {
    int tid_l = wave_s * 64 + lane_id(); asm volatile("" : "+v"(tid_l));
    const int tid = tid_l, wid = __builtin_amdgcn_readfirstlane(tid >> 6), lane = tid & 63, wr = wid >> 2, wc = wid & 3, fr = lane & 15, fq = lane >> 4;
    const int K = g.K, nt = K / BK;
    unsigned voffA[2], voffB[2];
#pragma unroll
    for (int i = 0; i < 2; ++i) { int R, C; stage_rc(tid * 16 + i * 8192, R, C); const int Rb = Epi::PERM ? ((R & ~31) + perm32(R & 31)) : R;
        voffA[i] = (unsigned)(R * g.lda + C) * 2u; voffB[i] = (unsigned)(Rb * g.ldb + C) * 2u; }
    const size_t kstep = (size_t)(BK * 2);
    const size_t hstepA = (size_t)HALF * g.lda * 2, hstepB = (size_t)HALF * g.ldb * 2;
    const size_t tstepA = 2 * hstepA, tstepB = 2 * hstepB;
    const unsigned ldsw = (unsigned)wid * 1024u;
    const int aoff = lds_byte(wr * 64 + fr, fq * 8), boff = lds_byte(wc * 32 + fr, fq * 8);
#define PG8_SA(b, h) (((b) * 2 + (h)) * HTB)
#define PG8_SB(b, h) ((4 + (b) * 2 + (h)) * HTB)
#define PG8_STAGE(bufoff, gbase, voff) do { _Pragma("unroll") for (int _i = 0; _i < 2; ++_i) \
        __builtin_amdgcn_global_load_lds((const unsigned*)((const char*)(gbase) + (voff)[_i]), (LAS unsigned*)(lds + (bufoff) + ldsw + _i * 8192), 16, 0, 0); } while (0)
#define PG8_LDA(dst, b, h) do { _Pragma("unroll") for (int m = 0; m < 4; ++m) _Pragma("unroll") for (int k = 0; k < 2; ++k) dst[m][k] = *(const LAS bf16x8*)(lds + PG8_SA(b, h) + aoff + m * 2048 + k * 1024); } while (0)
#define PG8_LDB(dst, b, h) do { _Pragma("unroll") for (int n = 0; n < 2; ++n) _Pragma("unroll") for (int k = 0; k < 2; ++k) dst[n][k] = *(const LAS bf16x8*)(lds + PG8_SB(b, h) + boff + n * 2048 + k * 1024); } while (0)
#define PG8_MMA(ai, bj, At, Bt) do { __builtin_amdgcn_s_setprio(1); _Pragma("unroll") for (int m = 0; m < 4; ++m) _Pragma("unroll") for (int n = 0; n < 2; ++n) _Pragma("unroll") for (int k = 0; k < 2; ++k) \
        acc[ai][bj][m][n] = __builtin_amdgcn_mfma_f32_16x16x32_bf16(Bt[n][k], At[m][k], acc[ai][bj][m][n], 0, 0, 0); __builtin_amdgcn_s_setprio(0); } while (0)
#define PG8_WAIT_V(n) asm volatile("s_waitcnt vmcnt(" #n ")" ::: "memory")
#define PG8_WAIT_L(n) asm volatile("s_waitcnt lgkmcnt(" #n ")" ::: "memory")
#define PG8_BAR __builtin_amdgcn_s_barrier()
#define PG8_SCHED __builtin_amdgcn_sched_barrier(0)
    Unit cur, nxt; int ui = 0;
    if (!S.next(0, cur)) return;
    f32x4 acc[2][2][4][2];
#pragma unroll
    for (int a = 0; a < 2; ++a)
#pragma unroll
        for (int b = 0; b < 2; ++b)
#pragma unroll
            for (int m = 0; m < 4; ++m)
#pragma unroll
                for (int n = 0; n < 2; ++n) acc[a][b][m][n] = (f32x4){0.f, 0.f, 0.f, 0.f};
    bf16x8 At[4][2], B0[2][2], B1[2][2];
    const char* cA = (const char*)g.A + (size_t)cur.pm * tstepA + (size_t)cur.koff * 2; const char* cB = (const char*)g.Bt + (size_t)cur.pn * tstepB + (size_t)cur.koff * 2;
    PG8_STAGE(PG8_SB(0, 0), cB, voffB); PG8_STAGE(PG8_SB(0, 1), cB + hstepB, voffB); PG8_STAGE(PG8_SA(0, 0), cA, voffA); PG8_STAGE(PG8_SA(0, 1), cA + hstepA, voffA);
    if (wr == 1) PG8_BAR;
    PG8_WAIT_V(2); PG8_BAR;
    PG8_STAGE(PG8_SB(1, 0), cB + kstep, voffB); PG8_STAGE(PG8_SA(1, 0), cA + kstep, voffA); PG8_STAGE(PG8_SB(1, 1), cB + hstepB + kstep, voffB);
    PG8_WAIT_V(6); PG8_BAR;
    for (;;) {
        const bool has_next = S.next(ui + 1, nxt);
        const char* nA = has_next ? (const char*)g.A + (size_t)nxt.pm * tstepA + (size_t)nxt.koff * 2 : cA; const char* nB = has_next ? (const char*)g.Bt + (size_t)nxt.pn * tstepB + (size_t)nxt.koff * 2 : cB;
        for (int t = 0; t < nt; t += 2) {
            const bool last = (t == nt - 2);
            const char* a1 = cA + (size_t)(t + 1) * kstep;
            const char* a2 = last ? nA : cA + (size_t)(t + 2) * kstep; const char* b2 = last ? nB : cB + (size_t)(t + 2) * kstep;
            const char* a3 = a2 + kstep; const char* b3 = b2 + kstep;
            PG8_LDB(B0, 0, 0); PG8_LDB(B1, 0, 1); PG8_SCHED; PG8_LDA(At, 0, 0); PG8_STAGE(PG8_SA(1, 1), a1 + hstepA, voffA);
            PG8_WAIT_V(8); PG8_WAIT_L(0); PG8_BAR; PG8_MMA(0, 0, At, B0); PG8_MMA(0, 1, At, B1); PG8_BAR; PG8_SCHED;
            PG8_LDA(At, 0, 1); PG8_STAGE(PG8_SB(0, 0), b2, voffB); PG8_STAGE(PG8_SB(0, 1), b2 + hstepB, voffB); PG8_STAGE(PG8_SA(0, 0), a2, voffA);
            PG8_WAIT_V(8); PG8_WAIT_L(0); PG8_BAR; PG8_MMA(1, 0, At, B0); PG8_MMA(1, 1, At, B1); PG8_BAR; PG8_SCHED;
            PG8_LDB(B0, 1, 0); PG8_LDB(B1, 1, 1); PG8_SCHED; PG8_LDA(At, 1, 0); PG8_STAGE(PG8_SA(0, 1), a2 + hstepA, voffA);
            PG8_WAIT_V(8); PG8_WAIT_L(0); PG8_BAR; PG8_MMA(0, 0, At, B0); PG8_MMA(0, 1, At, B1); PG8_BAR; PG8_SCHED;
            PG8_LDA(At, 1, 1); PG8_STAGE(PG8_SB(1, 0), b3, voffB); PG8_STAGE(PG8_SB(1, 1), b3 + hstepB, voffB); PG8_STAGE(PG8_SA(1, 0), a3, voffA);
            PG8_WAIT_V(8); PG8_WAIT_L(0); PG8_BAR; PG8_MMA(1, 0, At, B0); PG8_MMA(1, 1, At, B1); PG8_BAR; PG8_SCHED;
        }
        if constexpr (ALIGN_EPI) { if (wr == 0) PG8_BAR; }
        E(acc, cur, wr, wc, fr, fq);
        if (!has_next) break;
#pragma unroll
        for (int a = 0; a < 2; ++a)
#pragma unroll
            for (int b = 0; b < 2; ++b)
#pragma unroll
                for (int m = 0; m < 4; ++m)
#pragma unroll
                    for (int n = 0; n < 2; ++n) acc[a][b][m][n] = (f32x4){0.f, 0.f, 0.f, 0.f};
        cur = nxt; cA = nA; cB = nB; ++ui;
        if constexpr (ALIGN_EPI) { if (wr == 1) PG8_BAR; }
    }
    PG8_WAIT_V(0);
    if constexpr (!ALIGN_EPI) { if (wr == 0) PG8_BAR; }
    PG8_BAR;
#undef PG8_SA
#undef PG8_SB
#undef PG8_STAGE
#undef PG8_LDA
#undef PG8_LDB
#undef PG8_MMA
#undef PG8_WAIT_V
#undef PG8_WAIT_L
#undef PG8_BAR
#undef PG8_SCHED
}
}

typedef const f32x4 (&AccRef)[2][2][4][2];

__device__ __forceinline__ void rope8(float (&v)[8], const float* tab) {
    const f32x4 t0 = *(const f32x4*)tab, t1 = *(const f32x4*)(tab + 4);
    float x1, x2;
    x1 = v[0]; x2 = v[1]; v[0] = x1 * t0[0] - x2 * t0[1]; v[1] = x1 * t0[1] + x2 * t0[0];
    x1 = v[2]; x2 = v[3]; v[2] = x1 * t0[2] - x2 * t0[3]; v[3] = x1 * t0[3] + x2 * t0[2];
    x1 = v[4]; x2 = v[5]; v[4] = x1 * t1[0] - x2 * t1[1]; v[5] = x1 * t1[1] + x2 * t1[0];
    x1 = v[6]; x2 = v[7]; v[6] = x1 * t1[2] - x2 * t1[3]; v[7] = x1 * t1[3] + x2 * t1[2];
}
__device__ __forceinline__ void rope8v(float (&v)[8], const f32x4 t0, const f32x4 t1) {
    float x1, x2;
    x1 = v[0]; x2 = v[1]; v[0] = x1 * t0[0] - x2 * t0[1]; v[1] = x1 * t0[1] + x2 * t0[0];
    x1 = v[2]; x2 = v[3]; v[2] = x1 * t0[2] - x2 * t0[3]; v[3] = x1 * t0[3] + x2 * t0[2];
    x1 = v[4]; x2 = v[5]; v[4] = x1 * t1[0] - x2 * t1[1]; v[5] = x1 * t1[1] + x2 * t1[0];
    x1 = v[6]; x2 = v[7]; v[6] = x1 * t1[2] - x2 * t1[3]; v[7] = x1 * t1[3] + x2 * t1[2];
}
__device__ __forceinline__ u32x4 pack8(const float (&v)[8]) { u32x4 w; w.x = cvtpk(v[0], v[1]); w.y = cvtpk(v[2], v[3]); w.z = cvtpk(v[4], v[5]); w.w = cvtpk(v[6], v[7]); return w; }

template <int MODE> struct EpiProj {
    static constexpr bool PERM = true;
    bf16_t* Q; bf16_t* K; bf16_t* VT; const float* rope; const float* ssq; float qscale; const float* nbias;
    __device__ __forceinline__ void operator()(AccRef acc, const pg8::Unit& u, int wr, int wc, int fr_, int fq_) const {
        int lane_e = lane_id(); asm volatile("" : "+v"(lane_e)); const int fr = lane_e & 15, fq = lane_e >> 4; (void)fr_; (void)fq_;
        constexpr int LDQ = (MODE == 0) ? 1536 : 1024, NQ = (MODE == 0) ? 1536 : (MODE == 1 ? 0 : 1024);
        constexpr int LDK = (MODE == 2) ? 256 : 1024, NK = LDK, VCOLS = LDK;
        constexpr int TS = (MODE == 2) ? 64 : 32;
        const bool isctx = u.pm >= 256;
        const int row0 = u.pm * 256 + wr * 64 + fr, col0 = u.pn * 256 + wc * 32 + 8 * fq;
        f32x4 nbv[2][2]; float rs[4];
#pragma unroll
        for (int bj = 0; bj < 2; ++bj) {
            const int col = col0 + 128 * bj;
            if (MODE >= 2) { const float* nb = nbias + (isctx ? 8 : (u.pm >> 5)) * 4096 + col; nbv[bj][0] = *(const f32x4*)nb; nbv[bj][1] = *(const f32x4*)(nb + 4); }
            else { nbv[bj][0] = (f32x4){0.f, 0.f, 0.f, 0.f}; nbv[bj][1] = nbv[bj][0]; }
        }
#pragma unroll
        for (int r = 0; r < 8; ++r) {
            const int ai = r >> 2, m = r & 3; const int row = row0 + 128 * ai + 16 * m;
            if (m == 0) {
#pragma unroll
                for (int q = 0; q < 4; ++q) rs[q] = ssq[row0 + 128 * ai + 16 * q];
#pragma unroll
                for (int q = 0; q < 4; ++q) rs[q] = rsqrtf(rs[q] * (MODE == 0 ? 1.f / 256.f : (MODE == 1 ? 1.f / 128.f : 1.f / 1024.f)) + EPS);
            }
            const int rc = row - ML;
            const int b = isctx ? (rc >> 8) : (u.pm >> 5);
            const int kpos = isctx ? (rc & 255) : 256 + (row & 8191);
            const size_t kvrow = (size_t)b * KVLEN + kpos;
            const int vpos = (kpos & ~15) | perm16(kpos & 15);
            f32x4 tc[2][2] = {}; bool rp[2] = {false, false}; int roff[2] = {0, 0};
#pragma unroll
            for (int bj = 0; bj < 2; ++bj) { const int col = col0 + 128 * bj;
                if (MODE == 2) { rp[bj] = !isctx && col < 1280; roff[bj] = ((col & 63) >> 1) * 2; }
                else if (MODE == 0) { const int c96 = col % 96; rp[bj] = !isctx && c96 >= 64; roff[bj] = rp[bj] ? ((c96 - 64) >> 1) * 2 : 0; } }
            if (MODE == 2) {
#pragma unroll
                for (int bj = 0; bj < 2; ++bj) if (rp[bj]) { const float* tp = rope + (size_t)(row & 8191) * TS + roff[bj]; tc[bj][0] = *(const f32x4*)tp; tc[bj][1] = *(const f32x4*)(tp + 4); }
            }
#pragma unroll
            for (int bj = 0; bj < 2; ++bj) {
                const int col = col0 + 128 * bj;
                float v[8];
#pragma unroll
                for (int j = 0; j < 4; ++j) { v[j] = acc[ai][bj][m][0][j] * rs[m] + nbv[bj][0][j]; v[4 + j] = acc[ai][bj][m][1][j] * rs[m] + nbv[bj][1][j]; }
                if (MODE == 0 && rp[bj]) { const float* tp = rope + (size_t)(row & 8191) * TS + roff[bj]; tc[bj][0] = *(const f32x4*)tp; tc[bj][1] = *(const f32x4*)(tp + 4); }
                if ((MODE == 0 || MODE == 2) && rp[bj]) rope8v(v, tc[bj][0], tc[bj][1]);
                bool isv; int kc;
                if (MODE == 1) { const int within = col & 127; isv = within >= 64; kc = (col >> 7) * 64 + (within & 63); }
                else { isv = col >= NQ + NK; kc = isv ? col - NQ - NK : col - NQ; }
                if (MODE != 1 && col < NQ) {
#pragma unroll
                    for (int j = 0; j < 8; ++j) v[j] *= qscale;
                    *(u32x4*)(Q + (size_t)row * LDQ + col) = pack8(v);
                } else if (MODE != 0 && !isv) {
                    *(u32x4*)(K + kvrow * LDK + kc) = pack8(v);
                } else if (MODE != 0) {
                    bf16_t* vp = VT + ((size_t)(b * VCOLS + kc)) * KVLEN + vpos;
#pragma unroll
                    for (int j = 0; j < 8; ++j) vp[(size_t)j * KVLEN] = (bf16_t)(cvtpk(v[j], 0.f) & 0xffffu);
                }
            }
        }
    }
};

struct EpiLat {
    static constexpr bool PERM = true;
    bf16_t* lat; float* ssq_q; float* ssq_kv; bf16_t* KPE; const float* rope; const float* ssqn; const float* nbias;
    __device__ __forceinline__ void operator()(AccRef acc, const pg8::Unit& u, int wr, int wc, int fr_, int fq_) const {
        int lane_e = lane_id(); asm volatile("" : "+v"(lane_e)); const int fr = lane_e & 15, fq = lane_e >> 4; (void)fr_; (void)fq_;
        float rsv[8]; f32x4 nbv[2][2];
        { const int row0 = u.pm * 256 + wr * 64 + fr; const float* nb = nbias + (u.pm >= 256 ? 8 : (u.pm >> 5)) * 4096 + u.pn * 256 + wc * 32 + 8 * fq;
#pragma unroll
          for (int bj = 0; bj < 2; ++bj) { nbv[bj][0] = *(const f32x4*)(nb + 128 * bj); nbv[bj][1] = *(const f32x4*)(nb + 128 * bj + 4); }
#pragma unroll
          for (int r = 0; r < 8; ++r) rsv[r] = ssqn[row0 + 128 * (r >> 2) + 16 * (r & 3)];
#pragma unroll
          for (int r = 0; r < 8; ++r) rsv[r] = rsqrtf(rsv[r] * (1.f / 1024.f) + EPS); }
#pragma unroll
        for (int ai = 0; ai < 2; ++ai)
#pragma unroll
            for (int m = 0; m < 4; ++m) {
                const int row = u.pm * 256 + ai * 128 + wr * 64 + m * 16 + fr;
                const bool isctx = row >= ML; const int rc = row - ML;
                const int b = isctx ? (rc >> 8) : (row >> 13);
                const int tok = row & 8191;
                const int kpos = isctx ? (rc & 255) : 256 + tok;
                const size_t kvrow = (size_t)b * KVLEN + kpos;
                const float rs = rsv[ai * 4 + m];
                float ss = 0.f;
#pragma unroll
                for (int bj = 0; bj < 2; ++bj) {
                    const int col = u.pn * 256 + bj * 128 + wc * 32 + 8 * fq;
                    float v[8];
#pragma unroll
                    for (int j = 0; j < 4; ++j) { v[j] = acc[ai][bj][m][0][j] * rs; v[4 + j] = acc[ai][bj][m][1][j] * rs; }
                    {
#pragma unroll
                      for (int j = 0; j < 4; ++j) { v[j] += nbv[bj][0][j]; v[4 + j] += nbv[bj][1][j]; } }
                    if (col < 384) {
#pragma unroll
                        for (int j = 0; j < 8; ++j) ss += v[j] * v[j];
                        *(u32x4*)(lat + (size_t)row * 512 + col) = pack8(v);
                    } else if (col < 416) {
                        if (!isctx) rope8(v, rope + ((size_t)tok * 16 + ((col - 384) >> 1)) * 2);
                        *(u32x4*)(KPE + kvrow * 32 + (col - 384)) = pack8(v);
                    }
                }
                ss += shfl_xor_l(ss, 16, lane_e); ss += shfl_xor_l(ss, 32, lane_e);
                if (fq == 0 && (u.pn == 0 || wc < 4)) unsafeAtomicAdd((u.pn == 0 ? ssq_q : ssq_kv) + row, ss);
            }
    }
};

struct EpiResid {
    static constexpr bool PERM = false;
    const float* xin_l; const float* xin_c; float* xout_l; float* xout_c; const float* gate;
    bf16_t* xa; const float* gn; const float* scn; float* ssqn;
    __device__ __forceinline__ void operator()(AccRef acc, const pg8::Unit& u, int wr, int wc, int fr_, int fq_) const {
        int lane_e = lane_id(); asm volatile("" : "+v"(lane_e)); const int fr = lane_e & 15, fq = lane_e >> 4; (void)fr_; (void)fq_;
        const int bsel = u.pm >> 5;
        const int col0 = u.pn * 256 + wc * 32 + 4 * fq;
        const int row0 = u.pm * 256 + wr * 64 + fr;
        f32x4 gv[4], av[4];
#pragma unroll
        for (int c = 0; c < 4; ++c) { const int col = col0 + 128 * (c >> 1) + 16 * (c & 1);
            gv[c] = *(const f32x4*)(gate + bsel * 6144 + col);
            if (xa) { const f32x4 g4 = *(const f32x4*)(gn + col), s4 = *(const f32x4*)(scn + bsel * 6144 + col); av[c] = g4 * (s4 + 1.f); } else av[c] = (f32x4){0.f, 0.f, 0.f, 0.f}; }
        f32x4 xc[4], xn[4]; float ssr[8];
        { const float* xi = xin_l + (size_t)row0 * DM + col0;
#pragma unroll
          for (int c = 0; c < 4; ++c) xc[c] = *(const f32x4*)(xi + 128 * (c >> 1) + 16 * (c & 1)); }
#pragma unroll
        for (int r = 0; r < 8; ++r) {
            const int ai = r >> 2, m = r & 3; const int row = row0 + 128 * ai + 16 * m;
            if (r < 7) { const int rown = row0 + 128 * ((r + 1) >> 2) + 16 * ((r + 1) & 3); const float* xi = xin_l + (size_t)rown * DM + col0;
#pragma unroll
                for (int c = 0; c < 4; ++c) xn[c] = *(const f32x4*)(xi + 128 * (c >> 1) + 16 * (c & 1)); }
            float* xo = xout_l + (size_t)row * DM + col0; float ss = 0.f;
#pragma unroll
            for (int c = 0; c < 4; ++c) {
                const f32x4 y = xc[c] + gv[c] * acc[ai][c >> 1][m][c & 1];
                *(f32x4*)(xo + 128 * (c >> 1) + 16 * (c & 1)) = y;
                if (xa) { const f32x4 z = y * av[c]; ss += (y[0] * y[0] + y[1] * y[1]) + (y[2] * y[2] + y[3] * y[3]);
                    u32x2 o; o.x = cvtpk(z[0], z[1]); o.y = cvtpk(z[2], z[3]); *(u32x2*)(xa + (size_t)row * DM + col0 + 128 * (c >> 1) + 16 * (c & 1)) = o; }
            }
            ssr[r] = ss;
#pragma unroll
            for (int c = 0; c < 4; ++c) xc[c] = xn[c];
        }
        if (xa) {
#pragma unroll
            for (int r = 0; r < 8; ++r) { float ss = ssr[r]; ss += shfl_xor_l(ss, 16, lane_e); ss += shfl_xor_l(ss, 32, lane_e); ssr[r] = ss; }
            if (fq == 0) {
#pragma unroll
                for (int r = 0; r < 8; ++r) unsafeAtomicAdd(ssqn + row0 + 128 * (r >> 2) + 16 * (r & 3), ssr[r]);
            }
        }
    }
};

struct EpiCtxPartial {
    static constexpr bool PERM = false;
    float* part; int kchunk;
    __device__ __forceinline__ void operator()(AccRef acc, const pg8::Unit& u, int wr, int wc, int fr_, int fq_) const {
        int lane_e = lane_id(); asm volatile("" : "+v"(lane_e)); const int fr = lane_e & 15, fq = lane_e >> 4; (void)fr_; (void)fq_;
        float* pb = part + (size_t)(u.koff / kchunk) * MC * DM;
#pragma unroll
        for (int ai = 0; ai < 2; ++ai)
#pragma unroll
            for (int m = 0; m < 4; ++m) {
                const int row = u.pm * 256 + ai * 128 + wr * 64 + m * 16 + fr - ML;
                float* xr = pb + (size_t)row * DM;
#pragma unroll
                for (int bj = 0; bj < 2; ++bj)
#pragma unroll
                    for (int n = 0; n < 2; ++n) {
                        const int col = u.pn * 256 + bj * 128 + wc * 32 + 16 * n + 4 * fq;
                        *(f32x4*)(xr + col) = acc[ai][bj][m][n];
                    }
            }
    }
};

struct EpiSqRelu {
    static constexpr bool PERM = true;
    bf16_t* O; int ldc; const float* ssqn; const float* nbias;
    __device__ __forceinline__ void operator()(AccRef acc, const pg8::Unit& u, int wr, int wc, int fr_, int fq_) const {
        int lane_e = lane_id(); asm volatile("" : "+v"(lane_e)); const int fr = lane_e & 15, fq = lane_e >> 4; (void)fr_; (void)fq_;
        const int row0 = u.pm * 256 + wr * 64 + fr, col0 = u.pn * 256 + wc * 32 + 8 * fq;
        const float* nb = nbias + (u.pm >= 256 ? 8 : (u.pm >> 5)) * 4096 + col0;
        f32x4 bv[2][2]; float rs[8];
#pragma unroll
        for (int bj = 0; bj < 2; ++bj) { bv[bj][0] = *(const f32x4*)(nb + bj * 128); bv[bj][1] = *(const f32x4*)(nb + bj * 128 + 4); }
#pragma unroll
        for (int r = 0; r < 8; ++r) rs[r] = ssqn[row0 + 128 * (r >> 2) + 16 * (r & 3)];
#pragma unroll
        for (int r = 0; r < 8; ++r) rs[r] = rsqrtf(rs[r] * (1.f / 1024.f) + EPS);
#pragma unroll
        for (int r = 0; r < 8; ++r) {
            const int ai = r >> 2, m = r & 3; const int row = row0 + 128 * ai + 16 * m;
#pragma unroll
            for (int bj = 0; bj < 2; ++bj) {
                float v[8];
#pragma unroll
                for (int j = 0; j < 4; ++j) { float a = fmaxf(acc[ai][bj][m][0][j] * rs[r] + bv[bj][0][j], 0.f), c = fmaxf(acc[ai][bj][m][1][j] * rs[r] + bv[bj][1][j], 0.f); v[j] = a * a; v[4 + j] = c * c; }
                *(u32x4*)(O + (size_t)row * ldc + col0 + bj * 128) = pack8(v);
            }
        }
    }
};

constexpr int KP = 208, VP = 144;
constexpr int KT_BYTES = 64 * KP, VT_BYTES = 64 * VP, ABUF = KT_BYTES + VT_BYTES;
constexpr int ATT_OSTAGE_OFF = 73728;
constexpr int ATT_BIAS_OFF = 2 * ABUF;
struct AttnP { const bf16_t* Q; const bf16_t* K; const bf16_t* KPE; const bf16_t* VT; bf16_t* O; const float* sink; const float* bias; int nunits; };

__device__ __forceinline__ float rowmax32(const f32x16& a, const f32x16& b) {
    float x = __builtin_fmaxf(__builtin_fmaxf(a[0], a[1]), b[0]), y = __builtin_fmaxf(__builtin_fmaxf(a[2], a[3]), b[1]); x = __builtin_fmaxf(__builtin_fmaxf(x, b[2]), b[3]);
#pragma unroll
    for (int r = 4; r < 16; r += 4) { x = __builtin_fmaxf(__builtin_fmaxf(x, a[r]), a[r + 1]); y = __builtin_fmaxf(__builtin_fmaxf(y, a[r + 2]), a[r + 3]); x = __builtin_fmaxf(__builtin_fmaxf(x, b[r]), b[r + 1]); y = __builtin_fmaxf(__builtin_fmaxf(y, b[r + 2]), b[r + 3]); }
    const float m = __builtin_fmaxf(x, y);
    auto rr = __builtin_amdgcn_permlane32_swap(__float_as_uint(m), __float_as_uint(m), false, false);
    return __builtin_fmaxf(__uint_as_float(rr[0]), __uint_as_float(rr[1]));
}

template <int VAR>
__device__ __forceinline__ void attn_phase(LAS unsigned char* lds, const AttnP P, int vcu, int G, int wave_s) {
    constexpr int ND0 = (VAR == 0) ? 6 : 4;
    constexpr int QPITCH = (VAR == 0) ? 1536 : 1024, QH = (VAR == 0) ? 96 : 64;
    constexpr int KPITCH = (VAR == 1) ? 256 : 1024, VCOLS = (VAR == 1) ? 256 : 1024;
    constexpr bool USE_NEGM = (VAR != 2);
    constexpr float THR = 8.f;
    int tid_l = wave_s * 64 + lane_id(); asm volatile("" : "+v"(tid_l));
    const int tid = tid_l, lane = tid & 63, r32 = lane & 31, hi = lane >> 5;
    const int w = __builtin_amdgcn_readfirstlane(tid >> 6);
    LAS float* bias_lds = (LAS float*)(lds + ATT_BIAS_OFF);
    for (int it = 0;; ++it) {
        int u;
        if (VAR == 0 && G == 256) { u = (it < 16) ? ((it * 8 + (vcu >> 5)) * 32 + (vcu & 31)) : (4096 + (it - 16) * 256 + vcu); }
        else u = it * G + vcu;
        if (u >= P.nunits) break;
        const bool isctx = u >= 4096;
        int b, hq, hk, qrow, nt; int p_a = 0, p_b = 0;
        if (VAR == 0) {
            if (!isctx) { const int bh = u >> 5, qb = u & 31; b = bh >> 4; hq = bh & 15; qrow = b * SEQ + qb * 256 + 32 * w; nt = 132; }
            else { const int cu = u - 4096; b = cu >> 4; hq = cu & 15; qrow = ML + b * 256 + 32 * w; nt = 4; }
            hk = hq;
        } else if (VAR == 1) {
            if (!isctx) { const int blk = u & 63, hp = (u >> 6) & 7; b = u >> 9; hq = 2 * hp + (w >> 2); hk = hp >> 1; qrow = b * SEQ + blk * 128 + 32 * (w & 3);
                          const int jlo = blk == 0 ? 2 : 0, jhi = blk == 63 ? 4 : 6; nt = 4 + jhi - jlo; p_a = blk * 128 - 128 + 64 * jlo; p_b = blk * 128 + 32 * (w & 3); }
            else { const int cu = u - 4096, half = cu & 1, hp = (cu >> 1) & 7; b = cu >> 4; hq = 2 * hp + (w >> 2); hk = hp >> 1; qrow = ML + b * 256 + half * 128 + 32 * (w & 3); nt = 4; }
        } else {
            if (!isctx) { const int rq = u & 31; hq = (u >> 5) & 15; b = u >> 9; const int r0 = 4 * rq; qrow = b * SEQ + (r0 + (w >> 1)) * 64 + 32 * (w & 1);
                          int lo = r0 - 4; lo = lo < 0 ? 0 : (lo > 120 ? 120 : lo); int h2 = r0 - 1; h2 = h2 < 0 ? 0 : (h2 > 120 ? 120 : h2); nt = 4 + (h2 + 8 - lo); p_a = lo; p_b = r0 + (w >> 1); }
            else { const int cu = u - 4096; b = cu >> 4; hq = cu & 15; qrow = ML + b * 256 + 32 * w; nt = 4; }
            hk = hq;
        }
        if (VAR == 2 && !isctx) { if (tid < 465) bias_lds[tid] = P.bias[hq * 465 + tid] * LOG2E; }
        bf16x8 qf[ND0];
        { const bf16_t* qp = P.Q + (size_t)(qrow + r32) * QPITCH + hq * QH + hi * 8;
#pragma unroll
          for (int d0 = 0; d0 < ND0; ++d0) qf[d0] = *(const bf16x8*)(qp + d0 * 16); }
        f32x16 o0 = {}, o1 = {};
        const unsigned koff = (unsigned)(((b * KVLEN + (tid >> 3)) * KPITCH + hk * 64 + (tid & 7) * 8) * 2);
        const unsigned peoff = (unsigned)(((b * KVLEN + (tid >> 2)) * 32 + (tid & 3) * 8) * 2);
        const unsigned voff = (unsigned)(((b * VCOLS + hk * 64 + (tid >> 3)) * KVLEN + (tid & 7) * 8) * 2);
        u32x4 kreg, pereg = {}, vreg;
#define TILE_KPOS(t) (VAR == 0 ? 64 * (((t) + rot >= nt) ? (t) + rot - nt : (t) + rot) : ((t) < 4 ? 64 * (t) : (VAR == 1 ? 256 + p_a + 64 * ((t) - 4) : 256 + 64 * (p_a + (t) - 4))))
#define LOADK(t) do { const int kp_ = TILE_KPOS(t); kreg = *(const u32x4*)((const char*)P.K + (size_t)(koff + (unsigned)(kp_ * KPITCH * 2))); if (VAR == 0 && tid < 256) pereg = *(const u32x4*)((const char*)P.KPE + (size_t)(peoff + (unsigned)(kp_ * 64))); } while (0)
#define LOADV(t) do { const int kp_ = TILE_KPOS(t); vreg = *(const u32x4*)((const char*)P.VT + (size_t)(voff + (unsigned)(kp_ * 2))); } while (0)
#define STOREK(buf) do { LAS unsigned char* kb_ = lds + (buf) * ABUF; *(LAS u32x4*)(kb_ + (tid >> 3) * KP + (tid & 7) * 16) = kreg; \
        if (VAR == 0 && tid < 256) *(LAS u32x4*)(kb_ + (tid >> 2) * KP + 128 + (tid & 3) * 16) = pereg; } while (0)
#define STOREV(buf) do { *(LAS u32x4*)(lds + (buf) * ABUF + KT_BYTES + (tid >> 3) * VP + (tid & 7) * 16) = vreg; } while (0)
#define NEED(t) (((t) < 4) ? true : (VAR == 1 ? ((p_a + 64 * ((t) - 4) + 63 >= p_b - 128) && (p_a + 64 * ((t) - 4) <= p_b + 31 + 128)) : (VAR == 2 ? ((p_a + (t) - 4 >= na_rs) && (p_a + (t) - 4 < na_rs + 8)) : true)))
#define QK_TILE(P0, P1, buf, CINIT) do { const LAS unsigned char* kt_ = lds + (buf) * ABUF; P0 = (CINIT); P1 = (CINIT); \
        _Pragma("unroll") for (int d0 = 0; d0 < ND0; ++d0) { \
            const bf16x8 k0_ = *(const LAS bf16x8*)(kt_ + r32 * KP + d0 * 32 + hi * 16); const bf16x8 k1_ = *(const LAS bf16x8*)(kt_ + (32 + r32) * KP + d0 * 32 + hi * 16); \
            P0 = __builtin_amdgcn_mfma_f32_32x32x16_bf16(k0_, qf[d0], P0, 0, 0, 0); P1 = __builtin_amdgcn_mfma_f32_32x32x16_bf16(k1_, qf[d0], P1, 0, 0, 0); } } while (0)
#define MASK_TILE(P0, P1, t) do { \
        if (VAR == 1 && (t) >= 4) { const int d0_ = p_a + 64 * ((t) - 4) - (p_b + r32) + 4 * hi + 128; \
            _Pragma("unroll") for (int r = 0; r < 16; ++r) { const int dd = d0_ + (r & 3) + 8 * (r >> 2); if ((unsigned)dd > 256u) P0[r] = -1e30f; if ((unsigned)(dd + 32) > 256u) P1[r] = -1e30f; } } \
        if (VAR == 2 && (t) >= 4) { int c = (qrow & 63) + r32; asm volatile("" : "+v"(c)); const int kr = p_a + (t) - 4; int cs = c - 8; cs = cs < 0 ? 0 : (cs > 48 ? 48 : cs); const LAS float* brow = bias_lds + (kr - p_b + 7) * 31; \
            _Pragma("unroll") for (int r = 0; r < 16; ++r) { const int kc = 4 * hi + (r & 3) + 8 * (r >> 2); \
                { int bi = kc - c + 15; bi = bi < 0 ? 0 : (bi > 30 ? 30 : bi); P0[r] = ((unsigned)(kc - cs) < 16u) ? P0[r] + brow[bi] : -1e30f; } \
                { int bi = kc + 32 - c + 15; bi = bi < 0 ? 0 : (bi > 30 ? 30 : bi); P1[r] = ((unsigned)(kc + 32 - cs) < 16u) ? P1[r] + brow[bi] : -1e30f; } } } } while (0)
        const int rot = (VAR == 0 && !isctx) ? ((vcu & 31) * 4 + (vcu >> 5)) % 132 : 0;
        int na_rs = 0; if (VAR == 2) { na_rs = p_b - 4; na_rs = na_rs < 0 ? 0 : (na_rs > 120 ? 120 : na_rs); }
        LOADK(0); LOADV(0); STOREK(0); STOREV(0);
        if (nt > 1) { LOADK(1); STOREK(1); }
        __syncthreads();
        f32x16 pc0, pc1; const f32x16 zero16 = {};
        QK_TILE(pc0, pc1, 0, zero16);
        float mref = rowmax32(pc0, pc1), lrun = 0.f;
        if (VAR == 1) { const float sk = P.sink[hq] * LOG2E; mref = __builtin_fmaxf(mref, sk); lrun = (hi == 0) ? __builtin_amdgcn_exp2f(sk - mref) : 0.f; }
        f32x16 negm = {};
        if (USE_NEGM) {
#pragma unroll
            for (int r = 0; r < 16; ++r) { pc0[r] -= mref; pc1[r] -= mref; negm[r] = -mref; }
        }
        float rmc = 0.f;
        bool need_c = true;
        __syncthreads();
        for (int t = 0; t < nt; ++t) {
            const bool hn = (t + 1 < nt);
            if (hn) { const int t2 = (t + 2 < nt) ? t + 2 : nt - 1; LOADK(t2); LOADV(t + 1); }
            const bool need_n = hn && NEED(t + 1);
            if (need_c && __any(rmc > THR)) {
                const float dl = __builtin_fmaxf(rmc, 0.f), f = __builtin_amdgcn_exp2f(-dl);
                mref += dl; lrun *= f;
#pragma unroll
                for (int r = 0; r < 16; ++r) { if (USE_NEGM) { pc0[r] -= dl; pc1[r] -= dl; negm[r] = -mref; } o0[r] *= f; o1[r] *= f; }
            }
            f32x16 pn0 = {}, pn1 = {};
            float rmn = -1e30f;
            if (VAR != 2 && need_c && need_n) {
                const LAS unsigned char* kt_ = lds + ((t + 1) & 1) * ABUF; const LAS unsigned char* vt_ = lds + (t & 1) * ABUF + KT_BYTES;
                bf16x8 kf[2 * ND0], vf[8]; u32x4 w0, w1, w2, w3; float sacc = 0.f;
#define KRD(d0) do { kf[2 * (d0)] = *(const LAS bf16x8*)(kt_ + r32 * KP + (d0) * 32 + hi * 16); kf[2 * (d0) + 1] = *(const LAS bf16x8*)(kt_ + (32 + r32) * KP + (d0) * 32 + hi * 16); } while (0)
#define VRD(kk) do { vf[2 * (kk)] = *(const LAS bf16x8*)(vt_ + r32 * VP + (kk) * 32 + hi * 16); vf[2 * (kk) + 1] = *(const LAS bf16x8*)(vt_ + (32 + r32) * VP + (kk) * 32 + hi * 16); } while (0)
#define EX4(Pv, a, W, lo) do { if (!USE_NEGM) { Pv[a] -= mref; Pv[a + 1] -= mref; Pv[a + 2] -= mref; Pv[a + 3] -= mref; } Pv[a] = __builtin_amdgcn_exp2f(Pv[a]); Pv[a + 1] = __builtin_amdgcn_exp2f(Pv[a + 1]); Pv[a + 2] = __builtin_amdgcn_exp2f(Pv[a + 2]); Pv[a + 3] = __builtin_amdgcn_exp2f(Pv[a + 3]); \
        sacc += Pv[a]; sacc += Pv[a + 1]; sacc += Pv[a + 2]; sacc += Pv[a + 3]; if (lo) { W.x = cvtpk(Pv[a], Pv[a + 1]); W.y = cvtpk(Pv[a + 2], Pv[a + 3]); } else { W.z = cvtpk(Pv[a], Pv[a + 1]); W.w = cvtpk(Pv[a + 2], Pv[a + 3]); } } while (0)
#define SB() __builtin_amdgcn_sched_barrier(0)
#define QKP(d0, C0, C1) do { pn0 = __builtin_amdgcn_mfma_f32_32x32x16_bf16(kf[2 * (d0)], qf[d0], C0, 0, 0, 0); pn1 = __builtin_amdgcn_mfma_f32_32x32x16_bf16(kf[2 * (d0) + 1], qf[d0], C1, 0, 0, 0); } while (0)
#define PVP(kk, W) do { const bf16x8 pb_ = __builtin_bit_cast(bf16x8, W); o0 = __builtin_amdgcn_mfma_f32_32x32x16_bf16(vf[2 * (kk)], pb_, o0, 0, 0, 0); o1 = __builtin_amdgcn_mfma_f32_32x32x16_bf16(vf[2 * (kk) + 1], pb_, o1, 0, 0, 0); } while (0)
#define KR1(j) (kf[j] = *(const LAS bf16x8*)(kt_ + (32 * ((j) & 1) + r32) * KP + ((j) >> 1) * 32 + hi * 16))
#define VR1(i) (vf[i] = *(const LAS bf16x8*)(vt_ + (32 * ((i) & 1) + r32) * VP + ((i) >> 1) * 32 + hi * 16))
#define EX2(Pv, a, Wd) do { Pv[a] = __builtin_amdgcn_exp2f(Pv[a]); Pv[a + 1] = __builtin_amdgcn_exp2f(Pv[a + 1]); sacc += Pv[a]; sacc += Pv[a + 1]; Wd = cvtpk(Pv[a], Pv[a + 1]); } while (0)
#define QK1(j, C) do { if ((j) & 1) pn1 = __builtin_amdgcn_mfma_f32_32x32x16_bf16(kf[j], qf[(j) >> 1], C, 0, 0, 0); else pn0 = __builtin_amdgcn_mfma_f32_32x32x16_bf16(kf[j], qf[(j) >> 1], C, 0, 0, 0); } while (0)
#define PV1(i, W) do { const bf16x8 pb_ = __builtin_bit_cast(bf16x8, W); if ((i) & 1) o1 = __builtin_amdgcn_mfma_f32_32x32x16_bf16(vf[i], pb_, o1, 0, 0, 0); else o0 = __builtin_amdgcn_mfma_f32_32x32x16_bf16(vf[i], pb_, o0, 0, 0, 0); } while (0)
                if (ND0 == 6) {
                    KR1(0); KR1(1); KR1(2); KR1(3); SB();
                    QK1(0, negm); EX2(pc0, 0, w0.x); KR1(4); SB();
                    QK1(1, negm); EX2(pc0, 2, w0.y); KR1(5); SB();
                    QK1(2, pn0); EX2(pc0, 4, w0.z); KR1(6); SB();
                    QK1(3, pn1); EX2(pc0, 6, w0.w); KR1(7); SB();
                    QK1(4, pn0); EX2(pc0, 8, w1.x); KR1(8); SB();
                    QK1(5, pn1); EX2(pc0, 10, w1.y); KR1(9); SB();
                    QK1(6, pn0); EX2(pc0, 12, w1.z); KR1(10); SB();
                    QK1(7, pn1); EX2(pc0, 14, w1.w); KR1(11); SB();
                    QK1(8, pn0); EX2(pc1, 0, w2.x); VR1(0); SB();
                    QK1(9, pn1); EX2(pc1, 2, w2.y); VR1(1); SB();
                    QK1(10, pn0); EX2(pc1, 4, w2.z); VR1(2); SB();
                    QK1(11, pn1); EX2(pc1, 6, w2.w); VR1(3); SB();
                } else {
                    KR1(0); KR1(1); KR1(2); KR1(3); SB();
                    QK1(0, negm); EX2(pc0, 0, w0.x); EX2(pc0, 2, w0.y); KR1(4); SB();
                    QK1(1, negm); EX2(pc0, 4, w0.z); EX2(pc0, 6, w0.w); KR1(5); SB();
                    QK1(2, pn0); EX2(pc0, 8, w1.x); EX2(pc0, 10, w1.y); KR1(6); SB();
                    QK1(3, pn1); EX2(pc0, 12, w1.z); EX2(pc0, 14, w1.w); KR1(7); SB();
                    QK1(4, pn0); EX2(pc1, 0, w2.x); VR1(0); SB();
                    QK1(5, pn1); EX2(pc1, 2, w2.y); VR1(1); SB();
                    QK1(6, pn0); EX2(pc1, 4, w2.z); VR1(2); SB();
                    QK1(7, pn1); EX2(pc1, 6, w2.w); VR1(3); SB();
                }
                PV1(0, w0); EX2(pc1, 8, w3.x); VR1(4); SB();
                PV1(1, w0); EX2(pc1, 10, w3.y); VR1(5); SB();
                PV1(2, w1); EX2(pc1, 12, w3.z); VR1(6); SB();
                PV1(3, w1); EX2(pc1, 14, w3.w); VR1(7); SB();
                lrun += sacc;
                PV1(4, w2); MASK_TILE(pn0, pn1, t + 1); SB();
                PV1(5, w2); SB();
                PV1(6, w3); SB();
                PV1(7, w3); rmn = rowmax32(pn0, pn1); if (!USE_NEGM) rmn -= mref; SB();
#undef KR1
#undef VR1
#undef EX2
#undef QK1
#undef PV1
#undef KRD
#undef VRD
#undef EX4
#undef SB
#undef QKP
#undef PVP
            } else {
            if (need_n) QK_TILE(pn0, pn1, (t + 1) & 1, negm);
            if (need_c) {
                float sum = 0.f;
#pragma unroll
                for (int r = 0; r < 16; ++r) { if (!USE_NEGM) { pc0[r] -= mref; pc1[r] -= mref; } pc0[r] = __builtin_amdgcn_exp2f(pc0[r]); pc1[r] = __builtin_amdgcn_exp2f(pc1[r]); sum += pc0[r]; sum += pc1[r]; }
                lrun += sum;
                bf16x8 pk[4];
                { u32x4 a; a.x = cvtpk(pc0[0], pc0[1]); a.y = cvtpk(pc0[2], pc0[3]); a.z = cvtpk(pc0[4], pc0[5]); a.w = cvtpk(pc0[6], pc0[7]); pk[0] = __builtin_bit_cast(bf16x8, a); }
                { u32x4 a; a.x = cvtpk(pc0[8], pc0[9]); a.y = cvtpk(pc0[10], pc0[11]); a.z = cvtpk(pc0[12], pc0[13]); a.w = cvtpk(pc0[14], pc0[15]); pk[1] = __builtin_bit_cast(bf16x8, a); }
                { u32x4 a; a.x = cvtpk(pc1[0], pc1[1]); a.y = cvtpk(pc1[2], pc1[3]); a.z = cvtpk(pc1[4], pc1[5]); a.w = cvtpk(pc1[6], pc1[7]); pk[2] = __builtin_bit_cast(bf16x8, a); }
                { u32x4 a; a.x = cvtpk(pc1[8], pc1[9]); a.y = cvtpk(pc1[10], pc1[11]); a.z = cvtpk(pc1[12], pc1[13]); a.w = cvtpk(pc1[14], pc1[15]); pk[3] = __builtin_bit_cast(bf16x8, a); }
                const LAS unsigned char* vt = lds + (t & 1) * ABUF + KT_BYTES;
#pragma unroll
                for (int kk = 0; kk < 4; ++kk) {
                    const bf16x8 v0 = *(const LAS bf16x8*)(vt + r32 * VP + kk * 32 + hi * 16);
                    const bf16x8 v1 = *(const LAS bf16x8*)(vt + (32 + r32) * VP + kk * 32 + hi * 16);
                    o0 = __builtin_amdgcn_mfma_f32_32x32x16_bf16(v0, pk[kk], o0, 0, 0, 0);
                    o1 = __builtin_amdgcn_mfma_f32_32x32x16_bf16(v1, pk[kk], o1, 0, 0, 0);
                }
            }
            if (need_n) { MASK_TILE(pn0, pn1, t + 1); rmn = rowmax32(pn0, pn1); if (!USE_NEGM) rmn -= mref; }
            }
            if (hn) { STOREK(t & 1); STOREV((t + 1) & 1); }
            __syncthreads();
            pc0 = pn0; pc1 = pn1; rmc = rmn; need_c = need_n;
        }
#undef TILE_KPOS
#undef LOADK
#undef LOADV
#undef STOREK
#undef STOREV
#undef NEED
#undef QK_TILE
#undef MASK_TILE
        const float lt = lrun + shfl_xor_l(lrun, 32, lane), inv = 1.f / lt;
        LAS unsigned char* stg = lds + ATT_OSTAGE_OFF + w * (32 * 144);
#pragma unroll
        for (int g = 0; g < 4; ++g) {
            u32x2 a; a.x = cvtpk(o0[4 * g] * inv, o0[4 * g + 1] * inv); a.y = cvtpk(o0[4 * g + 2] * inv, o0[4 * g + 3] * inv); *(LAS u32x2*)(stg + r32 * 144 + (8 * g + 4 * hi) * 2) = a;
            u32x2 c; c.x = cvtpk(o1[4 * g] * inv, o1[4 * g + 1] * inv); c.y = cvtpk(o1[4 * g + 2] * inv, o1[4 * g + 3] * inv); *(LAS u32x2*)(stg + r32 * 144 + (32 + 8 * g + 4 * hi) * 2) = c;
        }
        asm volatile("s_waitcnt lgkmcnt(0)" ::: "memory");
        { bf16_t* ob = P.O + (size_t)(qrow + (lane >> 3)) * DM + hq * 64 + (lane & 7) * 8;
#pragma unroll
          for (int i = 0; i < 4; ++i) { const u32x4 v = *(const LAS u32x4*)(stg + (i * 8 + (lane >> 3)) * 144 + (lane & 7) * 16); *(u32x4*)(ob + (size_t)i * 8 * DM) = v; } }
    }
}

constexpr size_t MiB = 1u << 20;
constexpr size_t WS_BAR = 983040  ;
constexpr size_t WS_MOD = 0, WS_SSQ = 1 * MiB, WS_ROPE16 = 3 * MiB, WS_ROPE32 = 4 * MiB, WS_KPE = 6 * MiB, WS_XC = 12 * MiB;
constexpr size_t WS_W1T = 20 * MiB, WS_W2T = 52 * MiB, WS_MLA = 84 * MiB  , WS_SWA = 94 * MiB  , WS_NA = 99 * MiB  ;
constexpr size_t WS_H = 108 * MiB, WS_Q = 240 * MiB, WS_K = 438 * MiB, WS_VT = 570 * MiB, WS_O = 702 * MiB, WS_LAT = 702 * MiB, WS_HID = 240 * MiB, WS_NBIAS = 834 * MiB  , WS_SSQN = 836 * MiB  , WS_PART = 840 * MiB  , WS_END = 904 * MiB;

#define XB_TMO      128
#define XB_XCNT(j)  (256  + 64 * (j))
#define XB_XSUB(j)  (1280 + 64 * (j))
#define XB_XGEN(j)  (2304 + 64 * (j))
#define XB_TOP      3328
#define XB_TOPGEN   3392
#define XCD_BAR_WORDS 3456
#define XB_SPIN_CAP (1u << 18)
__device__ __forceinline__ unsigned xb_ld(unsigned* p)              { return __hip_atomic_load(p, __ATOMIC_RELAXED, __HIP_MEMORY_SCOPE_AGENT); }
__device__ __forceinline__ unsigned xb_add(unsigned* p, unsigned v) { return __hip_atomic_fetch_add(p, v, __ATOMIC_RELAXED, __HIP_MEMORY_SCOPE_AGENT); }
__device__ __forceinline__ unsigned xb_xcc_id() { return (unsigned)__builtin_amdgcn_s_getreg((3 << 11) | 20) & 0xFu; }
#define XB_SPIN(cond, bar) do { unsigned _sp = 0; while (cond) { __builtin_amdgcn_s_sleep(1); \
    if ((++_sp & 255u) == 0u) { if (xb_ld(&(bar)[XB_TMO])) break; if (_sp > XB_SPIN_CAP) { atomicAdd(&(bar)[XB_TMO], 1u); break; } } } } while (0)
struct XcdBarrier { unsigned* bar; unsigned x; volatile LAS unsigned* st; };
__device__ __forceinline__ XcdBarrier xcd_barrier_post(unsigned* bar, volatile LAS unsigned* st, bool t0) {
    XcdBarrier b; b.bar = bar; b.x = xb_xcc_id(); b.st = st;
    if (t0) (void)xb_add(&bar[XB_XCNT(b.x)], 1u);
    return b;
}
__device__ __forceinline__ void xcd_barrier_complete(unsigned* bar, unsigned x, unsigned& nloc, unsigned& nx) {
    const unsigned G = gridDim.x * gridDim.y * gridDim.z;
    unsigned sum, cnt, mine, sp = 0u;
    for (;;) {
        sum = 0u; cnt = 0u; mine = 0u;
#pragma unroll
        for (unsigned j = 0; j < 16; ++j) { const unsigned c = xb_ld(&bar[XB_XCNT(j)]); sum += c; cnt += (c > 0u) ? 1u : 0u; mine = (j == x) ? c : mine; }
        if (sum == G) break;
        __builtin_amdgcn_s_sleep(1);
        if ((++sp & 255u) == 0u) { if (xb_ld(&bar[XB_TMO])) break; if (sp > XB_SPIN_CAP) { atomicAdd(&bar[XB_TMO], 1u); break; } }
    }
    nloc = mine > 0u ? mine : 1u; nx = cnt > 0u ? cnt : 1u;
}
__device__ __forceinline__ void xcd_barrier(const XcdBarrier& b, bool t0) {
    asm volatile("s_waitcnt vmcnt(0)" ::: "memory");
    __syncthreads();
    if (t0) {
        unsigned* bar = b.bar; unsigned bx = b.x; asm volatile("" : "+s"(bar), "+s"(bx));
        __builtin_amdgcn_s_waitcnt(0);
        unsigned nloc = b.st[0], nx = b.st[1];
        if (nloc == 0u) { xcd_barrier_complete(bar, bx, nloc, nx); b.st[0] = nloc; b.st[1] = nx; }
        const unsigned old = xb_add(&bar[XB_XSUB(bx)], 1u);
        const unsigned gen = old / nloc;
        if (old + 1u == (gen + 1u) * nloc) {
            __builtin_amdgcn_fence(__ATOMIC_RELEASE, "agent");
            asm volatile("s_waitcnt vmcnt(0)" ::: "memory");
            const unsigned og = xb_add(&bar[XB_TOP], 1u);
            const unsigned tg = og / nx;
            if (og + 1u == (tg + 1u) * nx) xb_add(&bar[XB_TOPGEN], 1u);
            else XB_SPIN(xb_ld(&bar[XB_TOPGEN]) == tg, bar);
            __builtin_amdgcn_fence(__ATOMIC_ACQUIRE, "agent");
            xb_add(&bar[XB_XGEN(bx)], 1u);
            asm volatile("s_waitcnt vmcnt(0)" ::: "memory");
        } else {
            XB_SPIN(xb_ld(&bar[XB_XGEN(bx)]) == gen, bar);
            __builtin_amdgcn_fence(__ATOMIC_ACQUIRE, "agent");
            asm volatile("s_waitcnt vmcnt(0)" ::: "memory");
        }
    }
    __syncthreads();
}

__device__ __forceinline__ float wave_sum(float v, int lane) {
#pragma unroll
    for (int o = 1; o < 64; o <<= 1) v += shfl_xor_l(v, o, lane);
    return v;
}
__device__ __forceinline__ void sincos_red(float x, float& sn, float& cs) {
    const float n = rintf(x * 0.15915494309189535f);
    float r = fmaf(-n, 6.2831854820251465f, x); r = fmaf(-n, -1.7484555e-7f, r);
    const float rev = r * 0.15915494309189535f;
    sn = __builtin_amdgcn_sinf(rev); cs = __builtin_amdgcn_cosf(rev);
}
__device__ __forceinline__ void transpose_item(const float* W, int K, int N, bf16_t* WT, const float* g, LAS float* scr, int item, int lane) {
    const int nblk = N / 32, kb = item / nblk, nb = item % nblk, k0 = 64 * kb, n0 = 32 * nb;
#pragma unroll 8
    for (int i = 0; i < 32; ++i) { const int kk = 2 * i + (lane >> 5); float v = W[(size_t)(k0 + kk) * N + n0 + (lane & 31)]; if (g) v *= g[k0 + kk]; scr[kk * 33 + (lane & 31)] = v; }
    asm volatile("s_waitcnt lgkmcnt(0)" ::: "memory");
    const int c = lane & 7;
#pragma unroll
    for (int j = 0; j < 4; ++j) { const int n = (lane >> 3) + 8 * j; const LAS float* s = scr + (8 * c) * 33 + n;
        u32x4 o; o.x = cvtpk(s[0 * 33], s[1 * 33]); o.y = cvtpk(s[2 * 33], s[3 * 33]); o.z = cvtpk(s[4 * 33], s[5 * 33]); o.w = cvtpk(s[6 * 33], s[7 * 33]);
        *(u32x4*)(WT + (size_t)(n0 + n) * K + k0 + 8 * c) = o; }
    asm volatile("s_waitcnt lgkmcnt(0)" ::: "memory");
}

struct Args { const float* in[23]; float* out; unsigned char* ws; };

__device__ __forceinline__ void norm_pass0(const float* xl, const float* xc, const float* g, const float* mod, int sc_off, bf16_t* H, float* ssq, int gw, int NGW) {
    int lane = lane_id(); asm volatile("" : "+v"(lane));
    for (int row = gw; row < MT; row += NGW) {
        const bool isctx = row >= ML;
        const float* xr = isctx ? xc + (size_t)(row - ML) * DM : xl + (size_t)row * DM;
        const float* mp = mod + (isctx ? 8 : (row >> 13)) * 6144;
        f32x4 v[4]; float ss = 0.f;
#pragma unroll
        for (int j = 0; j < 4; ++j) { v[j] = *(const f32x4*)(xr + 4 * lane + 256 * j); ss += (v[j][0] * v[j][0] + v[j][1] * v[j][1]) + (v[j][2] * v[j][2] + v[j][3] * v[j][3]); }
        ss = wave_sum(ss, lane);
        if (lane == 0) ssq[row] = ss;
#pragma unroll
        for (int j = 0; j < 4; ++j) { const int col = 4 * lane + 256 * j;
            const f32x4 gg = *(const f32x4*)(g + col), sc = *(const f32x4*)(mp + sc_off + col);
            const f32x4 y = v[j] * gg * (sc + 1.f);
            u32x2 o; o.x = cvtpk(y[0], y[1]); o.y = cvtpk(y[2], y[3]); *(u32x2*)(H + (size_t)row * DM + col) = o; }
    }
}
__device__ __forceinline__ void norm_ctx(float* xc, const float* part, const float* gate8, const float* g, const float* sc, bf16_t* Hc, float* ssqc, int gw, int NGW) {
    int lane = lane_id(); asm volatile("" : "+v"(lane));
    for (int row = gw; row < MC; row += NGW) {
        float* xr = xc + (size_t)row * DM;
        f32x4 v[4]; float ss = 0.f;
#pragma unroll
        for (int j = 0; j < 4; ++j) { const int col = 4 * lane + 256 * j;
            f32x4 p = *(const f32x4*)(part + (size_t)row * DM + col);
#pragma unroll
            for (int kc = 1; kc < 8; ++kc) p += *(const f32x4*)(part + ((size_t)kc * MC + row) * DM + col);
            v[j] = *(const f32x4*)(xr + col) + *(const f32x4*)(gate8 + col) * p;
            *(f32x4*)(xr + col) = v[j];
            ss += (v[j][0] * v[j][0] + v[j][1] * v[j][1]) + (v[j][2] * v[j][2] + v[j][3] * v[j][3]); }
        ss = wave_sum(ss, lane);
        if (lane == 0) ssqc[row] = ss;
#pragma unroll
        for (int j = 0; j < 4; ++j) { const int col = 4 * lane + 256 * j;
            const f32x4 gg = *(const f32x4*)(g + col), s4 = *(const f32x4*)(sc + col);
            const f32x4 y = v[j] * gg * (s4 + 1.f);
            u32x2 o; o.x = cvtpk(y[0], y[1]); o.y = cvtpk(y[2], y[3]); *(u32x2*)(Hc + (size_t)row * DM + col) = o; }
    }
}
__device__ __forceinline__ void nbias_item(LAS unsigned char* lds, const float* W, int N, int n0, const float* mod, int sh_off, float* out, int wave, int lane) {
    LAS float* shl = (LAS float*)(lds + 65536); LAS float* red = (LAS float*)(lds + 102400);
    const int tid = wave * 64 + lane;
    for (int i = tid; i < 9 * 1024; i += 512) shl[i] = mod[(i >> 10) * 6144 + sh_off + (i & 1023)];
    __syncthreads();
    const int n = n0 + lane; const bool ok = n < N;
    const float* Wp = W + (ok ? n : 0);
    float s0 = 0, s1 = 0, s2 = 0, s3 = 0, s4 = 0, s5 = 0, s6 = 0, s7 = 0, s8 = 0;
#pragma unroll 8
    for (int k = wave * 128; k < wave * 128 + 128; ++k) { const float wv = Wp[(size_t)k * N];
        s0 += shl[k] * wv; s1 += shl[1024 + k] * wv; s2 += shl[2048 + k] * wv; s3 += shl[3072 + k] * wv; s4 += shl[4096 + k] * wv;
        s5 += shl[5120 + k] * wv; s6 += shl[6144 + k] * wv; s7 += shl[7168 + k] * wv; s8 += shl[8192 + k] * wv; }
    LAS float* rp = red + wave * 576 + lane;
    rp[0] = s0; rp[64] = s1; rp[128] = s2; rp[192] = s3; rp[256] = s4; rp[320] = s5; rp[384] = s6; rp[448] = s7; rp[512] = s8;
    __syncthreads();
    for (int i = tid; i < 576; i += 512) { float sum = 0.f;
#pragma unroll
        for (int ww = 0; ww < 8; ++ww) sum += red[ww * 576 + i];
        const int b = i >> 6, l = i & 63; if (n0 + l < N) out[b * 4096 + n0 + l] = sum; else if (n0 + l < 4096) out[b * 4096 + n0 + l] = 0.f; }
    __syncthreads();
}

__global__ void __launch_bounds__(512, 2) fwd_megakernel(Args a) {
    extern __shared__ __attribute__((aligned(16))) unsigned char lds_raw[];
    LAS unsigned char* lds = (LAS unsigned char*)lds_raw;
    cg::grid_group grid = cg::this_grid();
    const int wave = __builtin_amdgcn_readfirstlane((int)threadIdx.x >> 6);
    const int G = gridDim.x, bid = blockIdx.x;
    const int vcu = (G % 8 == 0) ? (bid % 8) * (G / 8) + bid / 8 : bid;
    const int gw = vcu * 8 + wave, NGW = G * 8;
    unsigned char* ws = a.ws;
    volatile LAS unsigned* bar_st = (volatile LAS unsigned*)(lds + 131072 + 64);
    if (wave == 0 && lane_id() < 2) bar_st[lane_id()] = 0u;
    __syncthreads();
    XcdBarrier xbar = xcd_barrier_post((unsigned*)(ws + WS_BAR), bar_st, wave == 0 && lane_id() == 0);
#define GRID_BAR() xcd_barrier(xbar, wave == 0 && lane_id() == 0)
    const float* x_in = a.in[0]; const float* c_in = a.in[1]; const float* ctx_in = a.in[2]; const float* cctx_in = a.in[3];
    const float* ada_w = a.in[4]; const float* ada_b = a.in[5]; const float* norm_mix_g = a.in[6]; const float* norm_mlp_g = a.in[7]; const float* norm_out_g = a.in[8];
    float* MOD = (float*)(ws + WS_MOD); float* SSQ = (float*)(ws + WS_SSQ);
    float* ROPE16 = (float*)(ws + WS_ROPE16); float* ROPE32 = (float*)(ws + WS_ROPE32);
    bf16_t* KPE = (bf16_t*)(ws + WS_KPE); float* XC = (float*)(ws + WS_XC);
    bf16_t* H = (bf16_t*)(ws + WS_H); bf16_t* Qb = (bf16_t*)(ws + WS_Q); bf16_t* Kb = (bf16_t*)(ws + WS_K); bf16_t* VTb = (bf16_t*)(ws + WS_VT);
    bf16_t* Ob = (bf16_t*)(ws + WS_O); bf16_t* LAT = (bf16_t*)(ws + WS_LAT); bf16_t* HID = (bf16_t*)(ws + WS_HID);
    float* X = a.out;
    float* NBIAS = (float*)(ws + WS_NBIAS); float* SSQN = (float*)(ws + WS_SSQN); float* PART = (float*)(ws + WS_PART);

    {
        const int lane = lane_id(), tid = wave * 64 + lane;
        LAS float* act = (LAS float*)(lds + 65536); LAS float* red = (LAS float*)(lds + 102400);
        for (int i = tid; i < 9 * 1024; i += 512) { const int b = i >> 10, k = i & 1023; const float v = b < 8 ? c_in[b * 1024 + k] : cctx_in[k]; act[i] = v / (1.f + __builtin_amdgcn_exp2f(-v * LOG2E)); }
        __syncthreads();
        for (int it = bid; it < 384; it += G) {
            const int layer = it / 96, n0 = (it % 96) * 64;
            const float* W = ada_w + (size_t)layer * 1024 * 6144 + n0 + lane;
            float s0 = 0, s1 = 0, s2 = 0, s3 = 0, s4 = 0, s5 = 0, s6 = 0, s7 = 0, s8 = 0;
#pragma unroll 8
            for (int k = wave * 128; k < wave * 128 + 128; ++k) { const float wv = W[(size_t)k * 6144];
                s0 += act[k] * wv; s1 += act[1024 + k] * wv; s2 += act[2048 + k] * wv; s3 += act[3072 + k] * wv; s4 += act[4096 + k] * wv;
                s5 += act[5120 + k] * wv; s6 += act[6144 + k] * wv; s7 += act[7168 + k] * wv; s8 += act[8192 + k] * wv; }
            LAS float* rp = red + wave * 576 + lane;
            rp[0] = s0; rp[64] = s1; rp[128] = s2; rp[192] = s3; rp[256] = s4; rp[320] = s5; rp[384] = s6; rp[448] = s7; rp[512] = s8;
            __syncthreads();
            for (int i = tid; i < 576; i += 512) { float s = 0.f;
#pragma unroll
                for (int ww = 0; ww < 8; ++ww) s += red[ww * 576 + i];
                const int b = i >> 6, l = i & 63; MOD[((size_t)layer * 9 + b) * 6144 + n0 + l] = s + ada_b[layer * 6144 + n0 + l]; }
            __syncthreads();
        }
        __syncthreads();
        LAS float* scr = (LAS float*)(lds + wave * 16384);
        int base = 0;
#define TR(Wsrc, K_, N_, dst, gsc) do { const int n_ = ((K_) / 64) * ((N_) / 32); \
            for (int it_ = (gw + NGW - (base % NGW)) % NGW; it_ < n_; it_ += NGW) transpose_item((Wsrc), (K_), (N_), (dst), (gsc), scr, it_, lane); base += n_; } while (0)
        for (int L = 0; L < 4; ++L) {
            TR(a.in[9] + (size_t)L * DM * FF, DM, FF, (bf16_t*)(ws + WS_W1T + (size_t)L * 8 * MiB), (const float*)nullptr);
            TR(a.in[10] + (size_t)L * FF * DM, FF, DM, (bf16_t*)(ws + WS_W2T + (size_t)L * 8 * MiB), (const float*)nullptr);
        }
        for (int j = 0; j < 2; ++j) {
            unsigned char* mb = ws + WS_MLA + (size_t)j * 5 * MiB;
            TR(a.in[11] + (size_t)j * DM * 416, DM, 416, (bf16_t*)mb, (const float*)nullptr);
            TR(a.in[13] + (size_t)j * 256 * 1536, 256, 1536, (bf16_t*)(mb + 1 * MiB), a.in[12] + j * 256);
            TR(a.in[15] + (size_t)j * 128 * 2048, 128, 2048, (bf16_t*)(mb + 1 * MiB + 768 * 1024), a.in[14] + j * 128);
            TR(a.in[16] + (size_t)j * DM * DM, DM, DM, (bf16_t*)(mb + 3 * MiB), (const float*)nullptr);
            u32x4* z = (u32x4*)(mb + (size_t)416 * 1024 * 2);
            for (int i = gw * 64 + lane; i < 96 * 1024 * 2 / 16; i += NGW * 64) z[i] = (u32x4){0u, 0u, 0u, 0u};
        }
        TR(a.in[17], DM, 1536, (bf16_t*)(ws + WS_SWA), (const float*)nullptr);
        TR(a.in[19], DM, DM, (bf16_t*)(ws + WS_SWA + 3 * MiB), (const float*)nullptr);
        TR(a.in[20], DM, 3072, (bf16_t*)(ws + WS_NA), (const float*)nullptr);
        TR(a.in[22], DM, DM, (bf16_t*)(ws + WS_NA + 6 * MiB), (const float*)nullptr);
#undef TR
        for (int i = gw * 64 + lane; i < 8192 * 16; i += NGW * 64) { const int t = i >> 4, p = i & 15; const int f = p & 7; const float pos = (float)(p < 8 ? (t >> 6) : (t & 63));
            const float ang = pos * __builtin_amdgcn_exp2f(-(float)f * (13.287712379549449f / 8.f)); float sn, cs; sincos_red(ang, sn, cs); ROPE16[2 * i] = cs; ROPE16[2 * i + 1] = sn; }
        for (int i = gw * 64 + lane; i < 8192 * 32; i += NGW * 64) { const int t = i >> 5, p = i & 31; const int f = p & 15; const float pos = (float)(p < 16 ? (t >> 6) : (t & 63));
            const float ang = pos * __builtin_amdgcn_exp2f(-(float)f * (13.287712379549449f / 16.f)); float sn, cs; sincos_red(ang, sn, cs); ROPE32[2 * i] = cs; ROPE32[2 * i + 1] = sn; }
        for (int i = gw * 64 + lane; i < 4 * MT; i += NGW * 64) SSQ[i] = 0.f;
        for (int i = gw * 64 + lane; i < 8 * MT; i += NGW * 64) SSQN[i] = 0.f;
    }
    grid.sync();
    {
        const int lane = lane_id();
        for (int it = bid; it < 8 + 24 + 48 + 8 + 256; it += G) {
            int r = it; const float* W; int N, L, which, blk;
            if (r < 8) { W = a.in[11]; N = 416; L = 0; which = 0; blk = r; }
            else if ((r -= 8) < 24) { W = a.in[17]; N = 1536; L = 1; which = 0; blk = r; }
            else if ((r -= 24) < 48) { W = a.in[20]; N = 3072; L = 2; which = 0; blk = r; }
            else if ((r -= 48) < 8) { W = a.in[11] + (size_t)DM * 416; N = 416; L = 3; which = 0; blk = r; }
            else { r -= 8; L = r >> 6; blk = r & 63; W = a.in[9] + (size_t)L * DM * FF; N = FF; which = 1; }
            nbias_item(lds, W, N, blk * 64, MOD + (size_t)L * 9 * 6144, which ? 3072 : 0, NBIAS + (size_t)(L * 2 + which) * 9 * 4096, wave, lane);
        }
        norm_pass0(x_in, ctx_in, norm_mix_g, MOD, 1024, H, SSQN, gw, NGW);
        for (int i = gw * 64 + lane; i < MC * DM / 4; i += NGW * 64) ((f32x4*)XC)[i] = ((const f32x4*)ctx_in)[i];
    }
    GRID_BAR();

    for (int L = 0; L < 4; ++L) {
        const int kind = L % 3, jl = L / 3; const bool last = (L == 3);
        const float* modL = MOD + (size_t)L * 9 * 6144;
        const float* xl = (L == 0) ? x_in : X; const float* xc = (L == 0) ? ctx_in : XC;
        const float* ssqn1 = SSQN + (size_t)(2 * L) * MT; const float* nbias1 = NBIAS + (size_t)(L * 2) * 9 * 4096;
        if (kind == 0) {
            unsigned char* mb = ws + WS_MLA + (size_t)jl * 5 * MiB;
            float* ssq_q = SSQ + (size_t)jl * 2 * MT; float* ssq_kv = ssq_q + MT;
            {
                pg8::Gemm g{H, (const bf16_t*)mb, MT, 512, DM, DM, DM}; pg8::StaticOrder S; S.init(MT, 512, G, bid);
                EpiLat E{LAT, ssq_q, ssq_kv, KPE, ROPE16, ssqn1, nbias1};
                pg8::gemm_phase<EpiLat, pg8::StaticOrder, true>(lds, g, S, E, wave);
            }
            GRID_BAR();
            {
                pg8::Gemm g{LAT, (const bf16_t*)(mb + 1 * MiB), MT, 1536, 256, 512, 256}; pg8::StaticOrder S; S.init(MT, 1536, G, bid);
                EpiProj<0> E{Qb, nullptr, nullptr, ROPE16, ssq_q, 0.10206207261596577f * LOG2E, nullptr};
                pg8::gemm_phase<EpiProj<0>, pg8::StaticOrder, true>(lds, g, S, E, wave);
            }
            {
                pg8::Gemm g{LAT + 256, (const bf16_t*)(mb + 1 * MiB + 768 * 1024), MT, 2048, 128, 512, 128}; pg8::StaticOrder S; S.init(MT, 2048, G, bid);
                EpiProj<1> E{nullptr, Kb, VTb, nullptr, ssq_kv, 1.f, nullptr};
                pg8::gemm_phase<EpiProj<1>, pg8::StaticOrder, true>(lds, g, S, E, wave);
            }
        } else if (kind == 1) {
            pg8::Gemm g{H, (const bf16_t*)(ws + WS_SWA), MT, 1536, DM, DM, DM}; pg8::StaticOrder S; S.init(MT, 1536, G, bid);
            EpiProj<2> E{Qb, Kb, VTb, ROPE32, ssqn1, 0.125f * LOG2E, nbias1};
            pg8::gemm_phase<EpiProj<2>, pg8::StaticOrder, true>(lds, g, S, E, wave);
        } else {
            pg8::Gemm g{H, (const bf16_t*)(ws + WS_NA), MT, 3072, DM, DM, DM}; pg8::StaticOrder S; S.init(MT, 3072, G, bid);
            EpiProj<3> E{Qb, Kb, VTb, nullptr, ssqn1, 0.125f * LOG2E, nbias1};
            pg8::gemm_phase<EpiProj<3>, pg8::StaticOrder, true>(lds, g, S, E, wave);
        }
        GRID_BAR();
        {
            AttnP P{Qb, Kb, KPE, VTb, Ob, a.in[18], a.in[21], last ? 4096 : 4096 + 128};
            if (kind == 0) attn_phase<0>(lds, P, vcu, G, wave);
            else if (kind == 1) attn_phase<1>(lds, P, vcu, G, wave);
            else attn_phase<2>(lds, P, vcu, G, wave);
        }
        GRID_BAR();
        const int Mres = last ? ML : MT;
        {
            const bf16_t* wo = (const bf16_t*)(kind == 0 ? ws + WS_MLA + (size_t)jl * 5 * MiB + 3 * MiB : (kind == 1 ? ws + WS_SWA + 3 * MiB : ws + WS_NA + 6 * MiB));
            {
                pg8::Gemm g{Ob, wo, ML, DM, DM, DM, DM}; pg8::StaticOrder S; S.init(ML, DM, G, bid);
                EpiResid E{xl, XC, X, XC, modL + 2048, H, norm_mlp_g + L * DM, modL + 4096, SSQN + (size_t)(2 * L + 1) * MT};
                pg8::gemm_phase<EpiResid, pg8::StaticOrder, true>(lds, g, S, E, wave);
            }
            if (!last) {
                pg8::Gemm g{Ob, wo, MT, DM, 128, DM, DM}; pg8::CtxSplitOrder S{bid, G, 128};
                EpiCtxPartial E{PART, 128};
                pg8::gemm_phase<EpiCtxPartial, pg8::CtxSplitOrder, true>(lds, g, S, E, wave);
            }
        }
        GRID_BAR();
        if (!last) { norm_ctx(XC, PART, modL + 2048 + 8 * 6144, norm_mlp_g + L * DM, modL + 8 * 6144 + 4096, H + (size_t)ML * DM, SSQN + (size_t)(2 * L + 1) * MT + ML, gw, NGW); GRID_BAR(); }
        {
            pg8::Gemm g{H, (const bf16_t*)(ws + WS_W1T + (size_t)L * 8 * MiB), Mres, FF, DM, DM, DM}; pg8::StaticOrder S; S.init(Mres, FF, G, bid);
            EpiSqRelu E{HID, FF, SSQN + (size_t)(2 * L + 1) * MT, NBIAS + (size_t)(L * 2 + 1) * 9 * 4096};
            pg8::gemm_phase<EpiSqRelu, pg8::StaticOrder, true>(lds, g, S, E, wave);
        }
        GRID_BAR();
        {
            const bf16_t* w2t = (const bf16_t*)(ws + WS_W2T + (size_t)L * 8 * MiB);
            {
                pg8::Gemm g{HID, w2t, ML, DM, FF, FF, FF}; pg8::StaticOrder S; S.init(ML, DM, G, bid);
                EpiResid E{X, XC, X, XC, modL + 5120, last ? nullptr : H, norm_mix_g + (L + 1) * DM, MOD + (size_t)(L + 1) * 9 * 6144 + 1024, SSQN + (size_t)(2 * L + 2) * MT};
                pg8::gemm_phase<EpiResid, pg8::StaticOrder, true>(lds, g, S, E, wave);
            }
            if (!last) {
                pg8::Gemm g{HID, w2t, MT, DM, 512, FF, FF}; pg8::CtxSplitOrder S{bid, G, 512};
                EpiCtxPartial E{PART, 512};
                pg8::gemm_phase<EpiCtxPartial, pg8::CtxSplitOrder, true>(lds, g, S, E, wave);
            }
        }
        GRID_BAR();
        if (!last) { norm_ctx(XC, PART, modL + 5120 + 8 * 6144, norm_mix_g + (L + 1) * DM, MOD + (size_t)(L + 1) * 9 * 6144 + 8 * 6144 + 1024, H + (size_t)ML * DM, SSQN + (size_t)(2 * L + 2) * MT + ML, gw, NGW); GRID_BAR(); }
    }
    int lane = lane_id(); asm volatile("" : "+v"(lane));
    for (int row = gw; row < ML; row += NGW) {
        float* xr = X + (size_t)row * DM;
        f32x4 v[4]; float ss = 0.f;
#pragma unroll
        for (int j = 0; j < 4; ++j) { v[j] = *(const f32x4*)(xr + 4 * lane + 256 * j); ss += (v[j][0] * v[j][0] + v[j][1] * v[j][1]) + (v[j][2] * v[j][2] + v[j][3] * v[j][3]); }
        const float rstd = rsqrtf(wave_sum(ss, lane) * (1.f / DM) + EPS);
#pragma unroll
        for (int j = 0; j < 4; ++j) { const int col = 4 * lane + 256 * j; const f32x4 gg = *(const f32x4*)(norm_out_g + col); *(f32x4*)(xr + col) = v[j] * rstd * gg; }
    }
}

constexpr int LDS_BYTES = 147456;
extern "C" void kernel_launch(void* const* d_in, const int* in_sizes, int n_in, void* d_out, int out_size, void* d_ws, size_t ws_size, hipStream_t stream) {
    static int grid = 0;
    if (grid == 0) {
        if (n_in != 23 || out_size != ML * DM || ws_size < WS_END) { fprintf(stderr, "kernel_launch: unexpected shapes (n_in %d out %d ws %zu)\n", n_in, out_size, ws_size); grid = -1; return; }
        int dev = 0, cus = 0, per_cu = 0;
        hipGetDevice(&dev); hipDeviceGetAttribute(&cus, hipDeviceAttributeMultiprocessorCount, dev);
        if (hipFuncSetAttribute((const void*)fwd_megakernel, hipFuncAttributeMaxDynamicSharedMemorySize, LDS_BYTES) != hipSuccess) { fprintf(stderr, "kernel_launch: hipFuncSetAttribute failed\n"); grid = -1; return; }
        if (hipOccupancyMaxActiveBlocksPerMultiprocessor(&per_cu, (const void*)fwd_megakernel, 512, LDS_BYTES) != hipSuccess || per_cu < 1) { fprintf(stderr, "kernel_launch: occupancy query gave %d\n", per_cu); per_cu = 1; }
        (void)hipGetLastError();
        grid = cus * per_cu;
    }
    if (grid < 0) return;
    if (hipMemsetAsync((char*)d_ws + WS_BAR, 0, XCD_BAR_WORDS * 4, stream) != hipSuccess) { fprintf(stderr, "kernel_launch: memset of the barrier words failed\n"); return; }
    Args a{};
    for (int i = 0; i < 23; ++i) a.in[i] = (const float*)d_in[i];
    a.out = (float*)d_out; a.ws = (unsigned char*)d_ws;
    void* args[] = {&a};
    hipError_t e = hipLaunchCooperativeKernel((const void*)fwd_megakernel, dim3(grid), dim3(512), args, LDS_BYTES, stream);
    if (e != hipSuccess) fprintf(stderr, "cooperative launch failed: %s (grid %d)\n", hipGetErrorString(e), grid);
}
```

```cpp
#include <hip/hip_runtime.h>
#include <hip/hip_cooperative_groups.h>
#include <cstdio>
#include <cstdint>
namespace cg = cooperative_groups;

#define LAS __attribute__((address_space(3)))
typedef unsigned short bf16_t;
typedef short bf16x8 __attribute__((ext_vector_type(8)));
typedef float f32x4 __attribute__((ext_vector_type(4)));
typedef float f32x16 __attribute__((ext_vector_type(16)));
typedef unsigned u32x4 __attribute__((ext_vector_type(4)));
typedef unsigned u32x2 __attribute__((ext_vector_type(2)));

constexpr int NB = 8, SEQ = 8192, DM = 1024, CTX = 256, FF = 4096;
constexpr int ML = NB * SEQ;
constexpr int MC = NB * CTX;
constexpr int MT = ML + MC;
constexpr int KVLEN = CTX + SEQ;
constexpr float EPS = 1e-6f;
constexpr float LOG2E = 1.4426950408889634f;

__device__ __forceinline__ unsigned cvtpk(float lo, float hi) {
    typedef float f2 __attribute__((ext_vector_type(2))); typedef __bf16 b2 __attribute__((ext_vector_type(2)));
    f2 v = {lo, hi}; b2 b = __builtin_convertvector(v, b2); return __builtin_bit_cast(unsigned, b);
}
__device__ __forceinline__ int lane_id() { int l; asm volatile("v_mbcnt_lo_u32_b32 %0, -1, 0\n\tv_mbcnt_hi_u32_b32 %0, -1, %0" : "=v"(l)); return l; }
__device__ __forceinline__ float shfl_xor_l(float v, int mask, int lane) { return __int_as_float(__builtin_amdgcn_ds_bpermute((lane ^ mask) << 2, __float_as_int(v))); }
__device__ __forceinline__ int perm16(int x) { return 8 * ((x >> 2) & 1) + (x & 3) + 4 * (x >> 3); }

namespace pg8 {
constexpr int BM = 256, BK = 64, HALF = 128, HTB = HALF * BK * 2, STAGE_BYTES = 8 * HTB, NXCD = 8, WGM = 8;
__host__ __device__ __forceinline__ int lds_byte(int r, int c) { const int st = (r >> 4) * 2 + (c >> 5), rr = r & 15, cc = c & 31, ob = rr * 64 + cc * 2; return st * 1024 + (ob ^ (((ob >> 9) & 1) << 5)); }
__host__ __device__ __forceinline__ void stage_rc(int b, int& R, int& C) { const int st = b / 1024, sb = b % 1024, swz = sb ^ (((sb >> 9) & 1) << 5); R = (st >> 1) * 16 + swz / 64; C = (st & 1) * 32 + (swz % 64) / 2; }
__host__ __device__ __forceinline__ int perm32(int rho) { const int n = rho >> 4, i = rho & 15; return 8 * (i >> 2) + 4 * n + (i & 3); }

struct Unit { int pm, pn, koff; };
struct Gemm { const bf16_t* A; const bf16_t* Bt; int M, N, K, lda, ldb; };

struct StaticOrder {
    int nM, nN, nwg, G, c;
    __device__ void init(int M, int N, int G_, int c_) { nM = M / BM; nN = N / BM; nwg = nM * nN; G = G_; c = c_; }
    __device__ bool next(int i, Unit& u) const {
        const long L = (long)i * G + c; if (L >= nwg) return false;
        int wgid = (int)L; { const int q = nwg / NXCD, r = nwg % NXCD, xcd = wgid % NXCD, off = wgid / NXCD; wgid = (xcd < r ? xcd * (q + 1) : r * (q + 1) + (xcd - r) * q) + off; }
        const int nig = WGM * nN, gid = wgid / nig, fm = gid * WGM, gsz = (nM - fm) < WGM ? (nM - fm) : WGM;
        u.pm = fm + ((wgid % nig) % gsz); u.pn = (wgid % nig) / gsz; u.koff = 0; return true;
    }
};

struct CtxSplitOrder {
    int c, G, kchunk;
    __device__ bool next(int i, Unit& u) const { const int L = i * G + c; if (L >= 256) return false; u.pm = 256 + (L >> 5); u.pn = (L >> 3) & 3; u.koff = (L & 7) * kchunk; return true; }
};

template <class Epi, class Sched, bool ALIGN_EPI>
__device__ __forceinline__ void gemm_phase(LAS unsigned char* lds, const Gemm g, const Sched& S, const Epi& E, int wave_s) {
    int tid_l = wave_s * 64 + lane_id(); asm volatile("" : "+v"(tid_l));
    const int tid = tid_l, wid = __builtin_amdgcn_readfirstlane(tid >> 6), lane = tid & 63, wr = wid >> 2, wc = wid & 3, fr = lane & 15, fq = lane >> 4;
    const int K = g.K, nt = K / BK;
    unsigned voffA[2], voffB[2];
#pragma unroll
    for (int i = 0; i < 2; ++i) { int R, C; stage_rc(tid * 16 + i * 8192, R, C); const int Rb = Epi::PERM ? ((R & ~31) + perm32(R & 31)) : R;
        voffA[i] = (unsigned)(R * g.lda + C) * 2u; voffB[i] = (unsigned)(Rb * g.ldb + C) * 2u; }
    const size_t kstep = (size_t)(BK * 2);
    const size_t hstepA = (size_t)HALF * g.lda * 2, hstepB = (size_t)HALF * g.ldb * 2;
    const size_t tstepA = 2 * hstepA, tstepB = 2 * hstepB;
    const unsigned ldsw = (unsigned)wid * 1024u;
    const int aoff = lds_byte(wr * 64 + fr, fq * 8), boff = lds_byte(wc * 32 + fr, fq * 8);
#define PG8_SA(b, h) (((b) * 2 + (h)) * HTB)
#define PG8_SB(b, h) ((4 + (b) * 2 + (h)) * HTB)
#define PG8_STAGE(bufoff, gbase, voff) do { _Pragma("unroll") for (int _i = 0; _i < 2; ++_i) \
        __builtin_amdgcn_global_load_lds((const unsigned*)((const char*)(gbase) + (voff)[_i]), (LAS unsigned*)(lds + (bufoff) + ldsw + _i * 8192), 16, 0, 0); } while (0)
#define PG8_LDA(dst, b, h) do { _Pragma("unroll") for (int m = 0; m < 4; ++m) _Pragma("unroll") for (int k = 0; k < 2; ++k) dst[m][k] = *(const LAS bf16x8*)(lds + PG8_SA(b, h) + aoff + m * 2048 + k * 1024); } while (0)
#define PG8_LDB(dst, b, h) do { _Pragma("unroll") for (int n = 0; n < 2; ++n) _Pragma("unroll") for (int k = 0; k < 2; ++k) dst[n][k] = *(const LAS bf16x8*)(lds + PG8_SB(b, h) + boff + n * 2048 + k * 1024); } while (0)
#define PG8_MMA(ai, bj, At, Bt) do { __builtin_amdgcn_s_setprio(1); _Pragma("unroll") for (int m = 0; m < 4; ++m) _Pragma("unroll") for (int n = 0; n < 2; ++n) _Pragma("unroll") for (int k = 0; k < 2; ++k) \
        acc[ai][bj][m][n] = __builtin_amdgcn_mfma_f32_16x16x32_bf16(Bt[n][k], At[m][k], acc[ai][bj][m][n], 0, 0, 0); __builtin_amdgcn_s_setprio(0); } while (0)
#define PG8_WAIT_V(n) asm volatile("s_waitcnt vmcnt(" #n ")" ::: "memory")
#define PG8_WAIT_L(n) asm volatile("s_waitcnt lgkmcnt(" #n ")" ::: "memory")
#define PG8_BAR __builtin_amdgcn_s_barrier()
#define PG8_SCHED __builtin_amdgcn_sched_barrier(0)
    Unit cur, nxt; int ui = 0;
    if (!S.next(0, cur)) return;
    f32x4 acc[2][2][4][2];
#pragma unroll
    for (int a = 0; a < 2; ++a)
#pragma unroll
        for (int b = 0; b < 2; ++b)
#pragma unroll
            for (int m = 0; m < 4; ++m)
#pragma unroll
                for (int n = 0; n < 2; ++n) acc[a][b][m][n] = (f32x4){0.f, 0.f, 0.f, 0.f};
    bf16x8 At[4][2], B0[2][2], B1[2][2];
    const char* cA = (const char*)g.A + (size_t)cur.pm * tstepA + (size_t)cur.koff * 2; const char* cB = (const char*)g.Bt + (size_t)cur.pn * tstepB + (size_t)cur.koff * 2;
    PG8_STAGE(PG8_SB(0, 0), cB, voffB); PG8_STAGE(PG8_SB(0, 1), cB + hstepB, voffB); PG8_STAGE(PG8_SA(0, 0), cA, voffA); PG8_STAGE(PG8_SA(0, 1), cA + hstepA, voffA);
    if (wr == 1) PG8_BAR;
    PG8_WAIT_V(2); PG8_BAR;
    PG8_STAGE(PG8_SB(1, 0), cB + kstep, voffB); PG8_STAGE(PG8_SA(1, 0), cA + kstep, voffA); PG8_STAGE(PG8_SB(1, 1), cB + hstepB + kstep, voffB);
    PG8_WAIT_V(6); PG8_BAR;
    for (;;) {
        const bool has_next = S.next(ui + 1, nxt);
        const char* nA = has_next ? (const char*)g.A + (size_t)nxt.pm * tstepA + (size_t)nxt.koff * 2 : cA; const char* nB = has_next ? (const char*)g.Bt + (size_t)nxt.pn * tstepB + (size_t)nxt.koff * 2 : cB;
        for (int t = 0; t < nt; t += 2) {
            const bool last = (t == nt - 2);
            const char* a1 = cA + (size_t)(t + 1) * kstep;
            const char* a2 = last ? nA : cA + (size_t)(t + 2) * kstep; const char* b2 = last ? nB : cB + (size_t)(t + 2) * kstep;
            const char* a3 = a2 + kstep; const char* b3 = b2 + kstep;
            PG8_LDB(B0, 0, 0); PG8_LDB(B1, 0, 1); PG8_SCHED; PG8_LDA(At, 0, 0); PG8_STAGE(PG8_SA(1, 1), a1 + hstepA, voffA);
            PG8_WAIT_V(8); PG8_WAIT_L(0); PG8_BAR; PG8_MMA(0, 0, At, B0); PG8_MMA(0, 1, At, B1); PG8_BAR; PG8_SCHED;
            PG8_LDA(At, 0, 1); PG8_STAGE(PG8_SB(0, 0), b2, voffB); PG8_STAGE(PG8_SB(0, 1), b2 + hstepB, voffB); PG8_STAGE(PG8_SA(0, 0), a2, voffA);
            PG8_WAIT_V(8); PG8_WAIT_L(0); PG8_BAR; PG8_MMA(1, 0, At, B0); PG8_MMA(1, 1, At, B1); PG8_BAR; PG8_SCHED;
            PG8_LDB(B0, 1, 0); PG8_LDB(B1, 1, 1); PG8_SCHED; PG8_LDA(At, 1, 0); PG8_STAGE(PG8_SA(0, 1), a2 + hstepA, voffA);
            PG8_WAIT_V(8); PG8_WAIT_L(0); PG8_BAR; PG8_MMA(0, 0, At, B0); PG8_MMA(0, 1, At, B1); PG8_BAR; PG8_SCHED;
            PG8_LDA(At, 1, 1); PG8_STAGE(PG8_SB(1, 0), b3, voffB); PG8_STAGE(PG8_SB(1, 1), b3 + hstepB, voffB); PG8_STAGE(PG8_SA(1, 0), a3, voffA);
            PG8_WAIT_V(8); PG8_WAIT_L(0); PG8_BAR; PG8_MMA(1, 0, At, B0); PG8_MMA(1, 1, At, B1); PG8_BAR; PG8_SCHED;
        }
        if constexpr (ALIGN_EPI) { if (wr == 0) PG8_BAR; }
        E(acc, cur, wr, wc, fr, fq);
        if (!has_next) break;
#pragma unroll
        for (int a = 0; a < 2; ++a)
#pragma unroll
            for (int b = 0; b < 2; ++b)
#pragma unroll
                for (int m = 0; m < 4; ++m)
#pragma unroll
                    for (int n = 0; n < 2; ++n) acc[a][b][m][n] = (f32x4){0.f, 0.f, 0.f, 0.f};
        cur = nxt; cA = nA; cB = nB; ++ui;
        if constexpr (ALIGN_EPI) { if (wr == 1) PG8_BAR; }
    }
    PG8_WAIT_V(0);
    if constexpr (!ALIGN_EPI) { if (wr == 0) PG8_BAR; }
    PG8_BAR;
#undef PG8_SA
#undef PG8_SB
#undef PG8_STAGE
#undef PG8_LDA
#undef PG8_LDB
#undef PG8_MMA
#undef PG8_WAIT_V
#undef PG8_WAIT_L
#undef PG8_BAR
#undef PG8_SCHED
}
}

typedef const f32x4 (&AccRef)[2][2][4][2];

__device__ __forceinline__ void rope8(float (&v)[8], const float* tab) {
    const f32x4 t0 = *(const f32x4*)tab, t1 = *(const f32x4*)(tab + 4);
    float x1, x2;
    x1 = v[0]; x2 = v[1]; v[0] = x1 * t0[0] - x2 * t0[1]; v[1] = x1 * t0[1] + x2 * t0[0];
    x1 = v[2]; x2 = v[3]; v[2] = x1 * t0[2] - x2 * t0[3]; v[3] = x1 * t0[3] + x2 * t0[2];
    x1 = v[4]; x2 = v[5]; v[4] = x1 * t1[0] - x2 * t1[1]; v[5] = x1 * t1[1] + x2 * t1[0];
    x1 = v[6]; x2 = v[7]; v[6] = x1 * t1[2] - x2 * t1[3]; v[7] = x1 * t1[3] + x2 * t1[2];
}
__device__ __forceinline__ void rope8v(float (&v)[8], const f32x4 t0, const f32x4 t1) {
    float x1, x2;
    x1 = v[0]; x2 = v[1]; v[0] = x1 * t0[0] - x2 * t0[1]; v[1] = x1 * t0[1] + x2 * t0[0];
    x1 = v[2]; x2 = v[3]; v[2] = x1 * t0[2] - x2 * t0[3]; v[3] = x1 * t0[3] + x2 * t0[2];
    x1 = v[4]; x2 = v[5]; v[4] = x1 * t1[0] - x2 * t1[1]; v[5] = x1 * t1[1] + x2 * t1[0];
    x1 = v[6]; x2 = v[7]; v[6] = x1 * t1[2] - x2 * t1[3]; v[7] = x1 * t1[3] + x2 * t1[2];
}
__device__ __forceinline__ u32x4 pack8(const float (&v)[8]) { u32x4 w; w.x = cvtpk(v[0], v[1]); w.y = cvtpk(v[2], v[3]); w.z = cvtpk(v[4], v[5]); w.w = cvtpk(v[6], v[7]); return w; }

template <int MODE> struct EpiProj {
    static constexpr bool PERM = true;
    bf16_t* Q; bf16_t* K; bf16_t* VT; const float* rope; const float* ssq; float qscale; const float* nbias;
    __device__ __forceinline__ void operator()(AccRef acc, const pg8::Unit& u, int wr, int wc, int fr_, int fq_) const {
        int lane_e = lane_id(); asm volatile("" : "+v"(lane_e)); const int fr = lane_e & 15, fq = lane_e >> 4; (void)fr_; (void)fq_;
        constexpr int LDQ = (MODE == 0) ? 1536 : 1024, NQ = (MODE == 0) ? 1536 : (MODE == 1 ? 0 : 1024);
        constexpr int LDK = (MODE == 2) ? 256 : 1024, NK = LDK, VCOLS = LDK;
        constexpr int TS = (MODE == 2) ? 64 : 32;
        const bool isctx = u.pm >= 256;
        const int row0 = u.pm * 256 + wr * 64 + fr, col0 = u.pn * 256 + wc * 32 + 8 * fq;
        f32x4 nbv[2][2]; float rs[4];
#pragma unroll
        for (int bj = 0; bj < 2; ++bj) {
            const int col = col0 + 128 * bj;
            if (MODE >= 2) { const float* nb = nbias + (isctx ? 8 : (u.pm >> 5)) * 4096 + col; nbv[bj][0] = *(const f32x4*)nb; nbv[bj][1] = *(const f32x4*)(nb + 4); }
            else { nbv[bj][0] = (f32x4){0.f, 0.f, 0.f, 0.f}; nbv[bj][1] = nbv[bj][0]; }
        }
#pragma unroll
        for (int r = 0; r < 8; ++r) {
            const int ai = r >> 2, m = r & 3; const int row = row0 + 128 * ai + 16 * m;
            if (m == 0) {
#pragma unroll
                for (int q = 0; q < 4; ++q) rs[q] = ssq[row0 + 128 * ai + 16 * q];
#pragma unroll
                for (int q = 0; q < 4; ++q) rs[q] = rsqrtf(rs[q] * (MODE == 0 ? 1.f / 256.f : (MODE == 1 ? 1.f / 128.f : 1.f / 1024.f)) + EPS);
            }
            const int rc = row - ML;
            const int b = isctx ? (rc >> 8) : (u.pm >> 5);
            const int kpos = isctx ? (rc & 255) : 256 + (row & 8191);
            const size_t kvrow = (size_t)b * KVLEN + kpos;
            const int vpos = (kpos & ~15) | perm16(kpos & 15);
            f32x4 tc[2][2] = {}; bool rp[2] = {false, false}; int roff[2] = {0, 0};
#pragma unroll
            for (int bj = 0; bj < 2; ++bj) { const int col = col0 + 128 * bj;
                if (MODE == 2) { rp[bj] = !isctx && col < 1280; roff[bj] = ((col & 63) >> 1) * 2; }
                else if (MODE == 0) { const int c96 = col % 96; rp[bj] = !isctx && c96 >= 64; roff[bj] = rp[bj] ? ((c96 - 64) >> 1) * 2 : 0; } }
            if (MODE == 2) {
#pragma unroll
                for (int bj = 0; bj < 2; ++bj) if (rp[bj]) { const float* tp = rope + (size_t)(row & 8191) * TS + roff[bj]; tc[bj][0] = *(const f32x4*)tp; tc[bj][1] = *(const f32x4*)(tp + 4); }
            }
#pragma unroll
            for (int bj = 0; bj < 2; ++bj) {
                const int col = col0 + 128 * bj;
                float v[8];
#pragma unroll
                for (int j = 0; j < 4; ++j) { v[j] = acc[ai][bj][m][0][j] * rs[m] + nbv[bj][0][j]; v[4 + j] = acc[ai][bj][m][1][j] * rs[m] + nbv[bj][1][j]; }
                if (MODE == 0 && rp[bj]) { const float* tp = rope + (size_t)(row & 8191) * TS + roff[bj]; tc[bj][0] = *(const f32x4*)tp; tc[bj][1] = *(const f32x4*)(tp + 4); }
                if ((MODE == 0 || MODE == 2) && rp[bj]) rope8v(v, tc[bj][0], tc[bj][1]);
                bool isv; int kc;
                if (MODE == 1) { const int within = col & 127; isv = within >= 64; kc = (col >> 7) * 64 + (within & 63); }
                else { isv = col >= NQ + NK; kc = isv ? col - NQ - NK : col - NQ; }
                if (MODE != 1 && col < NQ) {
#pragma unroll
                    for (int j = 0; j < 8; ++j) v[j] *= qscale;
                    *(u32x4*)(Q + (size_t)row * LDQ + col) = pack8(v);
                } else if (MODE != 0 && !isv) {
                    *(u32x4*)(K + kvrow * LDK + kc) = pack8(v);
                } else if (MODE != 0) {
                    bf16_t* vp = VT + ((size_t)(b * VCOLS + kc)) * KVLEN + vpos;
#pragma unroll
                    for (int j = 0; j < 8; ++j) vp[(size_t)j * KVLEN] = (bf16_t)(cvtpk(v[j], 0.f) & 0xffffu);
                }
            }
        }
    }
};

struct EpiLat {
    static constexpr bool PERM = true;
    bf16_t* lat; float* ssq_q; float* ssq_kv; bf16_t* KPE; const float* rope; const float* ssqn; const float* nbias;
    __device__ __forceinline__ void operator()(AccRef acc, const pg8::Unit& u, int wr, int wc, int fr_, int fq_) const {
        int lane_e = lane_id(); asm volatile("" : "+v"(lane_e)); const int fr = lane_e & 15, fq = lane_e >> 4; (void)fr_; (void)fq_;
        float rsv[8]; f32x4 nbv[2][2];
        { const int row0 = u.pm * 256 + wr * 64 + fr; const float* nb = nbias + (u.pm >= 256 ? 8 : (u.pm >> 5)) * 4096 + u.pn * 256 + wc * 32 + 8 * fq;
#pragma unroll
          for (int bj = 0; bj < 2; ++bj) { nbv[bj][0] = *(const f32x4*)(nb + 128 * bj); nbv[bj][1] = *(const f32x4*)(nb + 128 * bj + 4); }
#pragma unroll
          for (int r = 0; r < 8; ++r) rsv[r] = ssqn[row0 + 128 * (r >> 2) + 16 * (r & 3)];
#pragma unroll
          for (int r = 0; r < 8; ++r) rsv[r] = rsqrtf(rsv[r] * (1.f / 1024.f) + EPS); }
#pragma unroll
        for (int ai = 0; ai < 2; ++ai)
#pragma unroll
            for (int m = 0; m < 4; ++m) {
                const int row = u.pm * 256 + ai * 128 + wr * 64 + m * 16 + fr;
                const bool isctx = row >= ML; const int rc = row - ML;
                const int b = isctx ? (rc >> 8) : (row >> 13);
                const int tok = row & 8191;
                const int kpos = isctx ? (rc & 255) : 256 + tok;
                const size_t kvrow = (size_t)b * KVLEN + kpos;
                const float rs = rsv[ai * 4 + m];
                float ss = 0.f;
#pragma unroll
                for (int bj = 0; bj < 2; ++bj) {
                    const int col = u.pn * 256 + bj * 128 + wc * 32 + 8 * fq;
                    float v[8];
#pragma unroll
                    for (int j = 0; j < 4; ++j) { v[j] = acc[ai][bj][m][0][j] * rs; v[4 + j] = acc[ai][bj][m][1][j] * rs; }
                    {
#pragma unroll
                      for (int j = 0; j < 4; ++j) { v[j] += nbv[bj][0][j]; v[4 + j] += nbv[bj][1][j]; } }
                    if (col < 384) {
#pragma unroll
                        for (int j = 0; j < 8; ++j) ss += v[j] * v[j];
                        *(u32x4*)(lat + (size_t)row * 512 + col) = pack8(v);
                    } else if (col < 416) {
                        if (!isctx) rope8(v, rope + ((size_t)tok * 16 + ((col - 384) >> 1)) * 2);
                        *(u32x4*)(KPE + kvrow * 32 + (col - 384)) = pack8(v);
                    }
                }
                ss += shfl_xor_l(ss, 16, lane_e); ss += shfl_xor_l(ss, 32, lane_e);
                if (fq == 0 && (u.pn == 0 || wc < 4)) unsafeAtomicAdd((u.pn == 0 ? ssq_q : ssq_kv) + row, ss);
            }
    }
};

typedef _Float16 h16x4 __attribute__((ext_vector_type(4)));
__device__ __forceinline__ f32x4 ld_h4(const _Float16* p) { const h16x4 h = *(const h16x4*)p; return (f32x4){(float)h[0], (float)h[1], (float)h[2], (float)h[3]}; }
__device__ __forceinline__ void st_h4(_Float16* p, const f32x4 v) { h16x4 h; h[0] = (_Float16)v[0]; h[1] = (_Float16)v[1]; h[2] = (_Float16)v[2]; h[3] = (_Float16)v[3]; *(h16x4*)p = h; }
struct EpiResid {
    static constexpr bool PERM = false;
    const float* xin32; const _Float16* xin16; _Float16* xout16; const float* gate;
    bf16_t* xa; const float* gn; const float* scn; float* ssqn;
    __device__ __forceinline__ f32x4 ldx(size_t off) const { return xin32 ? *(const f32x4*)(xin32 + off) : ld_h4(xin16 + off); }
    __device__ __forceinline__ void operator()(AccRef acc, const pg8::Unit& u, int wr, int wc, int fr_, int fq_) const {
        int lane_e = lane_id(); asm volatile("" : "+v"(lane_e)); const int fr = lane_e & 15, fq = lane_e >> 4; (void)fr_; (void)fq_;
        const int bsel = u.pm >> 5;
        const int col0 = u.pn * 256 + wc * 32 + 4 * fq;
        const int row0 = u.pm * 256 + wr * 64 + fr;
        f32x4 gv[4], av[4];
#pragma unroll
        for (int c = 0; c < 4; ++c) { const int col = col0 + 128 * (c >> 1) + 16 * (c & 1);
            gv[c] = *(const f32x4*)(gate + bsel * 6144 + col);
            if (xa) { const f32x4 g4 = *(const f32x4*)(gn + col), s4 = *(const f32x4*)(scn + bsel * 6144 + col); av[c] = g4 * (s4 + 1.f); } else av[c] = (f32x4){0.f, 0.f, 0.f, 0.f}; }
        f32x4 xc[4], xn[4]; float ssr[8];
        { const size_t xo_ = (size_t)row0 * DM + col0;
#pragma unroll
          for (int c = 0; c < 4; ++c) xc[c] = ldx(xo_ + 128 * (c >> 1) + 16 * (c & 1)); }
#pragma unroll
        for (int r = 0; r < 8; ++r) {
            const int ai = r >> 2, m = r & 3; const int row = row0 + 128 * ai + 16 * m;
            if (r < 7) { const int rown = row0 + 128 * ((r + 1) >> 2) + 16 * ((r + 1) & 3); const size_t xo_ = (size_t)rown * DM + col0;
#pragma unroll
                for (int c = 0; c < 4; ++c) xn[c] = ldx(xo_ + 128 * (c >> 1) + 16 * (c & 1)); }
            _Float16* xo = xout16 + (size_t)row * DM + col0; float ss = 0.f;
#pragma unroll
            for (int c = 0; c < 4; ++c) {
                const f32x4 y = xc[c] + gv[c] * acc[ai][c >> 1][m][c & 1];
                st_h4(xo + 128 * (c >> 1) + 16 * (c & 1), y);
                if (xa) { const f32x4 z = y * av[c]; ss += (y[0] * y[0] + y[1] * y[1]) + (y[2] * y[2] + y[3] * y[3]);
                    u32x2 o; o.x = cvtpk(z[0], z[1]); o.y = cvtpk(z[2], z[3]); *(u32x2*)(xa + (size_t)row * DM + col0 + 128 * (c >> 1) + 16 * (c & 1)) = o; }
            }
            ssr[r] = ss;
#pragma unroll
            for (int c = 0; c < 4; ++c) xc[c] = xn[c];
        }
        if (xa) {
#pragma unroll
            for (int r = 0; r < 8; ++r) { float ss = ssr[r]; ss += shfl_xor_l(ss, 16, lane_e); ss += shfl_xor_l(ss, 32, lane_e); ssr[r] = ss; }
            if (fq == 0) {
#pragma unroll
                for (int r = 0; r < 8; ++r) unsafeAtomicAdd(ssqn + row0 + 128 * (r >> 2) + 16 * (r & 3), ssr[r]);
            }
        }
    }
};

struct EpiCtxPartial {
    static constexpr bool PERM = false;
    float* part; int kchunk;
    __device__ __forceinline__ void operator()(AccRef acc, const pg8::Unit& u, int wr, int wc, int fr_, int fq_) const {
        int lane_e = lane_id(); asm volatile("" : "+v"(lane_e)); const int fr = lane_e & 15, fq = lane_e >> 4; (void)fr_; (void)fq_;
        float* pb = part + (size_t)(u.koff / kchunk) * MC * DM;
#pragma unroll
        for (int ai = 0; ai < 2; ++ai)
#pragma unroll
            for (int m = 0; m < 4; ++m) {
                const int row = u.pm * 256 + ai * 128 + wr * 64 + m * 16 + fr - ML;
                float* xr = pb + (size_t)row * DM;
#pragma unroll
                for (int bj = 0; bj < 2; ++bj)
#pragma unroll
                    for (int n = 0; n < 2; ++n) {
                        const int col = u.pn * 256 + bj * 128 + wc * 32 + 16 * n + 4 * fq;
                        *(f32x4*)(xr + col) = acc[ai][bj][m][n];
                    }
            }
    }
};

struct EpiSqRelu {
    static constexpr bool PERM = true;
    bf16_t* O; int ldc; const float* ssqn; const float* nbias;
    __device__ __forceinline__ void operator()(AccRef acc, const pg8::Unit& u, int wr, int wc, int fr_, int fq_) const {
        int lane_e = lane_id(); asm volatile("" : "+v"(lane_e)); const int fr = lane_e & 15, fq = lane_e >> 4; (void)fr_; (void)fq_;
        const int row0 = u.pm * 256 + wr * 64 + fr, col0 = u.pn * 256 + wc * 32 + 8 * fq;
        const float* nb = nbias + (u.pm >= 256 ? 8 : (u.pm >> 5)) * 4096 + col0;
        f32x4 bv[2][2]; float rs[8];
#pragma unroll
        for (int bj = 0; bj < 2; ++bj) { bv[bj][0] = *(const f32x4*)(nb + bj * 128); bv[bj][1] = *(const f32x4*)(nb + bj * 128 + 4); }
#pragma unroll
        for (int r = 0; r < 8; ++r) rs[r] = ssqn[row0 + 128 * (r >> 2) + 16 * (r & 3)];
#pragma unroll
        for (int r = 0; r < 8; ++r) rs[r] = rsqrtf(rs[r] * (1.f / 1024.f) + EPS);
#pragma unroll
        for (int r = 0; r < 8; ++r) {
            const int ai = r >> 2, m = r & 3; const int row = row0 + 128 * ai + 16 * m;
#pragma unroll
            for (int bj = 0; bj < 2; ++bj) {
                float v[8];
#pragma unroll
                for (int j = 0; j < 4; ++j) { float a = fmaxf(acc[ai][bj][m][0][j] * rs[r] + bv[bj][0][j], 0.f), c = fmaxf(acc[ai][bj][m][1][j] * rs[r] + bv[bj][1][j], 0.f); v[j] = a * a; v[4 + j] = c * c; }
                *(u32x4*)(O + (size_t)row * ldc + col0 + bj * 128) = pack8(v);
            }
        }
    }
};

constexpr int KP = 208, VP = 144;
constexpr int KT_BYTES = 64 * KP, VT_BYTES = 64 * VP, ABUF = KT_BYTES + VT_BYTES;
constexpr int ATT_OSTAGE_OFF = 73728;
constexpr int ATT_BIAS_OFF = 2 * ABUF;
struct AttnP { const bf16_t* Q; const bf16_t* K; const bf16_t* KPE; const bf16_t* VT; bf16_t* O; const float* sink; const float* bias; int nunits; };

__device__ __forceinline__ float rowmax32(const f32x16& a, const f32x16& b) {
    float x = __builtin_fmaxf(__builtin_fmaxf(a[0], a[1]), b[0]), y = __builtin_fmaxf(__builtin_fmaxf(a[2], a[3]), b[1]); x = __builtin_fmaxf(__builtin_fmaxf(x, b[2]), b[3]);
#pragma unroll
    for (int r = 4; r < 16; r += 4) { x = __builtin_fmaxf(__builtin_fmaxf(x, a[r]), a[r + 1]); y = __builtin_fmaxf(__builtin_fmaxf(y, a[r + 2]), a[r + 3]); x = __builtin_fmaxf(__builtin_fmaxf(x, b[r]), b[r + 1]); y = __builtin_fmaxf(__builtin_fmaxf(y, b[r + 2]), b[r + 3]); }
    const float m = __builtin_fmaxf(x, y);
    auto rr = __builtin_amdgcn_permlane32_swap(__float_as_uint(m), __float_as_uint(m), false, false);
    return __builtin_fmaxf(__uint_as_float(rr[0]), __uint_as_float(rr[1]));
}

template <int VAR>
__device__ __forceinline__ void attn_phase(LAS unsigned char* lds, const AttnP P, int vcu, int G, int wave_s) {
    constexpr int ND0 = (VAR == 0) ? 6 : 4;
    constexpr int QPITCH = (VAR == 0) ? 1536 : 1024, QH = (VAR == 0) ? 96 : 64;
    constexpr int KPITCH = (VAR == 1) ? 256 : 1024, VCOLS = (VAR == 1) ? 256 : 1024;
    constexpr bool USE_NEGM = (VAR != 2);
    constexpr float THR = 8.f;
    int tid_l = wave_s * 64 + lane_id(); asm volatile("" : "+v"(tid_l));
    const int tid = tid_l, lane = tid & 63, r32 = lane & 31, hi = lane >> 5;
    const int w = __builtin_amdgcn_readfirstlane(tid >> 6);
    LAS float* bias_lds = (LAS float*)(lds + ATT_BIAS_OFF);
    for (int it = 0;; ++it) {
        int u;
        if (VAR == 0 && G == 256) { u = (it < 16) ? ((it * 8 + (vcu >> 5)) * 32 + (vcu & 31)) : (4096 + (it - 16) * 256 + vcu); }
        else u = it * G + vcu;
        if (u >= P.nunits) break;
        const bool isctx = u >= 4096;
        int b, hq, hk, qrow, nt; int p_a = 0, p_b = 0;
        if (VAR == 0) {
            if (!isctx) { const int bh = u >> 5, qb = u & 31; b = bh >> 4; hq = bh & 15; qrow = b * SEQ + qb * 256 + 32 * w; nt = 132; }
            else { const int cu = u - 4096; b = cu >> 4; hq = cu & 15; qrow = ML + b * 256 + 32 * w; nt = 4; }
            hk = hq;
        } else if (VAR == 1) {
            if (!isctx) { const int blk = u & 63, hp = (u >> 6) & 7; b = u >> 9; hq = 2 * hp + (w >> 2); hk = hp >> 1; qrow = b * SEQ + blk * 128 + 32 * (w & 3);
                          const int jlo = blk == 0 ? 2 : 0, jhi = blk == 63 ? 4 : 6; nt = 4 + jhi - jlo; p_a = blk * 128 - 128 + 64 * jlo; p_b = blk * 128 + 32 * (w & 3); }
            else { const int cu = u - 4096, half = cu & 1, hp = (cu >> 1) & 7; b = cu >> 4; hq = 2 * hp + (w >> 2); hk = hp >> 1; qrow = ML + b * 256 + half * 128 + 32 * (w & 3); nt = 4; }
        } else {
            if (!isctx) { const int rq = u & 31; hq = (u >> 5) & 15; b = u >> 9; const int r0 = 4 * rq; qrow = b * SEQ + (r0 + (w >> 1)) * 64 + 32 * (w & 1);
                          int lo = r0 - 4; lo = lo < 0 ? 0 : (lo > 120 ? 120 : lo); int h2 = r0 - 1; h2 = h2 < 0 ? 0 : (h2 > 120 ? 120 : h2); nt = 4 + (h2 + 8 - lo); p_a = lo; p_b = r0 + (w >> 1); }
            else { const int cu = u - 4096; b = cu >> 4; hq = cu & 15; qrow = ML + b * 256 + 32 * w; nt = 4; }
            hk = hq;
        }
        if (VAR == 2 && !isctx) { if (tid < 465) bias_lds[tid] = P.bias[hq * 465 + tid] * LOG2E; }
        bf16x8 qf[ND0];
        { const bf16_t* qp = P.Q + (size_t)(qrow + r32) * QPITCH + hq * QH + hi * 8;
#pragma unroll
          for (int d0 = 0; d0 < ND0; ++d0) qf[d0] = *(const bf16x8*)(qp + d0 * 16); }
        f32x16 o0 = {}, o1 = {};
        const unsigned koff = (unsigned)(((b * KVLEN + (tid >> 3)) * KPITCH + hk * 64 + (tid & 7) * 8) * 2);
        const unsigned peoff = (unsigned)(((b * KVLEN + (tid >> 2)) * 32 + (tid & 3) * 8) * 2);
        const unsigned voff = (unsigned)(((b * VCOLS + hk * 64 + (tid >> 3)) * KVLEN + (tid & 7) * 8) * 2);
        u32x4 kreg, pereg = {}, vreg;
#define TILE_KPOS(t) (VAR == 0 ? 64 * (((t) + rot >= nt) ? (t) + rot - nt : (t) + rot) : ((t) < 4 ? 64 * (t) : (VAR == 1 ? 256 + p_a + 64 * ((t) - 4) : 256 + 64 * (p_a + (t) - 4))))
#define LOADK(t) do { const int kp_ = TILE_KPOS(t); kreg = *(const u32x4*)((const char*)P.K + (size_t)(koff + (unsigned)(kp_ * KPITCH * 2))); if (VAR == 0 && tid < 256) pereg = *(const u32x4*)((const char*)P.KPE + (size_t)(peoff + (unsigned)(kp_ * 64))); } while (0)
#define LOADV(t) do { const int kp_ = TILE_KPOS(t); vreg = *(const u32x4*)((const char*)P.VT + (size_t)(voff + (unsigned)(kp_ * 2))); } while (0)
#define STOREK(buf) do { LAS unsigned char* kb_ = lds + (buf) * ABUF; *(LAS u32x4*)(kb_ + (tid >> 3) * KP + (tid & 7) * 16) = kreg; \
        if (VAR == 0 && tid < 256) *(LAS u32x4*)(kb_ + (tid >> 2) * KP + 128 + (tid & 3) * 16) = pereg; } while (0)
#define STOREV(buf) do { *(LAS u32x4*)(lds + (buf) * ABUF + KT_BYTES + (tid >> 3) * VP + (tid & 7) * 16) = vreg; } while (0)
#define NEED(t) (((t) < 4) ? true : (VAR == 1 ? ((p_a + 64 * ((t) - 4) + 63 >= p_b - 128) && (p_a + 64 * ((t) - 4) <= p_b + 31 + 128)) : (VAR == 2 ? ((p_a + (t) - 4 >= na_rs) && (p_a + (t) - 4 < na_rs + 8)) : true)))
#define QK_TILE(P0, P1, buf, CINIT) do { const LAS unsigned char* kt_ = lds + (buf) * ABUF; P0 = (CINIT); P1 = (CINIT); \
        _Pragma("unroll") for (int d0 = 0; d0 < ND0; ++d0) { \
            const bf16x8 k0_ = *(const LAS bf16x8*)(kt_ + r32 * KP + d0 * 32 + hi * 16); const bf16x8 k1_ = *(const LAS bf16x8*)(kt_ + (32 + r32) * KP + d0 * 32 + hi * 16); \
            P0 = __builtin_amdgcn_mfma_f32_32x32x16_bf16(k0_, qf[d0], P0, 0, 0, 0); P1 = __builtin_amdgcn_mfma_f32_32x32x16_bf16(k1_, qf[d0], P1, 0, 0, 0); } } while (0)
#define MASK_TILE(P0, P1, t) do { \
        if (VAR == 1 && (t) >= 4) { const int d0_ = p_a + 64 * ((t) - 4) - (p_b + r32) + 4 * hi + 128; \
            _Pragma("unroll") for (int r = 0; r < 16; ++r) { const int dd = d0_ + (r & 3) + 8 * (r >> 2); if ((unsigned)dd > 256u) P0[r] = -1e30f; if ((unsigned)(dd + 32) > 256u) P1[r] = -1e30f; } } \
        if (VAR == 2 && (t) >= 4) { int c = (qrow & 63) + r32; asm volatile("" : "+v"(c)); const int kr = p_a + (t) - 4; int cs = c - 8; cs = cs < 0 ? 0 : (cs > 48 ? 48 : cs); const LAS float* brow = bias_lds + (kr - p_b + 7) * 31; \
            _Pragma("unroll") for (int r = 0; r < 16; ++r) { const int kc = 4 * hi + (r & 3) + 8 * (r >> 2); \
                { int bi = kc - c + 15; bi = bi < 0 ? 0 : (bi > 30 ? 30 : bi); P0[r] = ((unsigned)(kc - cs) < 16u) ? P0[r] + brow[bi] : -1e30f; } \
                { int bi = kc + 32 - c + 15; bi = bi < 0 ? 0 : (bi > 30 ? 30 : bi); P1[r] = ((unsigned)(kc + 32 - cs) < 16u) ? P1[r] + brow[bi] : -1e30f; } } } } while (0)
        const int rot = (VAR == 0 && !isctx) ? ((vcu & 31) * 4 + (vcu >> 5)) % 132 : 0;
        int na_rs = 0; if (VAR == 2) { na_rs = p_b - 4; na_rs = na_rs < 0 ? 0 : (na_rs > 120 ? 120 : na_rs); }
        LOADK(0); LOADV(0); STOREK(0); STOREV(0);
        if (nt > 1) { LOADK(1); STOREK(1); }
        __syncthreads();
        f32x16 pc0, pc1; const f32x16 zero16 = {};
        QK_TILE(pc0, pc1, 0, zero16);
        float mref = rowmax32(pc0, pc1), lrun = 0.f;
        if (VAR == 1) { const float sk = P.sink[hq] * LOG2E; mref = __builtin_fmaxf(mref, sk); lrun = (hi == 0) ? __builtin_amdgcn_exp2f(sk - mref) : 0.f; }
        f32x16 negm = {};
        if (USE_NEGM) {
#pragma unroll
            for (int r = 0; r < 16; ++r) { pc0[r] -= mref; pc1[r] -= mref; negm[r] = -mref; }
        }
        float rmc = 0.f;
        bool need_c = true;
        __syncthreads();
        for (int t = 0; t < nt; ++t) {
            const bool hn = (t + 1 < nt);
            if (hn) { const int t2 = (t + 2 < nt) ? t + 2 : nt - 1; LOADK(t2); LOADV(t + 1); }
            const bool need_n = hn && NEED(t + 1);
            if (need_c && __any(rmc > THR)) {
                const float dl = __builtin_fmaxf(rmc, 0.f), f = __builtin_amdgcn_exp2f(-dl);
                mref += dl; lrun *= f;
#pragma unroll
                for (int r = 0; r < 16; ++r) { if (USE_NEGM) { pc0[r] -= dl; pc1[r] -= dl; negm[r] = -mref; } o0[r] *= f; o1[r] *= f; }
            }
            f32x16 pn0 = {}, pn1 = {};
            float rmn = -1e30f;
            if (VAR != 2 && need_c && need_n) {
                const LAS unsigned char* kt_ = lds + ((t + 1) & 1) * ABUF; const LAS unsigned char* vt_ = lds + (t & 1) * ABUF + KT_BYTES;
                bf16x8 kf[2 * ND0], vf[8]; u32x4 w0, w1, w2, w3; float sacc = 0.f;
#define KRD(d0) do { kf[2 * (d0)] = *(const LAS bf16x8*)(kt_ + r32 * KP + (d0) * 32 + hi * 16); kf[2 * (d0) + 1] = *(const LAS bf16x8*)(kt_ + (32 + r32) * KP + (d0) * 32 + hi * 16); } while (0)
#define VRD(kk) do { vf[2 * (kk)] = *(const LAS bf16x8*)(vt_ + r32 * VP + (kk) * 32 + hi * 16); vf[2 * (kk) + 1] = *(const LAS bf16x8*)(vt_ + (32 + r32) * VP + (kk) * 32 + hi * 16); } while (0)
#define EX4(Pv, a, W, lo) do { if (!USE_NEGM) { Pv[a] -= mref; Pv[a + 1] -= mref; Pv[a + 2] -= mref; Pv[a + 3] -= mref; } Pv[a] = __builtin_amdgcn_exp2f(Pv[a]); Pv[a + 1] = __builtin_amdgcn_exp2f(Pv[a + 1]); Pv[a + 2] = __builtin_amdgcn_exp2f(Pv[a + 2]); Pv[a + 3] = __builtin_amdgcn_exp2f(Pv[a + 3]); \
        sacc += Pv[a]; sacc += Pv[a + 1]; sacc += Pv[a + 2]; sacc += Pv[a + 3]; if (lo) { W.x = cvtpk(Pv[a], Pv[a + 1]); W.y = cvtpk(Pv[a + 2], Pv[a + 3]); } else { W.z = cvtpk(Pv[a], Pv[a + 1]); W.w = cvtpk(Pv[a + 2], Pv[a + 3]); } } while (0)
#define SB() __builtin_amdgcn_sched_barrier(0)
#define QKP(d0, C0, C1) do { pn0 = __builtin_amdgcn_mfma_f32_32x32x16_bf16(kf[2 * (d0)], qf[d0], C0, 0, 0, 0); pn1 = __builtin_amdgcn_mfma_f32_32x32x16_bf16(kf[2 * (d0) + 1], qf[d0], C1, 0, 0, 0); } while (0)
#define PVP(kk, W) do { const bf16x8 pb_ = __builtin_bit_cast(bf16x8, W); o0 = __builtin_amdgcn_mfma_f32_32x32x16_bf16(vf[2 * (kk)], pb_, o0, 0, 0, 0); o1 = __builtin_amdgcn_mfma_f32_32x32x16_bf16(vf[2 * (kk) + 1], pb_, o1, 0, 0, 0); } while (0)
#define KR1(j) (kf[j] = *(const LAS bf16x8*)(kt_ + (32 * ((j) & 1) + r32) * KP + ((j) >> 1) * 32 + hi * 16))
#define VR1(i) (vf[i] = *(const LAS bf16x8*)(vt_ + (32 * ((i) & 1) + r32) * VP + ((i) >> 1) * 32 + hi * 16))
#define EX2(Pv, a, Wd) do { Pv[a] = __builtin_amdgcn_exp2f(Pv[a]); Pv[a + 1] = __builtin_amdgcn_exp2f(Pv[a + 1]); sacc += Pv[a]; sacc += Pv[a + 1]; Wd = cvtpk(Pv[a], Pv[a + 1]); } while (0)
#define QK1(j, C) do { if ((j) & 1) pn1 = __builtin_amdgcn_mfma_f32_32x32x16_bf16(kf[j], qf[(j) >> 1], C, 0, 0, 0); else pn0 = __builtin_amdgcn_mfma_f32_32x32x16_bf16(kf[j], qf[(j) >> 1], C, 0, 0, 0); } while (0)
#define PV1(i, W) do { const bf16x8 pb_ = __builtin_bit_cast(bf16x8, W); if ((i) & 1) o1 = __builtin_amdgcn_mfma_f32_32x32x16_bf16(vf[i], pb_, o1, 0, 0, 0); else o0 = __builtin_amdgcn_mfma_f32_32x32x16_bf16(vf[i], pb_, o0, 0, 0, 0); } while (0)
                if (ND0 == 6) {
                    KR1(0); KR1(1); KR1(2); KR1(3); SB();
                    QK1(0, negm); EX2(pc0, 0, w0.x); KR1(4); SB();
                    QK1(1, negm); EX2(pc0, 2, w0.y); KR1(5); SB();
                    QK1(2, pn0); EX2(pc0, 4, w0.z); KR1(6); SB();
                    QK1(3, pn1); EX2(pc0, 6, w0.w); KR1(7); SB();
                    QK1(4, pn0); EX2(pc0, 8, w1.x); KR1(8); SB();
                    QK1(5, pn1); EX2(pc0, 10, w1.y); KR1(9); SB();
                    QK1(6, pn0); EX2(pc0, 12, w1.z); KR1(10); SB();
                    QK1(7, pn1); EX2(pc0, 14, w1.w); KR1(11); SB();
                    QK1(8, pn0); EX2(pc1, 0, w2.x); VR1(0); SB();
                    QK1(9, pn1); EX2(pc1, 2, w2.y); VR1(1); SB();
                    QK1(10, pn0); EX2(pc1, 4, w2.z); VR1(2); SB();
                    QK1(11, pn1); EX2(pc1, 6, w2.w); VR1(3); SB();
                } else {
                    KR1(0); KR1(1); KR1(2); KR1(3); SB();
                    QK1(0, negm); EX2(pc0, 0, w0.x); EX2(pc0, 2, w0.y); KR1(4); SB();
                    QK1(1, negm); EX2(pc0, 4, w0.z); EX2(pc0, 6, w0.w); KR1(5); SB();
                    QK1(2, pn0); EX2(pc0, 8, w1.x); EX2(pc0, 10, w1.y); KR1(6); SB();
                    QK1(3, pn1); EX2(pc0, 12, w1.z); EX2(pc0, 14, w1.w); KR1(7); SB();
                    QK1(4, pn0); EX2(pc1, 0, w2.x); VR1(0); SB();
                    QK1(5, pn1); EX2(pc1, 2, w2.y); VR1(1); SB();
                    QK1(6, pn0); EX2(pc1, 4, w2.z); VR1(2); SB();
                    QK1(7, pn1); EX2(pc1, 6, w2.w); VR1(3); SB();
                }
                PV1(0, w0); EX2(pc1, 8, w3.x); VR1(4); SB();
                PV1(1, w0); EX2(pc1, 10, w3.y); VR1(5); SB();
                PV1(2, w1); EX2(pc1, 12, w3.z); VR1(6); SB();
                PV1(3, w1); EX2(pc1, 14, w3.w); VR1(7); SB();
                lrun += sacc;
                PV1(4, w2); MASK_TILE(pn0, pn1, t + 1); SB();
                PV1(5, w2); SB();
                PV1(6, w3); SB();
                PV1(7, w3); rmn = rowmax32(pn0, pn1); if (!USE_NEGM) rmn -= mref; SB();
#undef KR1
#undef VR1
#undef EX2
#undef QK1
#undef PV1
#undef KRD
#undef VRD
#undef EX4
#undef SB
#undef QKP
#undef PVP
            } else {
            if (need_n) QK_TILE(pn0, pn1, (t + 1) & 1, negm);
            if (need_c) {
                float sum = 0.f;
#pragma unroll
                for (int r = 0; r < 16; ++r) { if (!USE_NEGM) { pc0[r] -= mref; pc1[r] -= mref; } pc0[r] = __builtin_amdgcn_exp2f(pc0[r]); pc1[r] = __builtin_amdgcn_exp2f(pc1[r]); sum += pc0[r]; sum += pc1[r]; }
                lrun += sum;
                bf16x8 pk[4];
                { u32x4 a; a.x = cvtpk(pc0[0], pc0[1]); a.y = cvtpk(pc0[2], pc0[3]); a.z = cvtpk(pc0[4], pc0[5]); a.w = cvtpk(pc0[6], pc0[7]); pk[0] = __builtin_bit_cast(bf16x8, a); }
                { u32x4 a; a.x = cvtpk(pc0[8], pc0[9]); a.y = cvtpk(pc0[10], pc0[11]); a.z = cvtpk(pc0[12], pc0[13]); a.w = cvtpk(pc0[14], pc0[15]); pk[1] = __builtin_bit_cast(bf16x8, a); }
                { u32x4 a; a.x = cvtpk(pc1[0], pc1[1]); a.y = cvtpk(pc1[2], pc1[3]); a.z = cvtpk(pc1[4], pc1[5]); a.w = cvtpk(pc1[6], pc1[7]); pk[2] = __builtin_bit_cast(bf16x8, a); }
                { u32x4 a; a.x = cvtpk(pc1[8], pc1[9]); a.y = cvtpk(pc1[10], pc1[11]); a.z = cvtpk(pc1[12], pc1[13]); a.w = cvtpk(pc1[14], pc1[15]); pk[3] = __builtin_bit_cast(bf16x8, a); }
                const LAS unsigned char* vt = lds + (t & 1) * ABUF + KT_BYTES;
#pragma unroll
                for (int kk = 0; kk < 4; ++kk) {
                    const bf16x8 v0 = *(const LAS bf16x8*)(vt + r32 * VP + kk * 32 + hi * 16);
                    const bf16x8 v1 = *(const LAS bf16x8*)(vt + (32 + r32) * VP + kk * 32 + hi * 16);
                    o0 = __builtin_amdgcn_mfma_f32_32x32x16_bf16(v0, pk[kk], o0, 0, 0, 0);
                    o1 = __builtin_amdgcn_mfma_f32_32x32x16_bf16(v1, pk[kk], o1, 0, 0, 0);
                }
            }
            if (need_n) { MASK_TILE(pn0, pn1, t + 1); rmn = rowmax32(pn0, pn1); if (!USE_NEGM) rmn -= mref; }
            }
            if (hn) { STOREK(t & 1); STOREV((t + 1) & 1); }
            __syncthreads();
            pc0 = pn0; pc1 = pn1; rmc = rmn; need_c = need_n;
        }
#undef TILE_KPOS
#undef LOADK
#undef LOADV
#undef STOREK
#undef STOREV
#undef NEED
#undef QK_TILE
#undef MASK_TILE
        const float lt = lrun + shfl_xor_l(lrun, 32, lane), inv = 1.f / lt;
        LAS unsigned char* stg = lds + ATT_OSTAGE_OFF + w * (32 * 144);
#pragma unroll
        for (int g = 0; g < 4; ++g) {
            u32x2 a; a.x = cvtpk(o0[4 * g] * inv, o0[4 * g + 1] * inv); a.y = cvtpk(o0[4 * g + 2] * inv, o0[4 * g + 3] * inv); *(LAS u32x2*)(stg + r32 * 144 + (8 * g + 4 * hi) * 2) = a;
            u32x2 c; c.x = cvtpk(o1[4 * g] * inv, o1[4 * g + 1] * inv); c.y = cvtpk(o1[4 * g + 2] * inv, o1[4 * g + 3] * inv); *(LAS u32x2*)(stg + r32 * 144 + (32 + 8 * g + 4 * hi) * 2) = c;
        }
        asm volatile("s_waitcnt lgkmcnt(0)" ::: "memory");
        { bf16_t* ob = P.O + (size_t)(qrow + (lane >> 3)) * DM + hq * 64 + (lane & 7) * 8;
#pragma unroll
          for (int i = 0; i < 4; ++i) { const u32x4 v = *(const LAS u32x4*)(stg + (i * 8 + (lane >> 3)) * 144 + (lane & 7) * 16); *(u32x4*)(ob + (size_t)i * 8 * DM) = v; } }
    }
}

constexpr size_t MiB = 1u << 20;
constexpr size_t WS_BAR = 983040  ;
constexpr size_t WS_MOD = 0, WS_SSQ = 1 * MiB, WS_ROPE16 = 3 * MiB, WS_ROPE32 = 4 * MiB, WS_KPE = 6 * MiB, WS_XC = 12 * MiB;
constexpr size_t WS_W1T = 20 * MiB, WS_W2T = 52 * MiB, WS_MLA = 84 * MiB  , WS_SWA = 94 * MiB  , WS_NA = 99 * MiB  ;
constexpr size_t WS_H = 108 * MiB, WS_Q = 240 * MiB, WS_K = 438 * MiB, WS_VT = 570 * MiB, WS_O = 702 * MiB, WS_LAT = 702 * MiB, WS_HID = 240 * MiB, WS_NBIAS = 834 * MiB  , WS_SSQN = 836 * MiB  , WS_PART_O = 240 * MiB  , WS_PART_M = 768 * MiB  ,
    WS_XH = 840 * MiB  , WS_END = 968 * MiB;

#define XB_TMO      128
#define XB_XCNT(j)  (256  + 64 * (j))
#define XB_XSUB(j)  (1280 + 64 * (j))
#define XB_XGEN(j)  (2304 + 64 * (j))
#define XB_TOP      3328
#define XB_TOPGEN   3392
#define XCD_BAR_WORDS 3456
#define XB_SPIN_CAP (1u << 18)
__device__ __forceinline__ unsigned xb_ld(unsigned* p)              { return __hip_atomic_load(p, __ATOMIC_RELAXED, __HIP_MEMORY_SCOPE_AGENT); }
__device__ __forceinline__ unsigned xb_add(unsigned* p, unsigned v) { return __hip_atomic_fetch_add(p, v, __ATOMIC_RELAXED, __HIP_MEMORY_SCOPE_AGENT); }
__device__ __forceinline__ unsigned xb_xcc_id() { return (unsigned)__builtin_amdgcn_s_getreg((3 << 11) | 20) & 0xFu; }
#define XB_SPIN(cond, bar) do { unsigned _sp = 0; while (cond) { __builtin_amdgcn_s_sleep(1); \
    if ((++_sp & 255u) == 0u) { if (xb_ld(&(bar)[XB_TMO])) break; if (_sp > XB_SPIN_CAP) { atomicAdd(&(bar)[XB_TMO], 1u); break; } } } } while (0)
struct XcdBarrier { unsigned* bar; unsigned x; volatile LAS unsigned* st; };
__device__ __forceinline__ XcdBarrier xcd_barrier_post(unsigned* bar, volatile LAS unsigned* st, bool t0) {
    XcdBarrier b; b.bar = bar; b.x = xb_xcc_id(); b.st = st;
    if (t0) (void)xb_add(&bar[XB_XCNT(b.x)], 1u);
    return b;
}
__device__ __forceinline__ void xcd_barrier_complete(unsigned* bar, unsigned x, unsigned& nloc, unsigned& nx) {
    const unsigned G = gridDim.x * gridDim.y * gridDim.z;
    unsigned sum, cnt, mine, sp = 0u;
    for (;;) {
        sum = 0u; cnt = 0u; mine = 0u;
#pragma unroll
        for (unsigned j = 0; j < 16; ++j) { const unsigned c = xb_ld(&bar[XB_XCNT(j)]); sum += c; cnt += (c > 0u) ? 1u : 0u; mine = (j == x) ? c : mine; }
        if (sum == G) break;
        __builtin_amdgcn_s_sleep(1);
        if ((++sp & 255u) == 0u) { if (xb_ld(&bar[XB_TMO])) break; if (sp > XB_SPIN_CAP) { atomicAdd(&bar[XB_TMO], 1u); break; } }
    }
    nloc = mine > 0u ? mine : 1u; nx = cnt > 0u ? cnt : 1u;
}
__device__ __forceinline__ void xcd_barrier(const XcdBarrier& b, bool t0) {
    asm volatile("s_waitcnt vmcnt(0)" ::: "memory");
    __syncthreads();
    if (t0) {
        unsigned* bar = b.bar; unsigned bx = b.x; asm volatile("" : "+s"(bar), "+s"(bx));
        __builtin_amdgcn_s_waitcnt(0);
        unsigned nloc = b.st[0], nx = b.st[1];
        if (nloc == 0u) { xcd_barrier_complete(bar, bx, nloc, nx); b.st[0] = nloc; b.st[1] = nx; }
        const unsigned old = xb_add(&bar[XB_XSUB(bx)], 1u);
        const unsigned gen = old / nloc;
        if (old + 1u == (gen + 1u) * nloc) {
            __builtin_amdgcn_fence(__ATOMIC_RELEASE, "agent");
            asm volatile("s_waitcnt vmcnt(0)" ::: "memory");
            const unsigned og = xb_add(&bar[XB_TOP], 1u);
            const unsigned tg = og / nx;
            if (og + 1u == (tg + 1u) * nx) xb_add(&bar[XB_TOPGEN], 1u);
            else XB_SPIN(xb_ld(&bar[XB_TOPGEN]) == tg, bar);
            __builtin_amdgcn_fence(__ATOMIC_ACQUIRE, "agent");
            xb_add(&bar[XB_XGEN(bx)], 1u);
            asm volatile("s_waitcnt vmcnt(0)" ::: "memory");
        } else {
            XB_SPIN(xb_ld(&bar[XB_XGEN(bx)]) == gen, bar);
            __builtin_amdgcn_fence(__ATOMIC_ACQUIRE, "agent");
            asm volatile("s_waitcnt vmcnt(0)" ::: "memory");
        }
    }
    __syncthreads();
}

__device__ __forceinline__ float wave_sum(float v, int lane) {
#pragma unroll
    for (int o = 1; o < 64; o <<= 1) v += shfl_xor_l(v, o, lane);
    return v;
}
__device__ __forceinline__ void sincos_red(float x, float& sn, float& cs) {
    const float n = rintf(x * 0.15915494309189535f);
    float r = fmaf(-n, 6.2831854820251465f, x); r = fmaf(-n, -1.7484555e-7f, r);
    const float rev = r * 0.15915494309189535f;
    sn = __builtin_amdgcn_sinf(rev); cs = __builtin_amdgcn_cosf(rev);
}
__device__ __forceinline__ void transpose_item(const float* W, int K, int N, bf16_t* WT, const float* g, LAS float* scr, int item, int lane) {
    const int nblk = N / 32, kb = item / nblk, nb = item % nblk, k0 = 64 * kb, n0 = 32 * nb;
#pragma unroll 8
    for (int i = 0; i < 32; ++i) { const int kk = 2 * i + (lane >> 5); float v = W[(size_t)(k0 + kk) * N + n0 + (lane & 31)]; if (g) v *= g[k0 + kk]; scr[kk * 33 + (lane & 31)] = v; }
    asm volatile("s_waitcnt lgkmcnt(0)" ::: "memory");
    const int c = lane & 7;
#pragma unroll
    for (int j = 0; j < 4; ++j) { const int n = (lane >> 3) + 8 * j; const LAS float* s = scr + (8 * c) * 33 + n;
        u32x4 o; o.x = cvtpk(s[0 * 33], s[1 * 33]); o.y = cvtpk(s[2 * 33], s[3 * 33]); o.z = cvtpk(s[4 * 33], s[5 * 33]); o.w = cvtpk(s[6 * 33], s[7 * 33]);
        *(u32x4*)(WT + (size_t)(n0 + n) * K + k0 + 8 * c) = o; }
    asm volatile("s_waitcnt lgkmcnt(0)" ::: "memory");
}

struct Args { const float* in[23]; float* out; unsigned char* ws; };

__device__ __forceinline__ void norm_pass0(const float* xl, const float* xc, const float* g, const float* mod, int sc_off, bf16_t* H, float* ssq, int gw, int NGW) {
    int lane = lane_id(); asm volatile("" : "+v"(lane));
    for (int row = gw; row < MT; row += NGW) {
        const bool isctx = row >= ML;
        const float* xr = isctx ? xc + (size_t)(row - ML) * DM : xl + (size_t)row * DM;
        const float* mp = mod + (isctx ? 8 : (row >> 13)) * 6144;
        f32x4 v[4]; float ss = 0.f;
#pragma unroll
        for (int j = 0; j < 4; ++j) { v[j] = *(const f32x4*)(xr + 4 * lane + 256 * j); ss += (v[j][0] * v[j][0] + v[j][1] * v[j][1]) + (v[j][2] * v[j][2] + v[j][3] * v[j][3]); }
        ss = wave_sum(ss, lane);
        if (lane == 0) ssq[row] = ss;
#pragma unroll
        for (int j = 0; j < 4; ++j) { const int col = 4 * lane + 256 * j;
            const f32x4 gg = *(const f32x4*)(g + col), sc = *(const f32x4*)(mp + sc_off + col);
            const f32x4 y = v[j] * gg * (sc + 1.f);
            u32x2 o; o.x = cvtpk(y[0], y[1]); o.y = cvtpk(y[2], y[3]); *(u32x2*)(H + (size_t)row * DM + col) = o; }
    }
}
__device__ __forceinline__ void norm_ctx(float* xc, const float* part, const float* gate8, const float* g, const float* sc, bf16_t* Hc, float* ssqc, int gw, int NGW) {
    int lane = lane_id(); asm volatile("" : "+v"(lane));
    for (int row = gw; row < MC; row += NGW) {
        float* xr = xc + (size_t)row * DM;
        f32x4 v[4]; float ss = 0.f;
#pragma unroll
        for (int j = 0; j < 4; ++j) { const int col = 4 * lane + 256 * j;
            f32x4 p = *(const f32x4*)(part + (size_t)row * DM + col);
#pragma unroll
            for (int kc = 1; kc < 8; ++kc) p += *(const f32x4*)(part + ((size_t)kc * MC + row) * DM + col);
            v[j] = *(const f32x4*)(xr + col) + *(const f32x4*)(gate8 + col) * p;
            *(f32x4*)(xr + col) = v[j];
            ss += (v[j][0] * v[j][0] + v[j][1] * v[j][1]) + (v[j][2] * v[j][2] + v[j][3] * v[j][3]); }
        ss = wave_sum(ss, lane);
        if (lane == 0) ssqc[row] = ss;
#pragma unroll
        for (int j = 0; j < 4; ++j) { const int col = 4 * lane + 256 * j;
            const f32x4 gg = *(const f32x4*)(g + col), s4 = *(const f32x4*)(sc + col);
            const f32x4 y = v[j] * gg * (s4 + 1.f);
            u32x2 o; o.x = cvtpk(y[0], y[1]); o.y = cvtpk(y[2], y[3]); *(u32x2*)(Hc + (size_t)row * DM + col) = o; }
    }
}
__device__ __forceinline__ void nbias_item(LAS unsigned char* lds, const float* W, int N, int n0, const float* mod, int sh_off, float* out, int wave, int lane) {
    LAS float* shl = (LAS float*)(lds + 65536); LAS float* red = (LAS float*)(lds + 102400);
    const int tid = wave * 64 + lane;
    for (int i = tid; i < 9 * 1024; i += 512) shl[i] = mod[(i >> 10) * 6144 + sh_off + (i & 1023)];
    __syncthreads();
    const int n = n0 + lane; const bool ok = n < N;
    const float* Wp = W + (ok ? n : 0);
    float s0 = 0, s1 = 0, s2 = 0, s3 = 0, s4 = 0, s5 = 0, s6 = 0, s7 = 0, s8 = 0;
#pragma unroll 8
    for (int k = wave * 128; k < wave * 128 + 128; ++k) { const float wv = Wp[(size_t)k * N];
        s0 += shl[k] * wv; s1 += shl[1024 + k] * wv; s2 += shl[2048 + k] * wv; s3 += shl[3072 + k] * wv; s4 += shl[4096 + k] * wv;
        s5 += shl[5120 + k] * wv; s6 += shl[6144 + k] * wv; s7 += shl[7168 + k] * wv; s8 += shl[8192 + k] * wv; }
    LAS float* rp = red + wave * 576 + lane;
    rp[0] = s0; rp[64] = s1; rp[128] = s2; rp[192] = s3; rp[256] = s4; rp[320] = s5; rp[384] = s6; rp[448] = s7; rp[512] = s8;
    __syncthreads();
    for (int i = tid; i < 576; i += 512) { float sum = 0.f;
#pragma unroll
        for (int ww = 0; ww < 8; ++ww) sum += red[ww * 576 + i];
        const int b = i >> 6, l = i & 63; if (n0 + l < N) out[b * 4096 + n0 + l] = sum; else if (n0 + l < 4096) out[b * 4096 + n0 + l] = 0.f; }
    __syncthreads();
}

__global__ void __launch_bounds__(512, 2) fwd_megakernel(Args a) {
    extern __shared__ __attribute__((aligned(16))) unsigned char lds_raw[];
    LAS unsigned char* lds = (LAS unsigned char*)lds_raw;
    cg::grid_group grid = cg::this_grid();
    const int wave = __builtin_amdgcn_readfirstlane((int)threadIdx.x >> 6);
    const int G = gridDim.x, bid = blockIdx.x;
    const int vcu = (G % 8 == 0) ? (bid % 8) * (G / 8) + bid / 8 : bid;
    const int gw = vcu * 8 + wave, NGW = G * 8;
    unsigned char* ws = a.ws;
    volatile LAS unsigned* bar_st = (volatile LAS unsigned*)(lds + 131072 + 64);
    if (wave == 0 && lane_id() < 2) bar_st[lane_id()] = 0u;
    __syncthreads();
    XcdBarrier xbar = xcd_barrier_post((unsigned*)(ws + WS_BAR), bar_st, wave == 0 && lane_id() == 0);
#define GRID_BAR() xcd_barrier(xbar, wave == 0 && lane_id() == 0)
    const float* x_in = a.in[0]; const float* c_in = a.in[1]; const float* ctx_in = a.in[2]; const float* cctx_in = a.in[3];
    const float* ada_w = a.in[4]; const float* ada_b = a.in[5]; const float* norm_mix_g = a.in[6]; const float* norm_mlp_g = a.in[7]; const float* norm_out_g = a.in[8];
    float* MOD = (float*)(ws + WS_MOD); float* SSQ = (float*)(ws + WS_SSQ);
    float* ROPE16 = (float*)(ws + WS_ROPE16); float* ROPE32 = (float*)(ws + WS_ROPE32);
    bf16_t* KPE = (bf16_t*)(ws + WS_KPE); float* XC = (float*)(ws + WS_XC);
    bf16_t* H = (bf16_t*)(ws + WS_H); bf16_t* Qb = (bf16_t*)(ws + WS_Q); bf16_t* Kb = (bf16_t*)(ws + WS_K); bf16_t* VTb = (bf16_t*)(ws + WS_VT);
    bf16_t* Ob = (bf16_t*)(ws + WS_O); bf16_t* LAT = (bf16_t*)(ws + WS_LAT); bf16_t* HID = (bf16_t*)(ws + WS_HID);
    _Float16* Xh = (_Float16*)(ws + WS_XH);
    float* NBIAS = (float*)(ws + WS_NBIAS); float* SSQN = (float*)(ws + WS_SSQN); float* PART_O = (float*)(ws + WS_PART_O); float* PART_M = (float*)(ws + WS_PART_M);

    {
        const int lane = lane_id(), tid = wave * 64 + lane;
        LAS float* act = (LAS float*)(lds + 65536); LAS float* red = (LAS float*)(lds + 102400);
        for (int i = tid; i < 9 * 1024; i += 512) { const int b = i >> 10, k = i & 1023; const float v = b < 8 ? c_in[b * 1024 + k] : cctx_in[k]; act[i] = v / (1.f + __builtin_amdgcn_exp2f(-v * LOG2E)); }
        __syncthreads();
        for (int it = bid; it < 384; it += G) {
            const int layer = it / 96, n0 = (it % 96) * 64;
            const float* W = ada_w + (size_t)layer * 1024 * 6144 + n0 + lane;
            float s0 = 0, s1 = 0, s2 = 0, s3 = 0, s4 = 0, s5 = 0, s6 = 0, s7 = 0, s8 = 0;
#pragma unroll 8
            for (int k = wave * 128; k < wave * 128 + 128; ++k) { const float wv = W[(size_t)k * 6144];
                s0 += act[k] * wv; s1 += act[1024 + k] * wv; s2 += act[2048 + k] * wv; s3 += act[3072 + k] * wv; s4 += act[4096 + k] * wv;
                s5 += act[5120 + k] * wv; s6 += act[6144 + k] * wv; s7 += act[7168 + k] * wv; s8 += act[8192 + k] * wv; }
            LAS float* rp = red + wave * 576 + lane;
            rp[0] = s0; rp[64] = s1; rp[128] = s2; rp[192] = s3; rp[256] = s4; rp[320] = s5; rp[384] = s6; rp[448] = s7; rp[512] = s8;
            __syncthreads();
            for (int i = tid; i < 576; i += 512) { float s = 0.f;
#pragma unroll
                for (int ww = 0; ww < 8; ++ww) s += red[ww * 576 + i];
                const int b = i >> 6, l = i & 63; MOD[((size_t)layer * 9 + b) * 6144 + n0 + l] = s + ada_b[layer * 6144 + n0 + l]; }
            __syncthreads();
        }
        __syncthreads();
        LAS float* scr = (LAS float*)(lds + wave * 16384);
        int base = 0;
#define TR(Wsrc, K_, N_, dst, gsc) do { const int n_ = ((K_) / 64) * ((N_) / 32); \
            for (int it_ = (gw + NGW - (base % NGW)) % NGW; it_ < n_; it_ += NGW) transpose_item((Wsrc), (K_), (N_), (dst), (gsc), scr, it_, lane); base += n_; } while (0)
        for (int L = 0; L < 4; ++L) {
            TR(a.in[9] + (size_t)L * DM * FF, DM, FF, (bf16_t*)(ws + WS_W1T + (size_t)L * 8 * MiB), (const float*)nullptr);
            TR(a.in[10] + (size_t)L * FF * DM, FF, DM, (bf16_t*)(ws + WS_W2T + (size_t)L * 8 * MiB), (const float*)nullptr);
        }
        for (int j = 0; j < 2; ++j) {
            unsigned char* mb = ws + WS_MLA + (size_t)j * 5 * MiB;
            TR(a.in[11] + (size_t)j * DM * 416, DM, 416, (bf16_t*)mb, (const float*)nullptr);
            TR(a.in[13] + (size_t)j * 256 * 1536, 256, 1536, (bf16_t*)(mb + 1 * MiB), a.in[12] + j * 256);
            TR(a.in[15] + (size_t)j * 128 * 2048, 128, 2048, (bf16_t*)(mb + 1 * MiB + 768 * 1024), a.in[14] + j * 128);
            TR(a.in[16] + (size_t)j * DM * DM, DM, DM, (bf16_t*)(mb + 3 * MiB), (const float*)nullptr);
            u32x4* z = (u32x4*)(mb + (size_t)416 * 1024 * 2);
            for (int i = gw * 64 + lane; i < 96 * 1024 * 2 / 16; i += NGW * 64) z[i] = (u32x4){0u, 0u, 0u, 0u};
        }
        TR(a.in[17], DM, 1536, (bf16_t*)(ws + WS_SWA), (const float*)nullptr);
        TR(a.in[19], DM, DM, (bf16_t*)(ws + WS_SWA + 3 * MiB), (const float*)nullptr);
        TR(a.in[20], DM, 3072, (bf16_t*)(ws + WS_NA), (const float*)nullptr);
        TR(a.in[22], DM, DM, (bf16_t*)(ws + WS_NA + 6 * MiB), (const float*)nullptr);
#undef TR
        for (int i = gw * 64 + lane; i < 8192 * 16; i += NGW * 64) { const int t = i >> 4, p = i & 15; const int f = p & 7; const float pos = (float)(p < 8 ? (t >> 6) : (t & 63));
            const float ang = pos * __builtin_amdgcn_exp2f(-(float)f * (13.287712379549449f / 8.f)); float sn, cs; sincos_red(ang, sn, cs); ROPE16[2 * i] = cs; ROPE16[2 * i + 1] = sn; }
        for (int i = gw * 64 + lane; i < 8192 * 32; i += NGW * 64) { const int t = i >> 5, p = i & 31; const int f = p & 15; const float pos = (float)(p < 16 ? (t >> 6) : (t & 63));
            const float ang = pos * __builtin_amdgcn_exp2f(-(float)f * (13.287712379549449f / 16.f)); float sn, cs; sincos_red(ang, sn, cs); ROPE32[2 * i] = cs; ROPE32[2 * i + 1] = sn; }
        for (int i = gw * 64 + lane; i < 4 * MT; i += NGW * 64) SSQ[i] = 0.f;
        for (int i = gw * 64 + lane; i < 8 * MT; i += NGW * 64) SSQN[i] = 0.f;
    }
    grid.sync();
    {
        const int lane = lane_id();
        for (int it = bid; it < 8 + 24 + 48 + 8 + 256; it += G) {
            int r = it; const float* W; int N, L, which, blk;
            if (r < 8) { W = a.in[11]; N = 416; L = 0; which = 0; blk = r; }
            else if ((r -= 8) < 24) { W = a.in[17]; N = 1536; L = 1; which = 0; blk = r; }
            else if ((r -= 24) < 48) { W = a.in[20]; N = 3072; L = 2; which = 0; blk = r; }
            else if ((r -= 48) < 8) { W = a.in[11] + (size_t)DM * 416; N = 416; L = 3; which = 0; blk = r; }
            else { r -= 8; L = r >> 6; blk = r & 63; W = a.in[9] + (size_t)L * DM * FF; N = FF; which = 1; }
            nbias_item(lds, W, N, blk * 64, MOD + (size_t)L * 9 * 6144, which ? 3072 : 0, NBIAS + (size_t)(L * 2 + which) * 9 * 4096, wave, lane);
        }
        norm_pass0(x_in, ctx_in, norm_mix_g, MOD, 1024, H, SSQN, gw, NGW);
        for (int i = gw * 64 + lane; i < MC * DM / 4; i += NGW * 64) ((f32x4*)XC)[i] = ((const f32x4*)ctx_in)[i];
    }
    GRID_BAR();

    for (int L = 0; L < 4; ++L) {
        const int kind = L % 3, jl = L / 3; const bool last = (L == 3);
        const float* modL = MOD + (size_t)L * 9 * 6144;
        const float* ssqn1 = SSQN + (size_t)(2 * L) * MT; const float* nbias1 = NBIAS + (size_t)(L * 2) * 9 * 4096;
        if (kind == 0) {
            unsigned char* mb = ws + WS_MLA + (size_t)jl * 5 * MiB;
            float* ssq_q = SSQ + (size_t)jl * 2 * MT; float* ssq_kv = ssq_q + MT;
            {
                pg8::Gemm g{H, (const bf16_t*)mb, MT, 512, DM, DM, DM}; pg8::StaticOrder S; S.init(MT, 512, G, bid);
                EpiLat E{LAT, ssq_q, ssq_kv, KPE, ROPE16, ssqn1, nbias1};
                pg8::gemm_phase<EpiLat, pg8::StaticOrder, true>(lds, g, S, E, wave);
            }
            GRID_BAR();
            {
                pg8::Gemm g{LAT, (const bf16_t*)(mb + 1 * MiB), MT, 1536, 256, 512, 256}; pg8::StaticOrder S; S.init(MT, 1536, G, bid);
                EpiProj<0> E{Qb, nullptr, nullptr, ROPE16, ssq_q, 0.10206207261596577f * LOG2E, nullptr};
                pg8::gemm_phase<EpiProj<0>, pg8::StaticOrder, true>(lds, g, S, E, wave);
            }
            {
                pg8::Gemm g{LAT + 256, (const bf16_t*)(mb + 1 * MiB + 768 * 1024), MT, 2048, 128, 512, 128}; pg8::StaticOrder S; S.init(MT, 2048, G, bid);
                EpiProj<1> E{nullptr, Kb, VTb, nullptr, ssq_kv, 1.f, nullptr};
                pg8::gemm_phase<EpiProj<1>, pg8::StaticOrder, true>(lds, g, S, E, wave);
            }
        } else if (kind == 1) {
            pg8::Gemm g{H, (const bf16_t*)(ws + WS_SWA), MT, 1536, DM, DM, DM}; pg8::StaticOrder S; S.init(MT, 1536, G, bid);
            EpiProj<2> E{Qb, Kb, VTb, ROPE32, ssqn1, 0.125f * LOG2E, nbias1};
            pg8::gemm_phase<EpiProj<2>, pg8::StaticOrder, true>(lds, g, S, E, wave);
        } else {
            pg8::Gemm g{H, (const bf16_t*)(ws + WS_NA), MT, 3072, DM, DM, DM}; pg8::StaticOrder S; S.init(MT, 3072, G, bid);
            EpiProj<3> E{Qb, Kb, VTb, nullptr, ssqn1, 0.125f * LOG2E, nbias1};
            pg8::gemm_phase<EpiProj<3>, pg8::StaticOrder, true>(lds, g, S, E, wave);
        }
        GRID_BAR();
        {
            AttnP P{Qb, Kb, KPE, VTb, Ob, a.in[18], a.in[21], last ? 4096 : 4096 + 128};
            if (kind == 0) attn_phase<0>(lds, P, vcu, G, wave);
            else if (kind == 1) attn_phase<1>(lds, P, vcu, G, wave);
            else attn_phase<2>(lds, P, vcu, G, wave);
        }
        GRID_BAR();
        const int Mres = last ? ML : MT;
        {
            const bf16_t* wo = (const bf16_t*)(kind == 0 ? ws + WS_MLA + (size_t)jl * 5 * MiB + 3 * MiB : (kind == 1 ? ws + WS_SWA + 3 * MiB : ws + WS_NA + 6 * MiB));
            {
                pg8::Gemm g{Ob, wo, ML, DM, DM, DM, DM}; pg8::StaticOrder S; S.init(ML, DM, G, bid);
                EpiResid E{L == 0 ? x_in : nullptr, Xh, Xh, modL + 2048, H, norm_mlp_g + L * DM, modL + 4096, SSQN + (size_t)(2 * L + 1) * MT};
                pg8::gemm_phase<EpiResid, pg8::StaticOrder, true>(lds, g, S, E, wave);
            }
            if (!last) {
                pg8::Gemm g{Ob, wo, MT, DM, 128, DM, DM}; pg8::CtxSplitOrder S{bid, G, 128};
                EpiCtxPartial E{PART_O, 128};
                pg8::gemm_phase<EpiCtxPartial, pg8::CtxSplitOrder, true>(lds, g, S, E, wave);
            }
        }
        GRID_BAR();
        if (!last) { norm_ctx(XC, PART_O, modL + 2048 + 8 * 6144, norm_mlp_g + L * DM, modL + 8 * 6144 + 4096, H + (size_t)ML * DM, SSQN + (size_t)(2 * L + 1) * MT + ML, gw, NGW); GRID_BAR(); }
        {
            pg8::Gemm g{H, (const bf16_t*)(ws + WS_W1T + (size_t)L * 8 * MiB), Mres, FF, DM, DM, DM}; pg8::StaticOrder S; S.init(Mres, FF, G, bid);
            EpiSqRelu E{HID, FF, SSQN + (size_t)(2 * L + 1) * MT, NBIAS + (size_t)(L * 2 + 1) * 9 * 4096};
            pg8::gemm_phase<EpiSqRelu, pg8::StaticOrder, true>(lds, g, S, E, wave);
        }
        GRID_BAR();
        {
            const bf16_t* w2t = (const bf16_t*)(ws + WS_W2T + (size_t)L * 8 * MiB);
            {
                pg8::Gemm g{HID, w2t, ML, DM, FF, FF, FF}; pg8::StaticOrder S; S.init(ML, DM, G, bid);
                EpiResid E{nullptr, Xh, Xh, modL + 5120, last ? nullptr : H, norm_mix_g + (L + 1) * DM, MOD + (size_t)(L + 1) * 9 * 6144 + 1024, SSQN + (size_t)(2 * L + 2) * MT};
                pg8::gemm_phase<EpiResid, pg8::StaticOrder, true>(lds, g, S, E, wave);
            }
            if (!last) {
                pg8::Gemm g{HID, w2t, MT, DM, 512, FF, FF}; pg8::CtxSplitOrder S{bid, G, 512};
                EpiCtxPartial E{PART_M, 512};
                pg8::gemm_phase<EpiCtxPartial, pg8::CtxSplitOrder, true>(lds, g, S, E, wave);
            }
        }
        GRID_BAR();
        if (!last) { norm_ctx(XC, PART_M, modL + 5120 + 8 * 6144, norm_mix_g + (L + 1) * DM, MOD + (size_t)(L + 1) * 9 * 6144 + 8 * 6144 + 1024, H + (size_t)ML * DM, SSQN + (size_t)(2 * L + 2) * MT + ML, gw, NGW); GRID_BAR(); }
    }
    int lane = lane_id(); asm volatile("" : "+v"(lane));
    for (int row = gw; row < ML; row += NGW) {
        const _Float16* xh = Xh + (size_t)row * DM; float* xr = a.out + (size_t)row * DM;
        f32x4 v[4]; float ss = 0.f;
#pragma unroll
        for (int j = 0; j < 4; ++j) { v[j] = ld_h4(xh + 4 * lane + 256 * j); ss += (v[j][0] * v[j][0] + v[j][1] * v[j][1]) + (v[j][2] * v[j][2] + v[j][3] * v[j][3]); }
        const float rstd = rsqrtf(wave_sum(ss, lane) * (1.f / DM) + EPS);
#pragma unroll
        for (int j = 0; j < 4; ++j) { const int col = 4 * lane + 256 * j; const f32x4 gg = *(const f32x4*)(norm_out_g + col); *(f32x4*)(xr + col) = v[j] * rstd * gg; }
    }
}

constexpr int LDS_BYTES = 147456;
extern "C" void kernel_launch(void* const* d_in, const int* in_sizes, int n_in, void* d_out, int out_size, void* d_ws, size_t ws_size, hipStream_t stream) {
    static int grid = 0;
    if (grid == 0) {
        if (n_in != 23 || out_size != ML * DM || ws_size < WS_END) { fprintf(stderr, "kernel_launch: unexpected shapes (n_in %d out %d ws %zu)\n", n_in, out_size, ws_size); grid = -1; return; }
        int dev = 0, cus = 0, per_cu = 0;
        hipGetDevice(&dev); hipDeviceGetAttribute(&cus, hipDeviceAttributeMultiprocessorCount, dev);
        if (hipFuncSetAttribute((const void*)fwd_megakernel, hipFuncAttributeMaxDynamicSharedMemorySize, LDS_BYTES) != hipSuccess) { fprintf(stderr, "kernel_launch: hipFuncSetAttribute failed\n"); grid = -1; return; }
        if (hipOccupancyMaxActiveBlocksPerMultiprocessor(&per_cu, (const void*)fwd_megakernel, 512, LDS_BYTES) != hipSuccess || per_cu < 1) { fprintf(stderr, "kernel_launch: occupancy query gave %d\n", per_cu); per_cu = 1; }
        (void)hipGetLastError();
        grid = cus * per_cu;
    }
    if (grid < 0) return;
    if (hipMemsetAsync((char*)d_ws + WS_BAR, 0, XCD_BAR_WORDS * 4, stream) != hipSuccess) { fprintf(stderr, "kernel_launch: memset of the barrier words failed\n"); return; }
    Args a{};
    for (int i = 0; i < 23; ++i) a.in[i] = (const float*)d_in[i];
    a.out = (float*)d_out; a.ws = (unsigned char*)d_ws;
    void* args[] = {&a};
    hipError_t e = hipLaunchCooperativeKernel((const void*)fwd_megakernel, dim3(grid), dim3(512), args, LDS_BYTES, stream);
    if (e != hipSuccess) fprintf(stderr, "cooperative launch failed: %s (grid %d)\n", hipGetErrorString(e), grid);
}
```

```cpp
#include <hip/hip_runtime.h>
#include <hip/hip_cooperative_groups.h>
#include <cstdio>
#include <cstdint>
namespace cg = cooperative_groups;

#define LAS __attribute__((address_space(3)))
typedef unsigned short bf16_t;
typedef short bf16x8 __attribute__((ext_vector_type(8)));
typedef float f32x4 __attribute__((ext_vector_type(4)));
typedef float f32x16 __attribute__((ext_vector_type(16)));
typedef unsigned u32x4 __attribute__((ext_vector_type(4)));
typedef unsigned u32x2 __attribute__((ext_vector_type(2)));

constexpr int NB = 8, SEQ = 8192, DM = 1024, CTX = 256, FF = 4096;
constexpr int ML = NB * SEQ;
constexpr int MC = NB * CTX;
constexpr int MT = ML + MC;
constexpr int KVLEN = CTX + SEQ;
constexpr float EPS = 1e-6f;
constexpr float LOG2E = 1.4426950408889634f;

__device__ __forceinline__ unsigned cvtpk(float lo, float hi) {
    typedef float f2 __attribute__((ext_vector_type(2))); typedef __bf16 b2 __attribute__((ext_vector_type(2)));
    f2 v = {lo, hi}; b2 b = __builtin_convertvector(v, b2); return __builtin_bit_cast(unsigned, b);
}
__device__ __forceinline__ int lane_id() { int l; asm volatile("v_mbcnt_lo_u32_b32 %0, -1, 0\n\tv_mbcnt_hi_u32_b32 %0, -1, %0" : "=v"(l)); return l; }
__device__ __forceinline__ float shfl_xor_l(float v, int mask, int lane) { return __int_as_float(__builtin_amdgcn_ds_bpermute((lane ^ mask) << 2, __float_as_int(v))); }
__device__ __forceinline__ int perm16(int x) { return 8 * ((x >> 2) & 1) + (x & 3) + 4 * (x >> 3); }

namespace pg8 {
constexpr int BM = 256, BK = 64, HALF = 128, HTB = HALF * BK * 2, STAGE_BYTES = 8 * HTB, NXCD = 8, WGM = 8;
__host__ __device__ __forceinline__ int lds_byte(int r, int c) { const int st = (r >> 4) * 2 + (c >> 5), rr = r & 15, cc = c & 31, ob = rr * 64 + cc * 2; return st * 1024 + (ob ^ (((ob >> 9) & 1) << 5)); }
__host__ __device__ __forceinline__ void stage_rc(int b, int& R, int& C) { const int st = b / 1024, sb = b % 1024, swz = sb ^ (((sb >> 9) & 1) << 5); R = (st >> 1) * 16 + swz / 64; C = (st & 1) * 32 + (swz % 64) / 2; }
__host__ __device__ __forceinline__ int perm32(int rho) { const int n = rho >> 4, i = rho & 15; return 8 * (i >> 2) + 4 * n + (i & 3); }

struct Unit { int pm, pn, koff; };
struct Gemm { const bf16_t* A; const bf16_t* Bt; int M, N, K, lda, ldb; };

struct StaticOrder {
    int nM, nN, nwg, G, c;
    __device__ void init(int M, int N, int G_, int c_) { nM = M / BM; nN = N / BM; nwg = nM * nN; G = G_; c = c_; }
    __device__ bool next(int i, Unit& u) const {
        const long L = (long)i * G + c; if (L >= nwg) return false;
        int wgid = (int)L; { const int q = nwg / NXCD, r = nwg % NXCD, xcd = wgid % NXCD, off = wgid / NXCD; wgid = (xcd < r ? xcd * (q + 1) : r * (q + 1) + (xcd - r) * q) + off; }
        const int nig = WGM * nN, gid = wgid / nig, fm = gid * WGM, gsz = (nM - fm) < WGM ? (nM - fm) : WGM;
        u.pm = fm + ((wgid % nig) % gsz); u.pn = (wgid % nig) / gsz; u.koff = 0; return true;
    }
};

struct CtxSplitOrder {
    int c, G, kchunk;
    __device__ bool next(int i, Unit& u) const { const int L = i * G + c; if (L >= 256) return false; u.pm = 256 + (L >> 5); u.pn = (L >> 3) & 3; u.koff = (L & 7) * kchunk; return true; }
};

template <class Epi, class Sched, bool ALIGN_EPI>
__device__ __forceinline__ void gemm_phase(LAS unsigned char* lds, const Gemm g, const Sched& S, const Epi& E, int wave_s) {
    int tid_l = wave_s * 64 + lane_id(); asm volatile("" : "+v"(tid_l));
    const int tid = tid_l, wid = __builtin_amdgcn_readfirstlane(tid >> 6), lane = tid & 63, wr = wid >> 2, wc = wid & 3, fr = lane & 15, fq = lane >> 4;
    const int K = g.K, nt = K / BK;
    unsigned voffA[2], voffB[2];
#pragma unroll
    for (int i = 0; i < 2; ++i) { int R, C; stage_rc(tid * 16 + i * 8192, R, C); const int Rb = Epi::PERM ? ((R & ~31) + perm32(R & 31)) : R;
        voffA[i] = (unsigned)(R * g.lda + C) * 2u; voffB[i] = (unsigned)(Rb * g.ldb + C) * 2u; }
    const size_t kstep = (size_t)(BK * 2);
    const size_t hstepA = (size_t)HALF * g.lda * 2, hstepB = (size_t)HALF * g.ldb * 2;
    const size_t tstepA = 2 * hstepA, tstepB = 2 * hstepB;
    const unsigned ldsw = (unsigned)wid * 1024u;
    const int aoff = lds_byte(wr * 64 + fr, fq * 8), boff = lds_byte(wc * 32 + fr, fq * 8);
#define PG8_SA(b, h) (((b) * 2 + (h)) * HTB)
#define PG8_SB(b, h) ((4 + (b) * 2 + (h)) * HTB)
#define PG8_STAGE(bufoff, gbase, voff) do { _Pragma("unroll") for (int _i = 0; _i < 2; ++_i) \
        __builtin_amdgcn_global_load_lds((const unsigned*)((const char*)(gbase) + (voff)[_i]), (LAS unsigned*)(lds + (bufoff) + ldsw + _i * 8192), 16, 0, 0); } while (0)
#define PG8_LDA(dst, b, h) do { _Pragma("unroll") for (int m = 0; m < 4; ++m) _Pragma("unroll") for (int k = 0; k < 2; ++k) dst[m][k] = *(const LAS bf16x8*)(lds + PG8_SA(b, h) + aoff + m * 2048 + k * 1024); } while (0)
#define PG8_LDB(dst, b, h) do { _Pragma("unroll") for (int n = 0; n < 2; ++n) _Pragma("unroll") for (int k = 0; k < 2; ++k) dst[n][k] = *(const LAS bf16x8*)(lds + PG8_SB(b, h) + boff + n * 2048 + k * 1024); } while (0)
#define PG8_MMA(ai, bj, At, Bt) do { __builtin_amdgcn_s_setprio(1); _Pragma("unroll") for (int m = 0; m < 4; ++m) _Pragma("unroll") for (int n = 0; n < 2; ++n) _Pragma("unroll") for (int k = 0; k < 2; ++k) \
        acc[ai][bj][m][n] = __builtin_amdgcn_mfma_f32_16x16x32_bf16(Bt[n][k], At[m][k], acc[ai][bj][m][n], 0, 0, 0); __builtin_amdgcn_s_setprio(0); } while (0)
#define PG8_WAIT_V(n) asm volatile("s_waitcnt vmcnt(" #n ")" ::: "memory")
#define PG8_WAIT_L(n) asm volatile("s_waitcnt lgkmcnt(" #n ")" ::: "memory")
#define PG8_BAR __builtin_amdgcn_s_barrier()
#define PG8_SCHED __builtin_amdgcn_sched_barrier(0)
    Unit cur, nxt; int ui = 0;
    if (!S.next(0, cur)) return;
    f32x4 acc[2][2][4][2];
#pragma unroll
    for (int a = 0; a < 2; ++a)
#pragma unroll
        for (int b = 0; b < 2; ++b)
#pragma unroll
            for (int m = 0; m < 4; ++m)
#pragma unroll
                for (int n = 0; n < 2; ++n) acc[a][b][m][n] = (f32x4){0.f, 0.f, 0.f, 0.f};
    bf16x8 At[4][2], B0[2][2], B1[2][2];
    const char* cA = (const char*)g.A + (size_t)cur.pm * tstepA + (size_t)cur.koff * 2; const char* cB = (const char*)g.Bt + (size_t)cur.pn * tstepB + (size_t)cur.koff * 2;
    PG8_STAGE(PG8_SB(0, 0), cB, voffB); PG8_STAGE(PG8_SB(0, 1), cB + hstepB, voffB); PG8_STAGE(PG8_SA(0, 0), cA, voffA); PG8_STAGE(PG8_SA(0, 1), cA + hstepA, voffA);
    if (wr == 1) PG8_BAR;
    PG8_WAIT_V(2); PG8_BAR;
    PG8_STAGE(PG8_SB(1, 0), cB + kstep, voffB); PG8_STAGE(PG8_SA(1, 0), cA + kstep, voffA); PG8_STAGE(PG8_SB(1, 1), cB + hstepB + kstep, voffB);
    PG8_WAIT_V(6); PG8_BAR;
    for (;;) {
        const bool has_next = S.next(ui + 1, nxt);
        const char* nA = has_next ? (const char*)g.A + (size_t)nxt.pm * tstepA + (size_t)nxt.koff * 2 : cA; const char* nB = has_next ? (const char*)g.Bt + (size_t)nxt.pn * tstepB + (size_t)nxt.koff * 2 : cB;
        for (int t = 0; t < nt; t += 2) {
            const bool last = (t == nt - 2);
            const char* a1 = cA + (size_t)(t + 1) * kstep;
            const char* a2 = last ? nA : cA + (size_t)(t + 2) * kstep; const char* b2 = last ? nB : cB + (size_t)(t + 2) * kstep;
            const char* a3 = a2 + kstep; const char* b3 = b2 + kstep;
            PG8_LDB(B0, 0, 0); PG8_LDB(B1, 0, 1); PG8_SCHED; PG8_LDA(At, 0, 0); PG8_STAGE(PG8_SA(1, 1), a1 + hstepA, voffA);
            PG8_WAIT_V(8); PG8_WAIT_L(0); PG8_BAR; PG8_MMA(0, 0, At, B0); PG8_MMA(0, 1, At, B1); PG8_BAR; PG8_SCHED;
            PG8_LDA(At, 0, 1); PG8_STAGE(PG8_SB(0, 0), b2, voffB); PG8_STAGE(PG8_SB(0, 1), b2 + hstepB, voffB); PG8_STAGE(PG8_SA(0, 0), a2, voffA);
            PG8_WAIT_V(8); PG8_WAIT_L(0); PG8_BAR; PG8_MMA(1, 0, At, B0); PG8_MMA(1, 1, At, B1); PG8_BAR; PG8_SCHED;
            PG8_LDB(B0, 1, 0); PG8_LDB(B1, 1, 1); PG8_SCHED; PG8_LDA(At, 1, 0); PG8_STAGE(PG8_SA(0, 1), a2 + hstepA, voffA);
            PG8_WAIT_V(8); PG8_WAIT_L(0); PG8_BAR; PG8_MMA(0, 0, At, B0); PG8_MMA(0, 1, At, B1); PG8_BAR; PG8_SCHED;
            PG8_LDA(At, 1, 1); PG8_STAGE(PG8_SB(1, 0), b3, voffB); PG8_STAGE(PG8_SB(1, 1), b3 + hstepB, voffB); PG8_STAGE(PG8_SA(1, 0), a3, voffA);
            PG8_WAIT_V(8); PG8_WAIT_L(0); PG8_BAR; PG8_MMA(1, 0, At, B0); PG8_MMA(1, 1, At, B1); PG8_BAR; PG8_SCHED;
        }
        if constexpr (ALIGN_EPI) { if (wr == 0) PG8_BAR; }
        E(acc, cur, wr, wc, fr, fq);
        if (!has_next) break;
#pragma unroll
        for (int a = 0; a < 2; ++a)
#pragma unroll
            for (int b = 0; b < 2; ++b)
#pragma unroll
                for (int m = 0; m < 4; ++m)
#pragma unroll
                    for (int n = 0; n < 2; ++n) acc[a][b][m][n] = (f32x4){0.f, 0.f, 0.f, 0.f};
        cur = nxt; cA = nA; cB = nB; ++ui;
        if constexpr (ALIGN_EPI) { if (wr == 1) PG8_BAR; }
    }
    PG8_WAIT_V(0);
    if constexpr (!ALIGN_EPI) { if (wr == 0) PG8_BAR; }
    PG8_BAR;
#undef PG8_SA
#undef PG8_SB
#undef PG8_STAGE
#undef PG8_LDA
#undef PG8_LDB
#undef PG8_MMA
#undef PG8_WAIT_V
#undef PG8_WAIT_L
#undef PG8_BAR
#undef PG8_SCHED
}
}

typedef const f32x4 (&AccRef)[2][2][4][2];

__device__ __forceinline__ void rope8(float (&v)[8], const float* tab) {
    const f32x4 t0 = *(const f32x4*)tab, t1 = *(const f32x4*)(tab + 4);
    float x1, x2;
    x1 = v[0]; x2 = v[1]; v[0] = x1 * t0[0] - x2 * t0[1]; v[1] = x1 * t0[1] + x2 * t0[0];
    x1 = v[2]; x2 = v[3]; v[2] = x1 * t0[2] - x2 * t0[3]; v[3] = x1 * t0[3] + x2 * t0[2];
    x1 = v[4]; x2 = v[5]; v[4] = x1 * t1[0] - x2 * t1[1]; v[5] = x1 * t1[1] + x2 * t1[0];
    x1 = v[6]; x2 = v[7]; v[6] = x1 * t1[2] - x2 * t1[3]; v[7] = x1 * t1[3] + x2 * t1[2];
}
__device__ __forceinline__ void rope8v(float (&v)[8], const f32x4 t0, const f32x4 t1) {
    float x1, x2;
    x1 = v[0]; x2 = v[1]; v[0] = x1 * t0[0] - x2 * t0[1]; v[1] = x1 * t0[1] + x2 * t0[0];
    x1 = v[2]; x2 = v[3]; v[2] = x1 * t0[2] - x2 * t0[3]; v[3] = x1 * t0[3] + x2 * t0[2];
    x1 = v[4]; x2 = v[5]; v[4] = x1 * t1[0] - x2 * t1[1]; v[5] = x1 * t1[1] + x2 * t1[0];
    x1 = v[6]; x2 = v[7]; v[6] = x1 * t1[2] - x2 * t1[3]; v[7] = x1 * t1[3] + x2 * t1[2];
}
__device__ __forceinline__ u32x4 pack8(const float (&v)[8]) { u32x4 w; w.x = cvtpk(v[0], v[1]); w.y = cvtpk(v[2], v[3]); w.z = cvtpk(v[4], v[5]); w.w = cvtpk(v[6], v[7]); return w; }

template <int MODE> struct EpiProj {
    static constexpr bool PERM = true;
    bf16_t* Q; bf16_t* K; bf16_t* VT; const float* rope; const float* ssq; float qscale; const float* nbias;
    __device__ __forceinline__ void operator()(AccRef acc, const pg8::Unit& u, int wr, int wc, int fr_, int fq_) const {
        int lane_e = lane_id(); asm volatile("" : "+v"(lane_e)); const int fr = lane_e & 15, fq = lane_e >> 4; (void)fr_; (void)fq_;
        constexpr int LDQ = (MODE == 0) ? 1536 : 1024, NQ = (MODE == 0) ? 1536 : (MODE == 1 ? 0 : 1024);
        constexpr int LDK = (MODE == 2) ? 256 : 1024, NK = LDK, VCOLS = LDK;
        constexpr int TS = (MODE == 2) ? 64 : 32;
        const bool isctx = u.pm >= 256;
        const int row0 = u.pm * 256 + wr * 64 + fr, col0 = u.pn * 256 + wc * 32 + 8 * fq;
        f32x4 nbv[2][2]; float rs[4];
#pragma unroll
        for (int bj = 0; bj < 2; ++bj) {
            const int col = col0 + 128 * bj;
            if (MODE >= 2) { const float* nb = nbias + (isctx ? 8 : (u.pm >> 5)) * 4096 + col; nbv[bj][0] = *(const f32x4*)nb; nbv[bj][1] = *(const f32x4*)(nb + 4); }
            else { nbv[bj][0] = (f32x4){0.f, 0.f, 0.f, 0.f}; nbv[bj][1] = nbv[bj][0]; }
        }
#pragma unroll
        for (int r = 0; r < 8; ++r) {
            const int ai = r >> 2, m = r & 3; const int row = row0 + 128 * ai + 16 * m;
            if (m == 0) {
#pragma unroll
                for (int q = 0; q < 4; ++q) rs[q] = ssq[row0 + 128 * ai + 16 * q];
#pragma unroll
                for (int q = 0; q < 4; ++q) rs[q] = rsqrtf(rs[q] * (MODE == 0 ? 1.f / 256.f : (MODE == 1 ? 1.f / 128.f : 1.f / 1024.f)) + EPS);
            }
            const int rc = row - ML;
            const int b = isctx ? (rc >> 8) : (u.pm >> 5);
            const int kpos = isctx ? (rc & 255) : 256 + (row & 8191);
            const size_t kvrow = (size_t)b * KVLEN + kpos;
            const int vpos = (kpos & ~15) | perm16(kpos & 15);
            f32x4 tc[2][2] = {}; bool rp[2] = {false, false}; int roff[2] = {0, 0};
#pragma unroll
            for (int bj = 0; bj < 2; ++bj) { const int col = col0 + 128 * bj;
                if (MODE == 2) { rp[bj] = !isctx && col < 1280; roff[bj] = ((col & 63) >> 1) * 2; }
                else if (MODE == 0) { const int c96 = col % 96; rp[bj] = !isctx && c96 >= 64; roff[bj] = rp[bj] ? ((c96 - 64) >> 1) * 2 : 0; } }
            if (MODE == 2) {
#pragma unroll
                for (int bj = 0; bj < 2; ++bj) if (rp[bj]) { const float* tp = rope + (size_t)(row & 8191) * TS + roff[bj]; tc[bj][0] = *(const f32x4*)tp; tc[bj][1] = *(const f32x4*)(tp + 4); }
            }
#pragma unroll
            for (int bj = 0; bj < 2; ++bj) {
                const int col = col0 + 128 * bj;
                float v[8];
#pragma unroll
                for (int j = 0; j < 4; ++j) { v[j] = acc[ai][bj][m][0][j] * rs[m] + nbv[bj][0][j]; v[4 + j] = acc[ai][bj][m][1][j] * rs[m] + nbv[bj][1][j]; }
                if (MODE == 0 && rp[bj]) { const float* tp = rope + (size_t)(row & 8191) * TS + roff[bj]; tc[bj][0] = *(const f32x4*)tp; tc[bj][1] = *(const f32x4*)(tp + 4); }
                if ((MODE == 0 || MODE == 2) && rp[bj]) rope8v(v, tc[bj][0], tc[bj][1]);
                bool isv; int kc;
                if (MODE == 1) { const int within = col & 127; isv = within >= 64; kc = (col >> 7) * 64 + (within & 63); }
                else { isv = col >= NQ + NK; kc = isv ? col - NQ - NK : col - NQ; }
                if (MODE != 1 && col < NQ) {
#pragma unroll
                    for (int j = 0; j < 8; ++j) v[j] *= qscale;
                    *(u32x4*)(Q + (size_t)row * LDQ + col) = pack8(v);
                } else if (MODE != 0 && !isv) {
                    *(u32x4*)(K + kvrow * LDK + kc) = pack8(v);
                } else if (MODE != 0) {
                    bf16_t* vp = VT + ((size_t)(b * VCOLS + kc)) * KVLEN + vpos;
#pragma unroll
                    for (int j = 0; j < 8; ++j) vp[(size_t)j * KVLEN] = (bf16_t)(cvtpk(v[j], 0.f) & 0xffffu);
                }
            }
        }
    }
};

struct EpiLat {
    static constexpr bool PERM = true;
    bf16_t* lat; float* ssq_q; float* ssq_kv; bf16_t* KPE; const float* rope; const float* ssqn; const float* nbias;
    __device__ __forceinline__ void operator()(AccRef acc, const pg8::Unit& u, int wr, int wc, int fr_, int fq_) const {
        int lane_e = lane_id(); asm volatile("" : "+v"(lane_e)); const int fr = lane_e & 15, fq = lane_e >> 4; (void)fr_; (void)fq_;
        float rsv[8]; f32x4 nbv[2][2];
        { const int row0 = u.pm * 256 + wr * 64 + fr; const float* nb = nbias + (u.pm >= 256 ? 8 : (u.pm >> 5)) * 4096 + u.pn * 256 + wc * 32 + 8 * fq;
#pragma unroll
          for (int bj = 0; bj < 2; ++bj) { nbv[bj][0] = *(const f32x4*)(nb + 128 * bj); nbv[bj][1] = *(const f32x4*)(nb + 128 * bj + 4); }
#pragma unroll
          for (int r = 0; r < 8; ++r) rsv[r] = ssqn[row0 + 128 * (r >> 2) + 16 * (r & 3)];
#pragma unroll
          for (int r = 0; r < 8; ++r) rsv[r] = rsqrtf(rsv[r] * (1.f / 1024.f) + EPS); }
#pragma unroll
        for (int ai = 0; ai < 2; ++ai)
#pragma unroll
            for (int m = 0; m < 4; ++m) {
                const int row = u.pm * 256 + ai * 128 + wr * 64 + m * 16 + fr;
                const bool isctx = row >= ML; const int rc = row - ML;
                const int b = isctx ? (rc >> 8) : (row >> 13);
                const int tok = row & 8191;
                const int kpos = isctx ? (rc & 255) : 256 + tok;
                const size_t kvrow = (size_t)b * KVLEN + kpos;
                const float rs = rsv[ai * 4 + m];
                float ss = 0.f;
#pragma unroll
                for (int bj = 0; bj < 2; ++bj) {
                    const int col = u.pn * 256 + bj * 128 + wc * 32 + 8 * fq;
                    float v[8];
#pragma unroll
                    for (int j = 0; j < 4; ++j) { v[j] = acc[ai][bj][m][0][j] * rs; v[4 + j] = acc[ai][bj][m][1][j] * rs; }
                    {
#pragma unroll
                      for (int j = 0; j < 4; ++j) { v[j] += nbv[bj][0][j]; v[4 + j] += nbv[bj][1][j]; } }
                    if (col < 384) {
#pragma unroll
                        for (int j = 0; j < 8; ++j) ss += v[j] * v[j];
                        *(u32x4*)(lat + (size_t)row * 512 + col) = pack8(v);
                    } else if (col < 416) {
                        if (!isctx) rope8(v, rope + ((size_t)tok * 16 + ((col - 384) >> 1)) * 2);
                        *(u32x4*)(KPE + kvrow * 32 + (col - 384)) = pack8(v);
                    }
                }
                ss += shfl_xor_l(ss, 16, lane_e); ss += shfl_xor_l(ss, 32, lane_e);
                if (fq == 0 && (u.pn == 0 || wc < 4)) unsafeAtomicAdd((u.pn == 0 ? ssq_q : ssq_kv) + row, ss);
            }
    }
};

typedef _Float16 h16x4 __attribute__((ext_vector_type(4)));
__device__ __forceinline__ f32x4 ld_h4(const _Float16* p) { const h16x4 h = *(const h16x4*)p; return (f32x4){(float)h[0], (float)h[1], (float)h[2], (float)h[3]}; }
__device__ __forceinline__ void st_h4(_Float16* p, const f32x4 v) { h16x4 h; h[0] = (_Float16)v[0]; h[1] = (_Float16)v[1]; h[2] = (_Float16)v[2]; h[3] = (_Float16)v[3]; *(h16x4*)p = h; }
typedef _Float16 h16x8 __attribute__((ext_vector_type(8)));
struct EpiResid {
    static constexpr bool PERM = true;
    const float* xin32; const _Float16* xin16; _Float16* xout16; const float* gate;
    bf16_t* xa; const float* gn; const float* scn; float* ssqn;
    __device__ __forceinline__ void ldx8(size_t off, f32x4& a, f32x4& b) const {
        if (xin32) { a = *(const f32x4*)(xin32 + off); b = *(const f32x4*)(xin32 + off + 4); }
        else { const h16x8 h = *(const h16x8*)(xin16 + off); a = (f32x4){(float)h[0], (float)h[1], (float)h[2], (float)h[3]}; b = (f32x4){(float)h[4], (float)h[5], (float)h[6], (float)h[7]}; }
    }
    __device__ __forceinline__ void operator()(AccRef acc, const pg8::Unit& u, int wr, int wc, int fr_, int fq_) const {
        int lane_e = lane_id(); asm volatile("" : "+v"(lane_e)); const int fr = lane_e & 15, fq = lane_e >> 4; (void)fr_; (void)fq_;
        const int bsel = u.pm >> 5;
        const int col0 = u.pn * 256 + wc * 32 + 8 * fq;
        const int row0 = u.pm * 256 + wr * 64 + fr;
        f32x4 gv[4], av[4];
#pragma unroll
        for (int c = 0; c < 4; ++c) { const int col = col0 + 128 * (c >> 1) + 4 * (c & 1);
            gv[c] = *(const f32x4*)(gate + bsel * 6144 + col);
            if (xa) { const f32x4 g4 = *(const f32x4*)(gn + col), s4 = *(const f32x4*)(scn + bsel * 6144 + col); av[c] = g4 * (s4 + 1.f); } else av[c] = (f32x4){0.f, 0.f, 0.f, 0.f}; }
        f32x4 xc[4], xn[4]; float ssr[8];
        { const size_t xo_ = (size_t)row0 * DM + col0; ldx8(xo_, xc[0], xc[1]); ldx8(xo_ + 128, xc[2], xc[3]); }
#pragma unroll
        for (int r = 0; r < 8; ++r) {
            const int ai = r >> 2, m = r & 3; const int row = row0 + 128 * ai + 16 * m;
            if (r < 7) { const int rown = row0 + 128 * ((r + 1) >> 2) + 16 * ((r + 1) & 3); const size_t xo_ = (size_t)rown * DM + col0; ldx8(xo_, xn[0], xn[1]); ldx8(xo_ + 128, xn[2], xn[3]); }
            _Float16* xo = xout16 + (size_t)row * DM + col0; float ss = 0.f;
#pragma unroll
            for (int bj = 0; bj < 2; ++bj) {
                const f32x4 y0 = xc[2 * bj] + gv[2 * bj] * acc[ai][bj][m][0], y1 = xc[2 * bj + 1] + gv[2 * bj + 1] * acc[ai][bj][m][1];
                { h16x8 h; h[0] = (_Float16)y0[0]; h[1] = (_Float16)y0[1]; h[2] = (_Float16)y0[2]; h[3] = (_Float16)y0[3]; h[4] = (_Float16)y1[0]; h[5] = (_Float16)y1[1]; h[6] = (_Float16)y1[2]; h[7] = (_Float16)y1[3];
                  *(h16x8*)(xo + 128 * bj) = h; }
                if (xa) { const f32x4 z0 = y0 * av[2 * bj], z1 = y1 * av[2 * bj + 1];
                    ss += (y0[0] * y0[0] + y0[1] * y0[1]) + (y0[2] * y0[2] + y0[3] * y0[3]); ss += (y1[0] * y1[0] + y1[1] * y1[1]) + (y1[2] * y1[2] + y1[3] * y1[3]);
                    u32x4 o; o.x = cvtpk(z0[0], z0[1]); o.y = cvtpk(z0[2], z0[3]); o.z = cvtpk(z1[0], z1[1]); o.w = cvtpk(z1[2], z1[3]);
                    *(u32x4*)(xa + (size_t)row * DM + col0 + 128 * bj) = o; }
            }
            ssr[r] = ss;
#pragma unroll
            for (int c = 0; c < 4; ++c) xc[c] = xn[c];
        }
        if (xa) {
#pragma unroll
            for (int r = 0; r < 8; ++r) { float ss = ssr[r]; ss += shfl_xor_l(ss, 16, lane_e); ss += shfl_xor_l(ss, 32, lane_e); ssr[r] = ss; }
            if (fq == 0) {
#pragma unroll
                for (int r = 0; r < 8; ++r) unsafeAtomicAdd(ssqn + row0 + 128 * (r >> 2) + 16 * (r & 3), ssr[r]);
            }
        }
    }
};

struct EpiCtxPartial {
    static constexpr bool PERM = false;
    float* part; int kchunk;
    __device__ __forceinline__ void operator()(AccRef acc, const pg8::Unit& u, int wr, int wc, int fr_, int fq_) const {
        int lane_e = lane_id(); asm volatile("" : "+v"(lane_e)); const int fr = lane_e & 15, fq = lane_e >> 4; (void)fr_; (void)fq_;
        float* pb = part + (size_t)(u.koff / kchunk) * MC * DM;
#pragma unroll
        for (int ai = 0; ai < 2; ++ai)
#pragma unroll
            for (int m = 0; m < 4; ++m) {
                const int row = u.pm * 256 + ai * 128 + wr * 64 + m * 16 + fr - ML;
                float* xr = pb + (size_t)row * DM;
#pragma unroll
                for (int bj = 0; bj < 2; ++bj)
#pragma unroll
                    for (int n = 0; n < 2; ++n) {
                        const int col = u.pn * 256 + bj * 128 + wc * 32 + 16 * n + 4 * fq;
                        *(f32x4*)(xr + col) = acc[ai][bj][m][n];
                    }
            }
    }
};

struct EpiSqRelu {
    static constexpr bool PERM = true;
    bf16_t* O; int ldc; const float* ssqn; const float* nbias;
    __device__ __forceinline__ void operator()(AccRef acc, const pg8::Unit& u, int wr, int wc, int fr_, int fq_) const {
        int lane_e = lane_id(); asm volatile("" : "+v"(lane_e)); const int fr = lane_e & 15, fq = lane_e >> 4; (void)fr_; (void)fq_;
        const int row0 = u.pm * 256 + wr * 64 + fr, col0 = u.pn * 256 + wc * 32 + 8 * fq;
        const float* nb = nbias + (u.pm >= 256 ? 8 : (u.pm >> 5)) * 4096 + col0;
        f32x4 bv[2][2]; float rs[8];
#pragma unroll
        for (int bj = 0; bj < 2; ++bj) { bv[bj][0] = *(const f32x4*)(nb + bj * 128); bv[bj][1] = *(const f32x4*)(nb + bj * 128 + 4); }
#pragma unroll
        for (int r = 0; r < 8; ++r) rs[r] = ssqn[row0 + 128 * (r >> 2) + 16 * (r & 3)];
#pragma unroll
        for (int r = 0; r < 8; ++r) rs[r] = rsqrtf(rs[r] * (1.f / 1024.f) + EPS);
#pragma unroll
        for (int r = 0; r < 8; ++r) {
            const int ai = r >> 2, m = r & 3; const int row = row0 + 128 * ai + 16 * m;
#pragma unroll
            for (int bj = 0; bj < 2; ++bj) {
                float v[8];
#pragma unroll
                for (int j = 0; j < 4; ++j) { float a = fmaxf(acc[ai][bj][m][0][j] * rs[r] + bv[bj][0][j], 0.f), c = fmaxf(acc[ai][bj][m][1][j] * rs[r] + bv[bj][1][j], 0.f); v[j] = a * a; v[4 + j] = c * c; }
                *(u32x4*)(O + (size_t)row * ldc + col0 + bj * 128) = pack8(v);
            }
        }
    }
};

constexpr int KP = 208, VP = 144;
constexpr int KT_BYTES = 64 * KP, VT_BYTES = 64 * VP, ABUF = KT_BYTES + VT_BYTES;
constexpr int ATT_OSTAGE_OFF = 73728;
constexpr int ATT_BIAS_OFF = 2 * ABUF;
struct AttnP { const bf16_t* Q; const bf16_t* K; const bf16_t* KPE; const bf16_t* VT; bf16_t* O; const float* sink; const float* bias; int nunits; };

__device__ __forceinline__ float rowmax32(const f32x16& a, const f32x16& b) {
    float x = __builtin_fmaxf(__builtin_fmaxf(a[0], a[1]), b[0]), y = __builtin_fmaxf(__builtin_fmaxf(a[2], a[3]), b[1]); x = __builtin_fmaxf(__builtin_fmaxf(x, b[2]), b[3]);
#pragma unroll
    for (int r = 4; r < 16; r += 4) { x = __builtin_fmaxf(__builtin_fmaxf(x, a[r]), a[r + 1]); y = __builtin_fmaxf(__builtin_fmaxf(y, a[r + 2]), a[r + 3]); x = __builtin_fmaxf(__builtin_fmaxf(x, b[r]), b[r + 1]); y = __builtin_fmaxf(__builtin_fmaxf(y, b[r + 2]), b[r + 3]); }
    const float m = __builtin_fmaxf(x, y);
    auto rr = __builtin_amdgcn_permlane32_swap(__float_as_uint(m), __float_as_uint(m), false, false);
    return __builtin_fmaxf(__uint_as_float(rr[0]), __uint_as_float(rr[1]));
}

template <int VAR>
__device__ __forceinline__ void attn_phase(LAS unsigned char* lds, const AttnP P, int vcu, int G, int wave_s) {
    constexpr int ND0 = (VAR == 0) ? 6 : 4;
    constexpr int QPITCH = (VAR == 0) ? 1536 : 1024, QH = (VAR == 0) ? 96 : 64;
    constexpr int KPITCH = (VAR == 1) ? 256 : 1024, VCOLS = (VAR == 1) ? 256 : 1024;
    constexpr bool USE_NEGM = (VAR != 2);
    constexpr float THR = 8.f;
    int tid_l = wave_s * 64 + lane_id(); asm volatile("" : "+v"(tid_l));
    const int tid = tid_l, lane = tid & 63, r32 = lane & 31, hi = lane >> 5;
    const int w = __builtin_amdgcn_readfirstlane(tid >> 6);
    LAS float* bias_lds = (LAS float*)(lds + ATT_BIAS_OFF);
    for (int it = 0;; ++it) {
        int u;
        if (VAR == 0 && G == 256) { u = (it < 16) ? ((it * 8 + (vcu >> 5)) * 32 + (vcu & 31)) : (4096 + (it - 16) * 256 + vcu); }
        else u = it * G + vcu;
        if (u >= P.nunits) break;
        const bool isctx = u >= 4096;
        int b, hq, hk, qrow, nt; int p_a = 0, p_b = 0;
        if (VAR == 0) {
            if (!isctx) { const int bh = u >> 5, qb = u & 31; b = bh >> 4; hq = bh & 15; qrow = b * SEQ + qb * 256 + 32 * w; nt = 132; }
            else { const int cu = u - 4096; b = cu >> 4; hq = cu & 15; qrow = ML + b * 256 + 32 * w; nt = 4; }
            hk = hq;
        } else if (VAR == 1) {
            if (!isctx) { const int blk = u & 63, hp = (u >> 6) & 7; b = u >> 9; hq = 2 * hp + (w >> 2); hk = hp >> 1; qrow = b * SEQ + blk * 128 + 32 * (w & 3);
                          const int jlo = blk == 0 ? 2 : 0, jhi = blk == 63 ? 4 : 6; nt = 4 + jhi - jlo; p_a = blk * 128 - 128 + 64 * jlo; p_b = blk * 128 + 32 * (w & 3); }
            else { const int cu = u - 4096, half = cu & 1, hp = (cu >> 1) & 7; b = cu >> 4; hq = 2 * hp + (w >> 2); hk = hp >> 1; qrow = ML + b * 256 + half * 128 + 32 * (w & 3); nt = 4; }
        } else {
            if (!isctx) { const int rq = u & 31; hq = (u >> 5) & 15; b = u >> 9; const int r0 = 4 * rq; qrow = b * SEQ + (r0 + (w >> 1)) * 64 + 32 * (w & 1);
                          int lo = r0 - 4; lo = lo < 0 ? 0 : (lo > 120 ? 120 : lo); int h2 = r0 - 1; h2 = h2 < 0 ? 0 : (h2 > 120 ? 120 : h2); nt = 4 + (h2 + 8 - lo); p_a = lo; p_b = r0 + (w >> 1); }
            else { const int cu = u - 4096; b = cu >> 4; hq = cu & 15; qrow = ML + b * 256 + 32 * w; nt = 4; }
            hk = hq;
        }
        if (VAR == 2 && !isctx) { if (tid < 465) bias_lds[tid] = P.bias[hq * 465 + tid] * LOG2E; }
        bf16x8 qf[ND0];
        { const bf16_t* qp = P.Q + (size_t)(qrow + r32) * QPITCH + hq * QH + hi * 8;
#pragma unroll
          for (int d0 = 0; d0 < ND0; ++d0) qf[d0] = *(const bf16x8*)(qp + d0 * 16); }
        f32x16 o0 = {}, o1 = {};
        const unsigned koff = (unsigned)(((b * KVLEN + (tid >> 3)) * KPITCH + hk * 64 + (tid & 7) * 8) * 2);
        const unsigned peoff = (unsigned)(((b * KVLEN + (tid >> 2)) * 32 + (tid & 3) * 8) * 2);
        const unsigned voff = (unsigned)(((b * VCOLS + hk * 64 + (tid >> 3)) * KVLEN + (tid & 7) * 8) * 2);
        u32x4 kreg, pereg = {}, vreg;
#define TILE_KPOS(t) (VAR == 0 ? 64 * (((t) + rot >= nt) ? (t) + rot - nt : (t) + rot) : ((t) < 4 ? 64 * (t) : (VAR == 1 ? 256 + p_a + 64 * ((t) - 4) : 256 + 64 * (p_a + (t) - 4))))
#define LOADK(t) do { const int kp_ = TILE_KPOS(t); kreg = *(const u32x4*)((const char*)P.K + (size_t)(koff + (unsigned)(kp_ * KPITCH * 2))); if (VAR == 0 && tid < 256) pereg = *(const u32x4*)((const char*)P.KPE + (size_t)(peoff + (unsigned)(kp_ * 64))); } while (0)
#define LOADV(t) do { const int kp_ = TILE_KPOS(t); vreg = *(const u32x4*)((const char*)P.VT + (size_t)(voff + (unsigned)(kp_ * 2))); } while (0)
#define STOREK(buf) do { LAS unsigned char* kb_ = lds + (buf) * ABUF; *(LAS u32x4*)(kb_ + (tid >> 3) * KP + (tid & 7) * 16) = kreg; \
        if (VAR == 0 && tid < 256) *(LAS u32x4*)(kb_ + (tid >> 2) * KP + 128 + (tid & 3) * 16) = pereg; } while (0)
#define STOREV(buf) do { *(LAS u32x4*)(lds + (buf) * ABUF + KT_BYTES + (tid >> 3) * VP + (tid & 7) * 16) = vreg; } while (0)
#define NEED(t) (((t) < 4) ? true : (VAR == 1 ? ((p_a + 64 * ((t) - 4) + 63 >= p_b - 128) && (p_a + 64 * ((t) - 4) <= p_b + 31 + 128)) : (VAR == 2 ? ((p_a + (t) - 4 >= na_rs) && (p_a + (t) - 4 < na_rs + 8)) : true)))
#define QK_TILE(P0, P1, buf, CINIT) do { const LAS unsigned char* kt_ = lds + (buf) * ABUF; P0 = (CINIT); P1 = (CINIT); \
        _Pragma("unroll") for (int d0 = 0; d0 < ND0; ++d0) { \
            const bf16x8 k0_ = *(const LAS bf16x8*)(kt_ + r32 * KP + d0 * 32 + hi * 16); const bf16x8 k1_ = *(const LAS bf16x8*)(kt_ + (32 + r32) * KP + d0 * 32 + hi * 16); \
            P0 = __builtin_amdgcn_mfma_f32_32x32x16_bf16(k0_, qf[d0], P0, 0, 0, 0); P1 = __builtin_amdgcn_mfma_f32_32x32x16_bf16(k1_, qf[d0], P1, 0, 0, 0); } } while (0)
#define MASK_TILE(P0, P1, t) do { \
        if (VAR == 1 && (t) >= 4) { const int d0_ = p_a + 64 * ((t) - 4) - (p_b + r32) + 4 * hi + 128; \
            _Pragma("unroll") for (int r = 0; r < 16; ++r) { const int dd = d0_ + (r & 3) + 8 * (r >> 2); if ((unsigned)dd > 256u) P0[r] = -1e30f; if ((unsigned)(dd + 32) > 256u) P1[r] = -1e30f; } } \
        if (VAR == 2 && (t) >= 4) { int c = (qrow & 63) + r32; asm volatile("" : "+v"(c)); const int kr = p_a + (t) - 4; int cs = c - 8; cs = cs < 0 ? 0 : (cs > 48 ? 48 : cs); const LAS float* brow = bias_lds + (kr - p_b + 7) * 31; \
            _Pragma("unroll") for (int r = 0; r < 16; ++r) { const int kc = 4 * hi + (r & 3) + 8 * (r >> 2); \
                { int bi = kc - c + 15; bi = bi < 0 ? 0 : (bi > 30 ? 30 : bi); P0[r] = ((unsigned)(kc - cs) < 16u) ? P0[r] + brow[bi] : -1e30f; } \
                { int bi = kc + 32 - c + 15; bi = bi < 0 ? 0 : (bi > 30 ? 30 : bi); P1[r] = ((unsigned)(kc + 32 - cs) < 16u) ? P1[r] + brow[bi] : -1e30f; } } } } while (0)
        const int rot = (VAR == 0 && !isctx) ? ((vcu & 31) * 4 + (vcu >> 5)) % 132 : 0;
        int na_rs = 0; if (VAR == 2) { na_rs = p_b - 4; na_rs = na_rs < 0 ? 0 : (na_rs > 120 ? 120 : na_rs); }
        LOADK(0); LOADV(0); STOREK(0); STOREV(0);
        if (nt > 1) { LOADK(1); STOREK(1); }
        __syncthreads();
        f32x16 pc0, pc1; const f32x16 zero16 = {};
        QK_TILE(pc0, pc1, 0, zero16);
        float mref = rowmax32(pc0, pc1), lrun = 0.f;
        if (VAR == 1) { const float sk = P.sink[hq] * LOG2E; mref = __builtin_fmaxf(mref, sk); lrun = (hi == 0) ? __builtin_amdgcn_exp2f(sk - mref) : 0.f; }
        f32x16 negm = {};
        if (USE_NEGM) {
#pragma unroll
            for (int r = 0; r < 16; ++r) { pc0[r] -= mref; pc1[r] -= mref; negm[r] = -mref; }
        }
        float rmc = 0.f;
        bool need_c = true;
        __syncthreads();
        for (int t = 0; t < nt; ++t) {
            const bool hn = (t + 1 < nt);
            if (hn) { const int t2 = (t + 2 < nt) ? t + 2 : nt - 1; LOADK(t2); LOADV(t + 1); }
            const bool need_n = hn && NEED(t + 1);
            if (need_c && __any(rmc > THR)) {
                const float dl = __builtin_fmaxf(rmc, 0.f), f = __builtin_amdgcn_exp2f(-dl);
                mref += dl; lrun *= f;
#pragma unroll
                for (int r = 0; r < 16; ++r) { if (USE_NEGM) { pc0[r] -= dl; pc1[r] -= dl; negm[r] = -mref; } o0[r] *= f; o1[r] *= f; }
            }
            f32x16 pn0 = {}, pn1 = {};
            float rmn = -1e30f;
            if (VAR != 2 && need_c && need_n) {
                const LAS unsigned char* kt_ = lds + ((t + 1) & 1) * ABUF; const LAS unsigned char* vt_ = lds + (t & 1) * ABUF + KT_BYTES;
                bf16x8 kf[2 * ND0], vf[8]; u32x4 w0, w1, w2, w3; float sacc = 0.f;
#define KRD(d0) do { kf[2 * (d0)] = *(const LAS bf16x8*)(kt_ + r32 * KP + (d0) * 32 + hi * 16); kf[2 * (d0) + 1] = *(const LAS bf16x8*)(kt_ + (32 + r32) * KP + (d0) * 32 + hi * 16); } while (0)
#define VRD(kk) do { vf[2 * (kk)] = *(const LAS bf16x8*)(vt_ + r32 * VP + (kk) * 32 + hi * 16); vf[2 * (kk) + 1] = *(const LAS bf16x8*)(vt_ + (32 + r32) * VP + (kk) * 32 + hi * 16); } while (0)
#define EX4(Pv, a, W, lo) do { if (!USE_NEGM) { Pv[a] -= mref; Pv[a + 1] -= mref; Pv[a + 2] -= mref; Pv[a + 3] -= mref; } Pv[a] = __builtin_amdgcn_exp2f(Pv[a]); Pv[a + 1] = __builtin_amdgcn_exp2f(Pv[a + 1]); Pv[a + 2] = __builtin_amdgcn_exp2f(Pv[a + 2]); Pv[a + 3] = __builtin_amdgcn_exp2f(Pv[a + 3]); \
        sacc += Pv[a]; sacc += Pv[a + 1]; sacc += Pv[a + 2]; sacc += Pv[a + 3]; if (lo) { W.x = cvtpk(Pv[a], Pv[a + 1]); W.y = cvtpk(Pv[a + 2], Pv[a + 3]); } else { W.z = cvtpk(Pv[a], Pv[a + 1]); W.w = cvtpk(Pv[a + 2], Pv[a + 3]); } } while (0)
#define SB() __builtin_amdgcn_sched_barrier(0)
#define QKP(d0, C0, C1) do { pn0 = __builtin_amdgcn_mfma_f32_32x32x16_bf16(kf[2 * (d0)], qf[d0], C0, 0, 0, 0); pn1 = __builtin_amdgcn_mfma_f32_32x32x16_bf16(kf[2 * (d0) + 1], qf[d0], C1, 0, 0, 0); } while (0)
#define PVP(kk, W) do { const bf16x8 pb_ = __builtin_bit_cast(bf16x8, W); o0 = __builtin_amdgcn_mfma_f32_32x32x16_bf16(vf[2 * (kk)], pb_, o0, 0, 0, 0); o1 = __builtin_amdgcn_mfma_f32_32x32x16_bf16(vf[2 * (kk) + 1], pb_, o1, 0, 0, 0); } while (0)
#define KR1(j) (kf[j] = *(const LAS bf16x8*)(kt_ + (32 * ((j) & 1) + r32) * KP + ((j) >> 1) * 32 + hi * 16))
#define VR1(i) (vf[i] = *(const LAS bf16x8*)(vt_ + (32 * ((i) & 1) + r32) * VP + ((i) >> 1) * 32 + hi * 16))
#define EX2(Pv, a, Wd) do { Pv[a] = __builtin_amdgcn_exp2f(Pv[a]); Pv[a + 1] = __builtin_amdgcn_exp2f(Pv[a + 1]); sacc += Pv[a]; sacc += Pv[a + 1]; Wd = cvtpk(Pv[a], Pv[a + 1]); } while (0)
#define QK1(j, C) do { if ((j) & 1) pn1 = __builtin_amdgcn_mfma_f32_32x32x16_bf16(kf[j], qf[(j) >> 1], C, 0, 0, 0); else pn0 = __builtin_amdgcn_mfma_f32_32x32x16_bf16(kf[j], qf[(j) >> 1], C, 0, 0, 0); } while (0)
#define PV1(i, W) do { const bf16x8 pb_ = __builtin_bit_cast(bf16x8, W); if ((i) & 1) o1 = __builtin_amdgcn_mfma_f32_32x32x16_bf16(vf[i], pb_, o1, 0, 0, 0); else o0 = __builtin_amdgcn_mfma_f32_32x32x16_bf16(vf[i], pb_, o0, 0, 0, 0); } while (0)
                if (ND0 == 6) {
                    KR1(0); KR1(1); KR1(2); KR1(3); SB();
                    QK1(0, negm); EX2(pc0, 0, w0.x); KR1(4); SB();
                    QK1(1, negm); EX2(pc0, 2, w0.y); KR1(5); SB();
                    QK1(2, pn0); EX2(pc0, 4, w0.z); KR1(6); SB();
                    QK1(3, pn1); EX2(pc0, 6, w0.w); KR1(7); SB();
                    QK1(4, pn0); EX2(pc0, 8, w1.x); KR1(8); SB();
                    QK1(5, pn1); EX2(pc0, 10, w1.y); KR1(9); SB();
                    QK1(6, pn0); EX2(pc0, 12, w1.z); KR1(10); SB();
                    QK1(7, pn1); EX2(pc0, 14, w1.w); KR1(11); SB();
                    QK1(8, pn0); EX2(pc1, 0, w2.x); VR1(0); SB();
                    QK1(9, pn1); EX2(pc1, 2, w2.y); VR1(1); SB();
                    QK1(10, pn0); EX2(pc1, 4, w2.z); VR1(2); SB();
                    QK1(11, pn1); EX2(pc1, 6, w2.w); VR1(3); SB();
                } else {
                    KR1(0); KR1(1); KR1(2); KR1(3); SB();
                    QK1(0, negm); EX2(pc0, 0, w0.x); EX2(pc0, 2, w0.y); KR1(4); SB();
                    QK1(1, negm); EX2(pc0, 4, w0.z); EX2(pc0, 6, w0.w); KR1(5); SB();
                    QK1(2, pn0); EX2(pc0, 8, w1.x); EX2(pc0, 10, w1.y); KR1(6); SB();
                    QK1(3, pn1); EX2(pc0, 12, w1.z); EX2(pc0, 14, w1.w); KR1(7); SB();
                    QK1(4, pn0); EX2(pc1, 0, w2.x); VR1(0); SB();
                    QK1(5, pn1); EX2(pc1, 2, w2.y); VR1(1); SB();
                    QK1(6, pn0); EX2(pc1, 4, w2.z); VR1(2); SB();
                    QK1(7, pn1); EX2(pc1, 6, w2.w); VR1(3); SB();
                }
                PV1(0, w0); EX2(pc1, 8, w3.x); VR1(4); SB();
                PV1(1, w0); EX2(pc1, 10, w3.y); VR1(5); SB();
                PV1(2, w1); EX2(pc1, 12, w3.z); VR1(6); SB();
                PV1(3, w1); EX2(pc1, 14, w3.w); VR1(7); SB();
                lrun += sacc;
                PV1(4, w2); MASK_TILE(pn0, pn1, t + 1); SB();
                PV1(5, w2); SB();
                PV1(6, w3); SB();
                PV1(7, w3); rmn = rowmax32(pn0, pn1); if (!USE_NEGM) rmn -= mref; SB();
#undef KR1
#undef VR1
#undef EX2
#undef QK1
#undef PV1
#undef KRD
#undef VRD
#undef EX4
#undef SB
#undef QKP
#undef PVP
            } else {
            if (need_n) QK_TILE(pn0, pn1, (t + 1) & 1, negm);
            if (need_c) {
                float sum = 0.f;
#pragma unroll
                for (int r = 0; r < 16; ++r) { if (!USE_NEGM) { pc0[r] -= mref; pc1[r] -= mref; } pc0[r] = __builtin_amdgcn_exp2f(pc0[r]); pc1[r] = __builtin_amdgcn_exp2f(pc1[r]); sum += pc0[r]; sum += pc1[r]; }
                lrun += sum;
                bf16x8 pk[4];
                { u32x4 a; a.x = cvtpk(pc0[0], pc0[1]); a.y = cvtpk(pc0[2], pc0[3]); a.z = cvtpk(pc0[4], pc0[5]); a.w = cvtpk(pc0[6], pc0[7]); pk[0] = __builtin_bit_cast(bf16x8, a); }
                { u32x4 a; a.x = cvtpk(pc0[8], pc0[9]); a.y = cvtpk(pc0[10], pc0[11]); a.z = cvtpk(pc0[12], pc0[13]); a.w = cvtpk(pc0[14], pc0[15]); pk[1] = __builtin_bit_cast(bf16x8, a); }
                { u32x4 a; a.x = cvtpk(pc1[0], pc1[1]); a.y = cvtpk(pc1[2], pc1[3]); a.z = cvtpk(pc1[4], pc1[5]); a.w = cvtpk(pc1[6], pc1[7]); pk[2] = __builtin_bit_cast(bf16x8, a); }
                { u32x4 a; a.x = cvtpk(pc1[8], pc1[9]); a.y = cvtpk(pc1[10], pc1[11]); a.z = cvtpk(pc1[12], pc1[13]); a.w = cvtpk(pc1[14], pc1[15]); pk[3] = __builtin_bit_cast(bf16x8, a); }
                const LAS unsigned char* vt = lds + (t & 1) * ABUF + KT_BYTES;
#pragma unroll
                for (int kk = 0; kk < 4; ++kk) {
                    const bf16x8 v0 = *(const LAS bf16x8*)(vt + r32 * VP + kk * 32 + hi * 16);
                    const bf16x8 v1 = *(const LAS bf16x8*)(vt + (32 + r32) * VP + kk * 32 + hi * 16);
                    o0 = __builtin_amdgcn_mfma_f32_32x32x16_bf16(v0, pk[kk], o0, 0, 0, 0);
                    o1 = __builtin_amdgcn_mfma_f32_32x32x16_bf16(v1, pk[kk], o1, 0, 0, 0);
                }
            }
            if (need_n) { MASK_TILE(pn0, pn1, t + 1); rmn = rowmax32(pn0, pn1); if (!USE_NEGM) rmn -= mref; }
            }
            if (hn) { STOREK(t & 1); STOREV((t + 1) & 1); }
            __syncthreads();
            pc0 = pn0; pc1 = pn1; rmc = rmn; need_c = need_n;
        }
#undef TILE_KPOS
#undef LOADK
#undef LOADV
#undef STOREK
#undef STOREV
#undef NEED
#undef QK_TILE
#undef MASK_TILE
        const float lt = lrun + shfl_xor_l(lrun, 32, lane), inv = 1.f / lt;
        LAS unsigned char* stg = lds + ATT_OSTAGE_OFF + w * (32 * 144);
#pragma unroll
        for (int g = 0; g < 4; ++g) {
            u32x2 a; a.x = cvtpk(o0[4 * g] * inv, o0[4 * g + 1] * inv); a.y = cvtpk(o0[4 * g + 2] * inv, o0[4 * g + 3] * inv); *(LAS u32x2*)(stg + r32 * 144 + (8 * g + 4 * hi) * 2) = a;
            u32x2 c; c.x = cvtpk(o1[4 * g] * inv, o1[4 * g + 1] * inv); c.y = cvtpk(o1[4 * g + 2] * inv, o1[4 * g + 3] * inv); *(LAS u32x2*)(stg + r32 * 144 + (32 + 8 * g + 4 * hi) * 2) = c;
        }
        asm volatile("s_waitcnt lgkmcnt(0)" ::: "memory");
        { bf16_t* ob = P.O + (size_t)(qrow + (lane >> 3)) * DM + hq * 64 + (lane & 7) * 8;
#pragma unroll
          for (int i = 0; i < 4; ++i) { const u32x4 v = *(const LAS u32x4*)(stg + (i * 8 + (lane >> 3)) * 144 + (lane & 7) * 16); *(u32x4*)(ob + (size_t)i * 8 * DM) = v; } }
    }
}

constexpr size_t MiB = 1u << 20;
constexpr size_t WS_BAR = 983040  ;
constexpr size_t WS_MOD = 0, WS_SSQ = 1 * MiB, WS_ROPE16 = 3 * MiB, WS_ROPE32 = 4 * MiB, WS_KPE = 6 * MiB, WS_XC = 12 * MiB;
constexpr size_t WS_W1T = 20 * MiB, WS_W2T = 52 * MiB, WS_MLA = 84 * MiB  , WS_SWA = 94 * MiB  , WS_NA = 99 * MiB  ;
constexpr size_t WS_H = 108 * MiB, WS_Q = 240 * MiB, WS_K = 438 * MiB, WS_VT = 570 * MiB, WS_O = 702 * MiB, WS_LAT = 702 * MiB, WS_HID = 240 * MiB, WS_NBIAS = 834 * MiB  , WS_SSQN = 836 * MiB  , WS_PART_O = 240 * MiB  , WS_PART_M = 768 * MiB  ,
    WS_XH = 840 * MiB  , WS_END = 968 * MiB;

#define XB_TMO      128
#define XB_XCNT(j)  (256  + 64 * (j))
#define XB_XSUB(j)  (1280 + 64 * (j))
#define XB_XGEN(j)  (2304 + 64 * (j))
#define XB_TOP      3328
#define XB_TOPGEN   3392
#define XCD_BAR_WORDS 3456
#define XB_SPIN_CAP (1u << 18)
__device__ __forceinline__ unsigned xb_ld(unsigned* p)              { return __hip_atomic_load(p, __ATOMIC_RELAXED, __HIP_MEMORY_SCOPE_AGENT); }
__device__ __forceinline__ unsigned xb_add(unsigned* p, unsigned v) { return __hip_atomic_fetch_add(p, v, __ATOMIC_RELAXED, __HIP_MEMORY_SCOPE_AGENT); }
__device__ __forceinline__ unsigned xb_xcc_id() { return (unsigned)__builtin_amdgcn_s_getreg((3 << 11) | 20) & 0xFu; }
#define XB_SPIN(cond, bar) do { unsigned _sp = 0; while (cond) { __builtin_amdgcn_s_sleep(1); \
    if ((++_sp & 255u) == 0u) { if (xb_ld(&(bar)[XB_TMO])) break; if (_sp > XB_SPIN_CAP) { atomicAdd(&(bar)[XB_TMO], 1u); break; } } } } while (0)
struct XcdBarrier { unsigned* bar; unsigned x; volatile LAS unsigned* st; };
__device__ __forceinline__ XcdBarrier xcd_barrier_post(unsigned* bar, volatile LAS unsigned* st, bool t0) {
    XcdBarrier b; b.bar = bar; b.x = xb_xcc_id(); b.st = st;
    if (t0) (void)xb_add(&bar[XB_XCNT(b.x)], 1u);
    return b;
}
__device__ __forceinline__ void xcd_barrier_complete(unsigned* bar, unsigned x, unsigned& nloc, unsigned& nx) {
    const unsigned G = gridDim.x * gridDim.y * gridDim.z;
    unsigned sum, cnt, mine, sp = 0u;
    for (;;) {
        sum = 0u; cnt = 0u; mine = 0u;
#pragma unroll
        for (unsigned j = 0; j < 16; ++j) { const unsigned c = xb_ld(&bar[XB_XCNT(j)]); sum += c; cnt += (c > 0u) ? 1u : 0u; mine = (j == x) ? c : mine; }
        if (sum == G) break;
        __builtin_amdgcn_s_sleep(1);
        if ((++sp & 255u) == 0u) { if (xb_ld(&bar[XB_TMO])) break; if (sp > XB_SPIN_CAP) { atomicAdd(&bar[XB_TMO], 1u); break; } }
    }
    nloc = mine > 0u ? mine : 1u; nx = cnt > 0u ? cnt : 1u;
}
__device__ __forceinline__ void xcd_barrier(const XcdBarrier& b, bool t0) {
    asm volatile("s_waitcnt vmcnt(0)" ::: "memory");
    __syncthreads();
    if (t0) {
        unsigned* bar = b.bar; unsigned bx = b.x; asm volatile("" : "+s"(bar), "+s"(bx));
        __builtin_amdgcn_s_waitcnt(0);
        unsigned nloc = b.st[0], nx = b.st[1];
        if (nloc == 0u) { xcd_barrier_complete(bar, bx, nloc, nx); b.st[0] = nloc; b.st[1] = nx; }
        const unsigned old = xb_add(&bar[XB_XSUB(bx)], 1u);
        const unsigned gen = old / nloc;
        if (old + 1u == (gen + 1u) * nloc) {
            __builtin_amdgcn_fence(__ATOMIC_RELEASE, "agent");
            asm volatile("s_waitcnt vmcnt(0)" ::: "memory");
            const unsigned og = xb_add(&bar[XB_TOP], 1u);
            const unsigned tg = og / nx;
            if (og + 1u == (tg + 1u) * nx) xb_add(&bar[XB_TOPGEN], 1u);
            else XB_SPIN(xb_ld(&bar[XB_TOPGEN]) == tg, bar);
            __builtin_amdgcn_fence(__ATOMIC_ACQUIRE, "agent");
            xb_add(&bar[XB_XGEN(bx)], 1u);
            asm volatile("s_waitcnt vmcnt(0)" ::: "memory");
        } else {
            XB_SPIN(xb_ld(&bar[XB_XGEN(bx)]) == gen, bar);
            __builtin_amdgcn_fence(__ATOMIC_ACQUIRE, "agent");
            asm volatile("s_waitcnt vmcnt(0)" ::: "memory");
        }
    }
    __syncthreads();
}

__device__ __forceinline__ float wave_sum(float v, int lane) {
#pragma unroll
    for (int o = 1; o < 64; o <<= 1) v += shfl_xor_l(v, o, lane);
    return v;
}
__device__ __forceinline__ void sincos_red(float x, float& sn, float& cs) {
    const float n = rintf(x * 0.15915494309189535f);
    float r = fmaf(-n, 6.2831854820251465f, x); r = fmaf(-n, -1.7484555e-7f, r);
    const float rev = r * 0.15915494309189535f;
    sn = __builtin_amdgcn_sinf(rev); cs = __builtin_amdgcn_cosf(rev);
}
__device__ __forceinline__ void transpose_item(const float* W, int K, int N, bf16_t* WT, const float* g, LAS float* scr, int item, int lane) {
    const int nblk = N / 32, kb = item / nblk, nb = item % nblk, k0 = 64 * kb, n0 = 32 * nb;
#pragma unroll 8
    for (int i = 0; i < 32; ++i) { const int kk = 2 * i + (lane >> 5); float v = W[(size_t)(k0 + kk) * N + n0 + (lane & 31)]; if (g) v *= g[k0 + kk]; scr[kk * 33 + (lane & 31)] = v; }
    asm volatile("s_waitcnt lgkmcnt(0)" ::: "memory");
    const int c = lane & 7;
#pragma unroll
    for (int j = 0; j < 4; ++j) { const int n = (lane >> 3) + 8 * j; const LAS float* s = scr + (8 * c) * 33 + n;
        u32x4 o; o.x = cvtpk(s[0 * 33], s[1 * 33]); o.y = cvtpk(s[2 * 33], s[3 * 33]); o.z = cvtpk(s[4 * 33], s[5 * 33]); o.w = cvtpk(s[6 * 33], s[7 * 33]);
        *(u32x4*)(WT + (size_t)(n0 + n) * K + k0 + 8 * c) = o; }
    asm volatile("s_waitcnt lgkmcnt(0)" ::: "memory");
}

struct Args { const float* in[23]; float* out; unsigned char* ws; };

__device__ __forceinline__ void norm_pass0(const float* xl, const float* xc, const float* g, const float* mod, int sc_off, bf16_t* H, float* ssq, int gw, int NGW) {
    int lane = lane_id(); asm volatile("" : "+v"(lane));
    for (int row = gw; row < MT; row += NGW) {
        const bool isctx = row >= ML;
        const float* xr = isctx ? xc + (size_t)(row - ML) * DM : xl + (size_t)row * DM;
        const float* mp = mod + (isctx ? 8 : (row >> 13)) * 6144;
        f32x4 v[4]; float ss = 0.f;
#pragma unroll
        for (int j = 0; j < 4; ++j) { v[j] = *(const f32x4*)(xr + 4 * lane + 256 * j); ss += (v[j][0] * v[j][0] + v[j][1] * v[j][1]) + (v[j][2] * v[j][2] + v[j][3] * v[j][3]); }
        ss = wave_sum(ss, lane);
        if (lane == 0) ssq[row] = ss;
#pragma unroll
        for (int j = 0; j < 4; ++j) { const int col = 4 * lane + 256 * j;
            const f32x4 gg = *(const f32x4*)(g + col), sc = *(const f32x4*)(mp + sc_off + col);
            const f32x4 y = v[j] * gg * (sc + 1.f);
            u32x2 o; o.x = cvtpk(y[0], y[1]); o.y = cvtpk(y[2], y[3]); *(u32x2*)(H + (size_t)row * DM + col) = o; }
    }
}
__device__ __forceinline__ void norm_ctx(float* xc, const float* part, const float* gate8, const float* g, const float* sc, bf16_t* Hc, float* ssqc, int gw, int NGW) {
    int lane = lane_id(); asm volatile("" : "+v"(lane));
    for (int row = gw; row < MC; row += NGW) {
        float* xr = xc + (size_t)row * DM;
        f32x4 v[4]; float ss = 0.f;
#pragma unroll
        for (int j = 0; j < 4; ++j) { const int col = 4 * lane + 256 * j;
            f32x4 p = *(const f32x4*)(part + (size_t)row * DM + col);
#pragma unroll
            for (int kc = 1; kc < 8; ++kc) p += *(const f32x4*)(part + ((size_t)kc * MC + row) * DM + col);
            v[j] = *(const f32x4*)(xr + col) + *(const f32x4*)(gate8 + col) * p;
            *(f32x4*)(xr + col) = v[j];
            ss += (v[j][0] * v[j][0] + v[j][1] * v[j][1]) + (v[j][2] * v[j][2] + v[j][3] * v[j][3]); }
        ss = wave_sum(ss, lane);
        if (lane == 0) ssqc[row] = ss;
#pragma unroll
        for (int j = 0; j < 4; ++j) { const int col = 4 * lane + 256 * j;
            const f32x4 gg = *(const f32x4*)(g + col), s4 = *(const f32x4*)(sc + col);
            const f32x4 y = v[j] * gg * (s4 + 1.f);
            u32x2 o; o.x = cvtpk(y[0], y[1]); o.y = cvtpk(y[2], y[3]); *(u32x2*)(Hc + (size_t)row * DM + col) = o; }
    }
}
__device__ __forceinline__ void nbias_item(LAS unsigned char* lds, const float* W, int N, int n0, const float* mod, int sh_off, float* out, int wave, int lane) {
    LAS float* shl = (LAS float*)(lds + 65536); LAS float* red = (LAS float*)(lds + 102400);
    const int tid = wave * 64 + lane;
    for (int i = tid; i < 9 * 1024; i += 512) shl[i] = mod[(i >> 10) * 6144 + sh_off + (i & 1023)];
    __syncthreads();
    const int n = n0 + lane; const bool ok = n < N;
    const float* Wp = W + (ok ? n : 0);
    float s0 = 0, s1 = 0, s2 = 0, s3 = 0, s4 = 0, s5 = 0, s6 = 0, s7 = 0, s8 = 0;
#pragma unroll 8
    for (int k = wave * 128; k < wave * 128 + 128; ++k) { const float wv = Wp[(size_t)k * N];
        s0 += shl[k] * wv; s1 += shl[1024 + k] * wv; s2 += shl[2048 + k] * wv; s3 += shl[3072 + k] * wv; s4 += shl[4096 + k] * wv;
        s5 += shl[5120 + k] * wv; s6 += shl[6144 + k] * wv; s7 += shl[7168 + k] * wv; s8 += shl[8192 + k] * wv; }
    LAS float* rp = red + wave * 576 + lane;
    rp[0] = s0; rp[64] = s1; rp[128] = s2; rp[192] = s3; rp[256] = s4; rp[320] = s5; rp[384] = s6; rp[448] = s7; rp[512] = s8;
    __syncthreads();
    for (int i = tid; i < 576; i += 512) { float sum = 0.f;
#pragma unroll
        for (int ww = 0; ww < 8; ++ww) sum += red[ww * 576 + i];
        const int b = i >> 6, l = i & 63; if (n0 + l < N) out[b * 4096 + n0 + l] = sum; else if (n0 + l < 4096) out[b * 4096 + n0 + l] = 0.f; }
    __syncthreads();
}

__global__ void __launch_bounds__(512, 2) fwd_megakernel(Args a) {
    extern __shared__ __attribute__((aligned(16))) unsigned char lds_raw[];
    LAS unsigned char* lds = (LAS unsigned char*)lds_raw;
    cg::grid_group grid = cg::this_grid();
    const int wave = __builtin_amdgcn_readfirstlane((int)threadIdx.x >> 6);
    const int G = gridDim.x, bid = blockIdx.x;
    const int vcu = (G % 8 == 0) ? (bid % 8) * (G / 8) + bid / 8 : bid;
    const int gw = vcu * 8 + wave, NGW = G * 8;
    unsigned char* ws = a.ws;
    volatile LAS unsigned* bar_st = (volatile LAS unsigned*)(lds + 131072 + 64);
    if (wave == 0 && lane_id() < 2) bar_st[lane_id()] = 0u;
    __syncthreads();
    XcdBarrier xbar = xcd_barrier_post((unsigned*)(ws + WS_BAR), bar_st, wave == 0 && lane_id() == 0);
#define GRID_BAR() xcd_barrier(xbar, wave == 0 && lane_id() == 0)
    const float* x_in = a.in[0]; const float* c_in = a.in[1]; const float* ctx_in = a.in[2]; const float* cctx_in = a.in[3];
    const float* ada_w = a.in[4]; const float* ada_b = a.in[5]; const float* norm_mix_g = a.in[6]; const float* norm_mlp_g = a.in[7]; const float* norm_out_g = a.in[8];
    float* MOD = (float*)(ws + WS_MOD); float* SSQ = (float*)(ws + WS_SSQ);
    float* ROPE16 = (float*)(ws + WS_ROPE16); float* ROPE32 = (float*)(ws + WS_ROPE32);
    bf16_t* KPE = (bf16_t*)(ws + WS_KPE); float* XC = (float*)(ws + WS_XC);
    bf16_t* H = (bf16_t*)(ws + WS_H); bf16_t* Qb = (bf16_t*)(ws + WS_Q); bf16_t* Kb = (bf16_t*)(ws + WS_K); bf16_t* VTb = (bf16_t*)(ws + WS_VT);
    bf16_t* Ob = (bf16_t*)(ws + WS_O); bf16_t* LAT = (bf16_t*)(ws + WS_LAT); bf16_t* HID = (bf16_t*)(ws + WS_HID);
    _Float16* Xh = (_Float16*)(ws + WS_XH);
    float* NBIAS = (float*)(ws + WS_NBIAS); float* SSQN = (float*)(ws + WS_SSQN); float* PART_O = (float*)(ws + WS_PART_O); float* PART_M = (float*)(ws + WS_PART_M);

    {
        const int lane = lane_id(), tid = wave * 64 + lane;
        LAS float* act = (LAS float*)(lds + 65536); LAS float* red = (LAS float*)(lds + 102400);
        for (int i = tid; i < 9 * 1024; i += 512) { const int b = i >> 10, k = i & 1023; const float v = b < 8 ? c_in[b * 1024 + k] : cctx_in[k]; act[i] = v / (1.f + __builtin_amdgcn_exp2f(-v * LOG2E)); }
        __syncthreads();
        for (int it = bid; it < 384; it += G) {
            const int layer = it / 96, n0 = (it % 96) * 64;
            const float* W = ada_w + (size_t)layer * 1024 * 6144 + n0 + lane;
            float s0 = 0, s1 = 0, s2 = 0, s3 = 0, s4 = 0, s5 = 0, s6 = 0, s7 = 0, s8 = 0;
#pragma unroll 8
            for (int k = wave * 128; k < wave * 128 + 128; ++k) { const float wv = W[(size_t)k * 6144];
                s0 += act[k] * wv; s1 += act[1024 + k] * wv; s2 += act[2048 + k] * wv; s3 += act[3072 + k] * wv; s4 += act[4096 + k] * wv;
                s5 += act[5120 + k] * wv; s6 += act[6144 + k] * wv; s7 += act[7168 + k] * wv; s8 += act[8192 + k] * wv; }
            LAS float* rp = red + wave * 576 + lane;
            rp[0] = s0; rp[64] = s1; rp[128] = s2; rp[192] = s3; rp[256] = s4; rp[320] = s5; rp[384] = s6; rp[448] = s7; rp[512] = s8;
            __syncthreads();
            for (int i = tid; i < 576; i += 512) { float s = 0.f;
#pragma unroll
                for (int ww = 0; ww < 8; ++ww) s += red[ww * 576 + i];
                const int b = i >> 6, l = i & 63; MOD[((size_t)layer * 9 + b) * 6144 + n0 + l] = s + ada_b[layer * 6144 + n0 + l]; }
            __syncthreads();
        }
        __syncthreads();
        LAS float* scr = (LAS float*)(lds + wave * 16384);
        int base = 0;
#define TR(Wsrc, K_, N_, dst, gsc) do { const int n_ = ((K_) / 64) * ((N_) / 32); \
            for (int it_ = (gw + NGW - (base % NGW)) % NGW; it_ < n_; it_ += NGW) transpose_item((Wsrc), (K_), (N_), (dst), (gsc), scr, it_, lane); base += n_; } while (0)
        for (int L = 0; L < 4; ++L) {
            TR(a.in[9] + (size_t)L * DM * FF, DM, FF, (bf16_t*)(ws + WS_W1T + (size_t)L * 8 * MiB), (const float*)nullptr);
            TR(a.in[10] + (size_t)L * FF * DM, FF, DM, (bf16_t*)(ws + WS_W2T + (size_t)L * 8 * MiB), (const float*)nullptr);
        }
        for (int j = 0; j < 2; ++j) {
            unsigned char* mb = ws + WS_MLA + (size_t)j * 5 * MiB;
            TR(a.in[11] + (size_t)j * DM * 416, DM, 416, (bf16_t*)mb, (const float*)nullptr);
            TR(a.in[13] + (size_t)j * 256 * 1536, 256, 1536, (bf16_t*)(mb + 1 * MiB), a.in[12] + j * 256);
            TR(a.in[15] + (size_t)j * 128 * 2048, 128, 2048, (bf16_t*)(mb + 1 * MiB + 768 * 1024), a.in[14] + j * 128);
            TR(a.in[16] + (size_t)j * DM * DM, DM, DM, (bf16_t*)(mb + 3 * MiB), (const float*)nullptr);
            u32x4* z = (u32x4*)(mb + (size_t)416 * 1024 * 2);
            for (int i = gw * 64 + lane; i < 96 * 1024 * 2 / 16; i += NGW * 64) z[i] = (u32x4){0u, 0u, 0u, 0u};
        }
        TR(a.in[17], DM, 1536, (bf16_t*)(ws + WS_SWA), (const float*)nullptr);
        TR(a.in[19], DM, DM, (bf16_t*)(ws + WS_SWA + 3 * MiB), (const float*)nullptr);
        TR(a.in[20], DM, 3072, (bf16_t*)(ws + WS_NA), (const float*)nullptr);
        TR(a.in[22], DM, DM, (bf16_t*)(ws + WS_NA + 6 * MiB), (const float*)nullptr);
#undef TR
        for (int i = gw * 64 + lane; i < 8192 * 16; i += NGW * 64) { const int t = i >> 4, p = i & 15; const int f = p & 7; const float pos = (float)(p < 8 ? (t >> 6) : (t & 63));
            const float ang = pos * __builtin_amdgcn_exp2f(-(float)f * (13.287712379549449f / 8.f)); float sn, cs; sincos_red(ang, sn, cs); ROPE16[2 * i] = cs; ROPE16[2 * i + 1] = sn; }
        for (int i = gw * 64 + lane; i < 8192 * 32; i += NGW * 64) { const int t = i >> 5, p = i & 31; const int f = p & 15; const float pos = (float)(p < 16 ? (t >> 6) : (t & 63));
            const float ang = pos * __builtin_amdgcn_exp2f(-(float)f * (13.287712379549449f / 16.f)); float sn, cs; sincos_red(ang, sn, cs); ROPE32[2 * i] = cs; ROPE32[2 * i + 1] = sn; }
        for (int i = gw * 64 + lane; i < 4 * MT; i += NGW * 64) SSQ[i] = 0.f;
        for (int i = gw * 64 + lane; i < 8 * MT; i += NGW * 64) SSQN[i] = 0.f;
    }
    grid.sync();
    {
        const int lane = lane_id();
        for (int it = bid; it < 8 + 24 + 48 + 8 + 256; it += G) {
            int r = it; const float* W; int N, L, which, blk;
            if (r < 8) { W = a.in[11]; N = 416; L = 0; which = 0; blk = r; }
            else if ((r -= 8) < 24) { W = a.in[17]; N = 1536; L = 1; which = 0; blk = r; }
            else if ((r -= 24) < 48) { W = a.in[20]; N = 3072; L = 2; which = 0; blk = r; }
            else if ((r -= 48) < 8) { W = a.in[11] + (size_t)DM * 416; N = 416; L = 3; which = 0; blk = r; }
            else { r -= 8; L = r >> 6; blk = r & 63; W = a.in[9] + (size_t)L * DM * FF; N = FF; which = 1; }
            nbias_item(lds, W, N, blk * 64, MOD + (size_t)L * 9 * 6144, which ? 3072 : 0, NBIAS + (size_t)(L * 2 + which) * 9 * 4096, wave, lane);
        }
        norm_pass0(x_in, ctx_in, norm_mix_g, MOD, 1024, H, SSQN, gw, NGW);
        for (int i = gw * 64 + lane; i < MC * DM / 4; i += NGW * 64) ((f32x4*)XC)[i] = ((const f32x4*)ctx_in)[i];
    }
    GRID_BAR();

    for (int L = 0; L < 4; ++L) {
        const int kind = L % 3, jl = L / 3; const bool last = (L == 3);
        const float* modL = MOD + (size_t)L * 9 * 6144;
        const float* ssqn1 = SSQN + (size_t)(2 * L) * MT; const float* nbias1 = NBIAS + (size_t)(L * 2) * 9 * 4096;
        if (kind == 0) {
            unsigned char* mb = ws + WS_MLA + (size_t)jl * 5 * MiB;
            float* ssq_q = SSQ + (size_t)jl * 2 * MT; float* ssq_kv = ssq_q + MT;
            {
                pg8::Gemm g{H, (const bf16_t*)mb, MT, 512, DM, DM, DM}; pg8::StaticOrder S; S.init(MT, 512, G, bid);
                EpiLat E{LAT, ssq_q, ssq_kv, KPE, ROPE16, ssqn1, nbias1};
                pg8::gemm_phase<EpiLat, pg8::StaticOrder, true>(lds, g, S, E, wave);
            }
            GRID_BAR();
            {
                pg8::Gemm g{LAT, (const bf16_t*)(mb + 1 * MiB), MT, 1536, 256, 512, 256}; pg8::StaticOrder S; S.init(MT, 1536, G, bid);
                EpiProj<0> E{Qb, nullptr, nullptr, ROPE16, ssq_q, 0.10206207261596577f * LOG2E, nullptr};
                pg8::gemm_phase<EpiProj<0>, pg8::StaticOrder, true>(lds, g, S, E, wave);
            }
            {
                pg8::Gemm g{LAT + 256, (const bf16_t*)(mb + 1 * MiB + 768 * 1024), MT, 2048, 128, 512, 128}; pg8::StaticOrder S; S.init(MT, 2048, G, bid);
                EpiProj<1> E{nullptr, Kb, VTb, nullptr, ssq_kv, 1.f, nullptr};
                pg8::gemm_phase<EpiProj<1>, pg8::StaticOrder, true>(lds, g, S, E, wave);
            }
        } else if (kind == 1) {
            pg8::Gemm g{H, (const bf16_t*)(ws + WS_SWA), MT, 1536, DM, DM, DM}; pg8::StaticOrder S; S.init(MT, 1536, G, bid);
            EpiProj<2> E{Qb, Kb, VTb, ROPE32, ssqn1, 0.125f * LOG2E, nbias1};
            pg8::gemm_phase<EpiProj<2>, pg8::StaticOrder, true>(lds, g, S, E, wave);
        } else {
            pg8::Gemm g{H, (const bf16_t*)(ws + WS_NA), MT, 3072, DM, DM, DM}; pg8::StaticOrder S; S.init(MT, 3072, G, bid);
            EpiProj<3> E{Qb, Kb, VTb, nullptr, ssqn1, 0.125f * LOG2E, nbias1};
            pg8::gemm_phase<EpiProj<3>, pg8::StaticOrder, true>(lds, g, S, E, wave);
        }
        GRID_BAR();
        {
            AttnP P{Qb, Kb, KPE, VTb, Ob, a.in[18], a.in[21], last ? 4096 : 4096 + 128};
            if (kind == 0) attn_phase<0>(lds, P, vcu, G, wave);
            else if (kind == 1) attn_phase<1>(lds, P, vcu, G, wave);
            else attn_phase<2>(lds, P, vcu, G, wave);
        }
        GRID_BAR();
        const int Mres = last ? ML : MT;
        {
            const bf16_t* wo = (const bf16_t*)(kind == 0 ? ws + WS_MLA + (size_t)jl * 5 * MiB + 3 * MiB : (kind == 1 ? ws + WS_SWA + 3 * MiB : ws + WS_NA + 6 * MiB));
            {
                pg8::Gemm g{Ob, wo, ML, DM, DM, DM, DM}; pg8::StaticOrder S; S.init(ML, DM, G, bid);
                EpiResid E{L == 0 ? x_in : nullptr, Xh, Xh, modL + 2048, H, norm_mlp_g + L * DM, modL + 4096, SSQN + (size_t)(2 * L + 1) * MT};
                pg8::gemm_phase<EpiResid, pg8::StaticOrder, true>(lds, g, S, E, wave);
            }
            if (!last) {
                pg8::Gemm g{Ob, wo, MT, DM, 128, DM, DM}; pg8::CtxSplitOrder S{bid, G, 128};
                EpiCtxPartial E{PART_O, 128};
                pg8::gemm_phase<EpiCtxPartial, pg8::CtxSplitOrder, true>(lds, g, S, E, wave);
            }
        }
        GRID_BAR();
        if (!last) { norm_ctx(XC, PART_O, modL + 2048 + 8 * 6144, norm_mlp_g + L * DM, modL + 8 * 6144 + 4096, H + (size_t)ML * DM, SSQN + (size_t)(2 * L + 1) * MT + ML, gw, NGW); GRID_BAR(); }
        {
            pg8::Gemm g{H, (const bf16_t*)(ws + WS_W1T + (size_t)L * 8 * MiB), Mres, FF, DM, DM, DM}; pg8::StaticOrder S; S.init(Mres, FF, G, bid);
            EpiSqRelu E{HID, FF, SSQN + (size_t)(2 * L + 1) * MT, NBIAS + (size_t)(L * 2 + 1) * 9 * 4096};
            pg8::gemm_phase<EpiSqRelu, pg8::StaticOrder, true>(lds, g, S, E, wave);
        }
        GRID_BAR();
        {
            const bf16_t* w2t = (const bf16_t*)(ws + WS_W2T + (size_t)L * 8 * MiB);
            {
                pg8::Gemm g{HID, w2t, ML, DM, FF, FF, FF}; pg8::StaticOrder S; S.init(ML, DM, G, bid);
                EpiResid E{nullptr, Xh, Xh, modL + 5120, last ? nullptr : H, norm_mix_g + (L + 1) * DM, MOD + (size_t)(L + 1) * 9 * 6144 + 1024, SSQN + (size_t)(2 * L + 2) * MT};
                pg8::gemm_phase<EpiResid, pg8::StaticOrder, true>(lds, g, S, E, wave);
            }
            if (!last) {
                pg8::Gemm g{HID, w2t, MT, DM, 512, FF, FF}; pg8::CtxSplitOrder S{bid, G, 512};
                EpiCtxPartial E{PART_M, 512};
                pg8::gemm_phase<EpiCtxPartial, pg8::CtxSplitOrder, true>(lds, g, S, E, wave);
            }
        }
        GRID_BAR();
        if (!last) { norm_ctx(XC, PART_M, modL + 5120 + 8 * 6144, norm_mix_g + (L + 1) * DM, MOD + (size_t)(L + 1) * 9 * 6144 + 8 * 6144 + 1024, H + (size_t)ML * DM, SSQN + (size_t)(2 * L + 2) * MT + ML, gw, NGW); GRID_BAR(); }
    }
    int lane = lane_id(); asm volatile("" : "+v"(lane));
    for (int row = gw; row < ML; row += NGW) {
        const _Float16* xh = Xh + (size_t)row * DM; float* xr = a.out + (size_t)row * DM;
        f32x4 v[4]; float ss = 0.f;
#pragma unroll
        for (int j = 0; j < 4; ++j) { v[j] = ld_h4(xh + 4 * lane + 256 * j); ss += (v[j][0] * v[j][0] + v[j][1] * v[j][1]) + (v[j][2] * v[j][2] + v[j][3] * v[j][3]); }
        const float rstd = rsqrtf(wave_sum(ss, lane) * (1.f / DM) + EPS);
#pragma unroll
        for (int j = 0; j < 4; ++j) { const int col = 4 * lane + 256 * j; const f32x4 gg = *(const f32x4*)(norm_out_g + col); *(f32x4*)(xr + col) = v[j] * rstd * gg; }
    }
}

constexpr int LDS_BYTES = 147456;
extern "C" void kernel_launch(void* const* d_in, const int* in_sizes, int n_in, void* d_out, int out_size, void* d_ws, size_t ws_size, hipStream_t stream) {
    static int grid = 0;
    if (grid == 0) {
        if (n_in != 23 || out_size != ML * DM || ws_size < WS_END) { fprintf(stderr, "kernel_launch: unexpected shapes (n_in %d out %d ws %zu)\n", n_in, out_size, ws_size); grid = -1; return; }
        int dev = 0, cus = 0, per_cu = 0;
        hipGetDevice(&dev); hipDeviceGetAttribute(&cus, hipDeviceAttributeMultiprocessorCount, dev);
        if (hipFuncSetAttribute((const void*)fwd_megakernel, hipFuncAttributeMaxDynamicSharedMemorySize, LDS_BYTES) != hipSuccess) { fprintf(stderr, "kernel_launch: hipFuncSetAttribute failed\n"); grid = -1; return; }
        if (hipOccupancyMaxActiveBlocksPerMultiprocessor(&per_cu, (const void*)fwd_megakernel, 512, LDS_BYTES) != hipSuccess || per_cu < 1) { fprintf(stderr, "kernel_launch: occupancy query gave %d\n", per_cu); per_cu = 1; }
        (void)hipGetLastError();
        grid = cus * per_cu;
    }
    if (grid < 0) return;
    if (hipMemsetAsync((char*)d_ws + WS_BAR, 0, XCD_BAR_WORDS * 4, stream) != hipSuccess) { fprintf(stderr, "kernel_launch: memset of the barrier words failed\n"); return; }
    Args a{};
    for (int i = 0; i < 23; ++i) a.in[i] = (const float*)d_in[i];
    a.out = (float*)d_out; a.ws = (unsigned char*)d_ws;
    void* args[] = {&a};
    hipError_t e = hipLaunchCooperativeKernel((const void*)fwd_megakernel, dim3(grid), dim3(512), args, LDS_BYTES, stream);
    if (e != hipSuccess) fprintf(stderr, "cooperative launch failed: %s (grid %d)\n", hipGetErrorString(e), grid);
}
```

```cpp
#include <hip/hip_runtime.h>
#include <hip/hip_cooperative_groups.h>
#include <cstdio>
#include <cstdint>
namespace cg = cooperative_groups;

#define LAS __attribute__((address_space(3)))
typedef unsigned short bf16_t;
typedef short bf16x8 __attribute__((ext_vector_type(8)));
typedef float f32x4 __attribute__((ext_vector_type(4)));
typedef float f32x16 __attribute__((ext_vector_type(16)));
typedef unsigned u32x4 __attribute__((ext_vector_type(4)));
typedef unsigned u32x2 __attribute__((ext_vector_type(2)));

constexpr int NB = 8, SEQ = 8192, DM = 1024, CTX = 256, FF = 4096;
constexpr int ML = NB * SEQ;
constexpr int MC = NB * CTX;
constexpr int MT = ML + MC;
constexpr int KVLEN = CTX + SEQ;
constexpr float EPS = 1e-6f;
constexpr float LOG2E = 1.4426950408889634f;

__device__ __forceinline__ unsigned cvtpk(float lo, float hi) {
    typedef float f2 __attribute__((ext_vector_type(2))); typedef __bf16 b2 __attribute__((ext_vector_type(2)));
    f2 v = {lo, hi}; b2 b = __builtin_convertvector(v, b2); return __builtin_bit_cast(unsigned, b);
}
__device__ __forceinline__ int lane_id() { int l; asm volatile("v_mbcnt_lo_u32_b32 %0, -1, 0\n\tv_mbcnt_hi_u32_b32 %0, -1, %0" : "=v"(l)); return l; }
__device__ __forceinline__ float shfl_xor_l(float v, int mask, int lane) { return __int_as_float(__builtin_amdgcn_ds_bpermute((lane ^ mask) << 2, __float_as_int(v))); }
__device__ __forceinline__ int perm16(int x) { return 8 * ((x >> 2) & 1) + (x & 3) + 4 * (x >> 3); }

namespace pg8 {
constexpr int BM = 256, BK = 64, HALF = 128, HTB = HALF * BK * 2, STAGE_BYTES = 8 * HTB, NXCD = 8, WGM = 8;
__host__ __device__ __forceinline__ int lds_byte(int r, int c) { const int st = (r >> 4) * 2 + (c >> 5), rr = r & 15, cc = c & 31, ob = rr * 64 + cc * 2; return st * 1024 + (ob ^ (((ob >> 9) & 1) << 5)); }
__host__ __device__ __forceinline__ void stage_rc(int b, int& R, int& C) { const int st = b / 1024, sb = b % 1024, swz = sb ^ (((sb >> 9) & 1) << 5); R = (st >> 1) * 16 + swz / 64; C = (st & 1) * 32 + (swz % 64) / 2; }
__host__ __device__ __forceinline__ int perm32(int rho) { const int n = rho >> 4, i = rho & 15; return 8 * (i >> 2) + 4 * n + (i & 3); }

struct Unit { int pm, pn, koff; };
struct Gemm { const bf16_t* A; const bf16_t* Bt; int M, N, K, lda, ldb; };

struct StaticOrder {
    int nM, nN, nwg, G, c;
    __device__ void init(int M, int N, int G_, int c_) { nM = M / BM; nN = N / BM; nwg = nM * nN; G = G_; c = c_; }
    __device__ bool next(int i, Unit& u) const {
        const long L = (long)i * G + c; if (L >= nwg) return false;
        int wgid = (int)L; { const int q = nwg / NXCD, r = nwg % NXCD, xcd = wgid % NXCD, off = wgid / NXCD; wgid = (xcd < r ? xcd * (q + 1) : r * (q + 1) + (xcd - r) * q) + off; }
        const int nig = WGM * nN, gid = wgid / nig, fm = gid * WGM, gsz = (nM - fm) < WGM ? (nM - fm) : WGM;
        u.pm = fm + ((wgid % nig) % gsz); u.pn = (wgid % nig) / gsz; u.koff = 0; return true;
    }
};

struct CtxSplitOrder {
    int c, G, kchunk;
    __device__ bool next(int i, Unit& u) const { const int L = i * G + c; if (L >= 256) return false; u.pm = 256 + (L >> 5); u.pn = (L >> 3) & 3; u.koff = (L & 7) * kchunk; return true; }
};

template <class Epi, class Sched, bool ALIGN_EPI>
__device__ __forceinline__ void gemm_phase(LAS unsigned char* lds, const Gemm g, const Sched& S, const Epi& E, int wave_s) {
    int tid_l = wave_s * 64 + lane_id(); asm volatile("" : "+v"(tid_l));
    const int tid = tid_l, wid = __builtin_amdgcn_readfirstlane(tid >> 6), lane = tid & 63, wr = wid >> 2, wc = wid & 3, fr = lane & 15, fq = lane >> 4;
    const int K = g.K, nt = K / BK;
    unsigned voffA[2], voffB[2];
#pragma unroll
    for (int i = 0; i < 2; ++i) { int R, C; stage_rc(tid * 16 + i * 8192, R, C); const int Rb = Epi::PERM ? ((R & ~31) + perm32(R & 31)) : R;
        voffA[i] = (unsigned)(R * g.lda + C) * 2u; voffB[i] = (unsigned)(Rb * g.ldb + C) * 2u; }
    const size_t kstep = (size_t)(BK * 2);
    const size_t hstepA = (size_t)HALF * g.lda * 2, hstepB = (size_t)HALF * g.ldb * 2;
    const size_t tstepA = 2 * hstepA, tstepB = 2 * hstepB;
    const unsigned ldsw = (unsigned)wid * 1024u;
    const int aoff = lds_byte(wr * 64 + fr, fq * 8), boff = lds_byte(wc * 32 + fr, fq * 8);
#define PG8_SA(b, h) (((b) * 2 + (h)) * HTB)
#define PG8_SB(b, h) ((4 + (b) * 2 + (h)) * HTB)
#define PG8_STAGE(bufoff, gbase, voff) do { _Pragma("unroll") for (int _i = 0; _i < 2; ++_i) \
        __builtin_amdgcn_global_load_lds((const unsigned*)((const char*)(gbase) + (voff)[_i]), (LAS unsigned*)(lds + (bufoff) + ldsw + _i * 8192), 16, 0, 0); } while (0)
#define PG8_LDA(dst, b, h) do { _Pragma("unroll") for (int m = 0; m < 4; ++m) _Pragma("unroll") for (int k = 0; k < 2; ++k) dst[m][k] = *(const LAS bf16x8*)(lds + PG8_SA(b, h) + aoff + m * 2048 + k * 1024); } while (0)
#define PG8_LDB(dst, b, h) do { _Pragma("unroll") for (int n = 0; n < 2; ++n) _Pragma("unroll") for (int k = 0; k < 2; ++k) dst[n][k] = *(const LAS bf16x8*)(lds + PG8_SB(b, h) + boff + n * 2048 + k * 1024); } while (0)
#define PG8_MMA(ai, bj, At, Bt) do { __builtin_amdgcn_s_setprio(1); _Pragma("unroll") for (int m = 0; m < 4; ++m) _Pragma("unroll") for (int n = 0; n < 2; ++n) _Pragma("unroll") for (int k = 0; k < 2; ++k) \
        acc[ai][bj][m][n] = __builtin_amdgcn_mfma_f32_16x16x32_bf16(Bt[n][k], At[m][k], acc[ai][bj][m][n], 0, 0, 0); __builtin_amdgcn_s_setprio(0); } while (0)
#define PG8_WAIT_V(n) asm volatile("s_waitcnt vmcnt(" #n ")" ::: "memory")
#define PG8_WAIT_L(n) asm volatile("s_waitcnt lgkmcnt(" #n ")" ::: "memory")
#define PG8_BAR __builtin_amdgcn_s_barrier()
#define PG8_SCHED __builtin_amdgcn_sched_barrier(0)
    Unit cur, nxt; int ui = 0;
    if (!S.next(0, cur)) return;
    f32x4 acc[2][2][4][2];
#pragma unroll
    for (int a = 0; a < 2; ++a)
#pragma unroll
        for (int b = 0; b < 2; ++b)
#pragma unroll
            for (int m = 0; m < 4; ++m)
#pragma unroll
                for (int n = 0; n < 2; ++n) acc[a][b][m][n] = (f32x4){0.f, 0.f, 0.f, 0.f};
    bf16x8 At[4][2], B0[2][2], B1[2][2];
    const char* cA = (const char*)g.A + (size_t)cur.pm * tstepA + (size_t)cur.koff * 2; const char* cB = (const char*)g.Bt + (size_t)cur.pn * tstepB + (size_t)cur.koff * 2;
    PG8_STAGE(PG8_SB(0, 0), cB, voffB); PG8_STAGE(PG8_SB(0, 1), cB + hstepB, voffB); PG8_STAGE(PG8_SA(0, 0), cA, voffA); PG8_STAGE(PG8_SA(0, 1), cA + hstepA, voffA);
    if (wr == 1) PG8_BAR;
    PG8_WAIT_V(2); PG8_BAR;
    PG8_STAGE(PG8_SB(1, 0), cB + kstep, voffB); PG8_STAGE(PG8_SA(1, 0), cA + kstep, voffA); PG8_STAGE(PG8_SB(1, 1), cB + hstepB + kstep, voffB);
    PG8_WAIT_V(6); PG8_BAR;
    for (;;) {
        const bool has_next = S.next(ui + 1, nxt);
        const char* nA = has_next ? (const char*)g.A + (size_t)nxt.pm * tstepA + (size_t)nxt.koff * 2 : cA; const char* nB = has_next ? (const char*)g.Bt + (size_t)nxt.pn * tstepB + (size_t)nxt.koff * 2 : cB;
        for (int t = 0; t < nt; t += 2) {
            const bool last = (t == nt - 2);
            const char* a1 = cA + (size_t)(t + 1) * kstep;
            const char* a2 = last ? nA : cA + (size_t)(t + 2) * kstep; const char* b2 = last ? nB : cB + (size_t)(t + 2) * kstep;
            const char* a3 = a2 + kstep; const char* b3 = b2 + kstep;
            PG8_LDB(B0, 0, 0); PG8_LDB(B1, 0, 1); PG8_SCHED; PG8_LDA(At, 0, 0); PG8_STAGE(PG8_SA(1, 1), a1 + hstepA, voffA);
            PG8_WAIT_V(8); PG8_WAIT_L(0); PG8_BAR; PG8_MMA(0, 0, At, B0); PG8_MMA(0, 1, At, B1); PG8_BAR; PG8_SCHED;
            PG8_LDA(At, 0, 1); PG8_STAGE(PG8_SB(0, 0), b2, voffB); PG8_STAGE(PG8_SB(0, 1), b2 + hstepB, voffB); PG8_STAGE(PG8_SA(0, 0), a2, voffA);
            PG8_WAIT_V(8); PG8_WAIT_L(0); PG8_BAR; PG8_MMA(1, 0, At, B0); PG8_MMA(1, 1, At, B1); PG8_BAR; PG8_SCHED;
            PG8_LDB(B0, 1, 0); PG8_LDB(B1, 1, 1); PG8_SCHED; PG8_LDA(At, 1, 0); PG8_STAGE(PG8_SA(0, 1), a2 + hstepA, voffA);
            PG8_WAIT_V(8); PG8_WAIT_L(0); PG8_BAR; PG8_MMA(0, 0, At, B0); PG8_MMA(0, 1, At, B1); PG8_BAR; PG8_SCHED;
            PG8_LDA(At, 1, 1); PG8_STAGE(PG8_SB(1, 0), b3, voffB); PG8_STAGE(PG8_SB(1, 1), b3 + hstepB, voffB); PG8_STAGE(PG8_SA(1, 0), a3, voffA);
            PG8_WAIT_V(8); PG8_WAIT_L(0); PG8_BAR; PG8_MMA(1, 0, At, B0); PG8_MMA(1, 1, At, B1); PG8_BAR; PG8_SCHED;
        }
        if constexpr (ALIGN_EPI) { if (wr == 0) PG8_BAR; }
        E(acc, cur, wr, wc, fr, fq);
        if (!has_next) break;
#pragma unroll
        for (int a = 0; a < 2; ++a)
#pragma unroll
            for (int b = 0; b < 2; ++b)
#pragma unroll
                for (int m = 0; m < 4; ++m)
#pragma unroll
                    for (int n = 0; n < 2; ++n) acc[a][b][m][n] = (f32x4){0.f, 0.f, 0.f, 0.f};
        cur = nxt; cA = nA; cB = nB; ++ui;
        if constexpr (ALIGN_EPI) { if (wr == 1) PG8_BAR; }
    }
    PG8_WAIT_V(0);
    if constexpr (!ALIGN_EPI) { if (wr == 0) PG8_BAR; }
    PG8_BAR;
#undef PG8_SA
#undef PG8_SB
#undef PG8_STAGE
#undef PG8_LDA
#undef PG8_LDB
#undef PG8_MMA
#undef PG8_WAIT_V
#undef PG8_WAIT_L
#undef PG8_BAR
#undef PG8_SCHED
}
}

typedef const f32x4 (&AccRef)[2][2][4][2];

__device__ __forceinline__ void rope8(float (&v)[8], const float* tab) {
    const f32x4 t0 = *(const f32x4*)tab, t1 = *(const f32x4*)(tab + 4);
    float x1, x2;
    x1 = v[0]; x2 = v[1]; v[0] = x1 * t0[0] - x2 * t0[1]; v[1] = x1 * t0[1] + x2 * t0[0];
    x1 = v[2]; x2 = v[3]; v[2] = x1 * t0[2] - x2 * t0[3]; v[3] = x1 * t0[3] + x2 * t0[2];
    x1 = v[4]; x2 = v[5]; v[4] = x1 * t1[0] - x2 * t1[1]; v[5] = x1 * t1[1] + x2 * t1[0];
    x1 = v[6]; x2 = v[7]; v[6] = x1 * t1[2] - x2 * t1[3]; v[7] = x1 * t1[3] + x2 * t1[2];
}
__device__ __forceinline__ void rope8v(float (&v)[8], const f32x4 t0, const f32x4 t1) {
    float x1, x2;
    x1 = v[0]; x2 = v[1]; v[0] = x1 * t0[0] - x2 * t0[1]; v[1] = x1 * t0[1] + x2 * t0[0];
    x1 = v[2]; x2 = v[3]; v[2] = x1 * t0[2] - x2 * t0[3]; v[3] = x1 * t0[3] + x2 * t0[2];
    x1 = v[4]; x2 = v[5]; v[4] = x1 * t1[0] - x2 * t1[1]; v[5] = x1 * t1[1] + x2 * t1[0];
    x1 = v[6]; x2 = v[7]; v[6] = x1 * t1[2] - x2 * t1[3]; v[7] = x1 * t1[3] + x2 * t1[2];
}
__device__ __forceinline__ u32x4 pack8(const float (&v)[8]) { u32x4 w; w.x = cvtpk(v[0], v[1]); w.y = cvtpk(v[2], v[3]); w.z = cvtpk(v[4], v[5]); w.w = cvtpk(v[6], v[7]); return w; }

template <int MODE> struct EpiProj {
    static constexpr bool PERM = true;
    bf16_t* Q; bf16_t* K; bf16_t* VT; const float* rope; const float* ssq; float qscale; const float* nbias;
    __device__ __forceinline__ void operator()(AccRef acc, const pg8::Unit& u, int wr, int wc, int fr_, int fq_) const {
        int lane_e = lane_id(); asm volatile("" : "+v"(lane_e)); const int fr = lane_e & 15, fq = lane_e >> 4; (void)fr_; (void)fq_;
        constexpr int LDQ = (MODE == 0) ? 1536 : 1024, NQ = (MODE == 0) ? 1536 : (MODE == 1 ? 0 : 1024);
        constexpr int LDK = (MODE == 2) ? 256 : 1024, NK = LDK, VCOLS = LDK;
        constexpr int TS = (MODE == 2) ? 64 : 32;
        const bool isctx = u.pm >= 256;
        const int row0 = u.pm * 256 + wr * 64 + fr, col0 = u.pn * 256 + wc * 32 + 8 * fq;
        f32x4 nbv[2][2]; float rs[4];
#pragma unroll
        for (int bj = 0; bj < 2; ++bj) {
            const int col = col0 + 128 * bj;
            if (MODE >= 2) { const float* nb = nbias + (isctx ? 8 : (u.pm >> 5)) * 4096 + col; nbv[bj][0] = *(const f32x4*)nb; nbv[bj][1] = *(const f32x4*)(nb + 4); }
            else { nbv[bj][0] = (f32x4){0.f, 0.f, 0.f, 0.f}; nbv[bj][1] = nbv[bj][0]; }
        }
#pragma unroll
        for (int r = 0; r < 8; ++r) {
            const int ai = r >> 2, m = r & 3; const int row = row0 + 128 * ai + 16 * m;
            if (m == 0) {
#pragma unroll
                for (int q = 0; q < 4; ++q) rs[q] = ssq[row0 + 128 * ai + 16 * q];
#pragma unroll
                for (int q = 0; q < 4; ++q) rs[q] = rsqrtf(rs[q] * (MODE == 0 ? 1.f / 256.f : (MODE == 1 ? 1.f / 128.f : 1.f / 1024.f)) + EPS);
            }
            const int rc = row - ML;
            const int b = isctx ? (rc >> 8) : (u.pm >> 5);
            const int kpos = isctx ? (rc & 255) : 256 + (row & 8191);
            const size_t kvrow = (size_t)b * KVLEN + kpos;
            const int vpos = (kpos & ~15) | perm16(kpos & 15);
            f32x4 tc[2][2] = {}; bool rp[2] = {false, false}; int roff[2] = {0, 0};
#pragma unroll
            for (int bj = 0; bj < 2; ++bj) { const int col = col0 + 128 * bj;
                if (MODE == 2) { rp[bj] = !isctx && col < 1280; roff[bj] = ((col & 63) >> 1) * 2; }
                else if (MODE == 0) { const int c96 = col % 96; rp[bj] = !isctx && c96 >= 64; roff[bj] = rp[bj] ? ((c96 - 64) >> 1) * 2 : 0; } }
            if (MODE == 2) {
#pragma unroll
                for (int bj = 0; bj < 2; ++bj) if (rp[bj]) { const float* tp = rope + (size_t)(row & 8191) * TS + roff[bj]; tc[bj][0] = *(const f32x4*)tp; tc[bj][1] = *(const f32x4*)(tp + 4); }
            }
#pragma unroll
            for (int bj = 0; bj < 2; ++bj) {
                const int col = col0 + 128 * bj;
                float v[8];
#pragma unroll
                for (int j = 0; j < 4; ++j) { v[j] = acc[ai][bj][m][0][j] * rs[m] + nbv[bj][0][j]; v[4 + j] = acc[ai][bj][m][1][j] * rs[m] + nbv[bj][1][j]; }
                if (MODE == 0 && rp[bj]) { const float* tp = rope + (size_t)(row & 8191) * TS + roff[bj]; tc[bj][0] = *(const f32x4*)tp; tc[bj][1] = *(const f32x4*)(tp + 4); }
                if ((MODE == 0 || MODE == 2) && rp[bj]) rope8v(v, tc[bj][0], tc[bj][1]);
                bool isv; int kc;
                if (MODE == 1) { const int within = col & 127; isv = within >= 64; kc = (col >> 7) * 64 + (within & 63); }
                else { isv = col >= NQ + NK; kc = isv ? col - NQ - NK : col - NQ; }
                if (MODE != 1 && col < NQ) {
#pragma unroll
                    for (int j = 0; j < 8; ++j) v[j] *= qscale;
                    *(u32x4*)(Q + (size_t)row * LDQ + col) = pack8(v);
                } else if (MODE != 0 && !isv) {
                    *(u32x4*)(K + kvrow * LDK + kc) = pack8(v);
                } else if (MODE != 0) {
                    bf16_t* vp = VT + ((size_t)(b * VCOLS + kc)) * KVLEN + vpos;
#pragma unroll
                    for (int j = 0; j < 8; ++j) vp[(size_t)j * KVLEN] = (bf16_t)(cvtpk(v[j], 0.f) & 0xffffu);
                }
            }
        }
    }
};

struct EpiLat {
    static constexpr bool PERM = true;
    bf16_t* lat; float* ssq_q; float* ssq_kv; bf16_t* KPE; const float* rope; const float* ssqn; const float* nbias;
    __device__ __forceinline__ void operator()(AccRef acc, const pg8::Unit& u, int wr, int wc, int fr_, int fq_) const {
        int lane_e = lane_id(); asm volatile("" : "+v"(lane_e)); const int fr = lane_e & 15, fq = lane_e >> 4; (void)fr_; (void)fq_;
        float rsv[8]; f32x4 nbv[2][2];
        { const int row0 = u.pm * 256 + wr * 64 + fr; const float* nb = nbias + (u.pm >= 256 ? 8 : (u.pm >> 5)) * 4096 + u.pn * 256 + wc * 32 + 8 * fq;
#pragma unroll
          for (int bj = 0; bj < 2; ++bj) { nbv[bj][0] = *(const f32x4*)(nb + 128 * bj); nbv[bj][1] = *(const f32x4*)(nb + 128 * bj + 4); }
#pragma unroll
          for (int r = 0; r < 8; ++r) rsv[r] = ssqn[row0 + 128 * (r >> 2) + 16 * (r & 3)];
#pragma unroll
          for (int r = 0; r < 8; ++r) rsv[r] = rsqrtf(rsv[r] * (1.f / 1024.f) + EPS); }
#pragma unroll
        for (int ai = 0; ai < 2; ++ai)
#pragma unroll
            for (int m = 0; m < 4; ++m) {
                const int row = u.pm * 256 + ai * 128 + wr * 64 + m * 16 + fr;
                const bool isctx = row >= ML; const int rc = row - ML;
                const int b = isctx ? (rc >> 8) : (row >> 13);
                const int tok = row & 8191;
                const int kpos = isctx ? (rc & 255) : 256 + tok;
                const size_t kvrow = (size_t)b * KVLEN + kpos;
                const float rs = rsv[ai * 4 + m];
                float ss = 0.f;
#pragma unroll
                for (int bj = 0; bj < 2; ++bj) {
                    const int col = u.pn * 256 + bj * 128 + wc * 32 + 8 * fq;
                    float v[8];
#pragma unroll
                    for (int j = 0; j < 4; ++j) { v[j] = acc[ai][bj][m][0][j] * rs; v[4 + j] = acc[ai][bj][m][1][j] * rs; }
                    {
#pragma unroll
                      for (int j = 0; j < 4; ++j) { v[j] += nbv[bj][0][j]; v[4 + j] += nbv[bj][1][j]; } }
                    if (col < 384) {
#pragma unroll
                        for (int j = 0; j < 8; ++j) ss += v[j] * v[j];
                        *(u32x4*)(lat + (size_t)row * 512 + col) = pack8(v);
                    } else if (col < 416) {
                        if (!isctx) rope8(v, rope + ((size_t)tok * 16 + ((col - 384) >> 1)) * 2);
                        *(u32x4*)(KPE + kvrow * 32 + (col - 384)) = pack8(v);
                    }
                }
                ss += shfl_xor_l(ss, 16, lane_e); ss += shfl_xor_l(ss, 32, lane_e);
                if (fq == 0 && (u.pn == 0 || wc < 4)) unsafeAtomicAdd((u.pn == 0 ? ssq_q : ssq_kv) + row, ss);
            }
    }
};

typedef _Float16 h16x4 __attribute__((ext_vector_type(4)));
__device__ __forceinline__ f32x4 ld_h4(const _Float16* p) { const h16x4 h = *(const h16x4*)p; return (f32x4){(float)h[0], (float)h[1], (float)h[2], (float)h[3]}; }
__device__ __forceinline__ void st_h4(_Float16* p, const f32x4 v) { h16x4 h; h[0] = (_Float16)v[0]; h[1] = (_Float16)v[1]; h[2] = (_Float16)v[2]; h[3] = (_Float16)v[3]; *(h16x4*)p = h; }
typedef _Float16 h16x8 __attribute__((ext_vector_type(8)));
struct EpiResid {
    static constexpr bool PERM = true;
    const float* xin32; const _Float16* xin16; _Float16* xout16; const float* gate;
    bf16_t* xa; const float* gn; const float* scn; float* ssqn;
    __device__ __forceinline__ void ldx8(size_t off, f32x4& a, f32x4& b) const {
        if (xin32) { a = *(const f32x4*)(xin32 + off); b = *(const f32x4*)(xin32 + off + 4); }
        else { const h16x8 h = *(const h16x8*)(xin16 + off); a = (f32x4){(float)h[0], (float)h[1], (float)h[2], (float)h[3]}; b = (f32x4){(float)h[4], (float)h[5], (float)h[6], (float)h[7]}; }
    }
    __device__ __forceinline__ void operator()(AccRef acc, const pg8::Unit& u, int wr, int wc, int fr_, int fq_) const {
        int lane_e = lane_id(); asm volatile("" : "+v"(lane_e)); const int fr = lane_e & 15, fq = lane_e >> 4; (void)fr_; (void)fq_;
        const int bsel = u.pm >> 5;
        const int col0 = u.pn * 256 + wc * 32 + 8 * fq;
        const int row0 = u.pm * 256 + wr * 64 + fr;
        f32x4 gv[4], av[4];
#pragma unroll
        for (int c = 0; c < 4; ++c) { const int col = col0 + 128 * (c >> 1) + 4 * (c & 1);
            gv[c] = *(const f32x4*)(gate + bsel * 6144 + col);
            if (xa) { const f32x4 g4 = *(const f32x4*)(gn + col), s4 = *(const f32x4*)(scn + bsel * 6144 + col); av[c] = g4 * (s4 + 1.f); } else av[c] = (f32x4){0.f, 0.f, 0.f, 0.f}; }
        f32x4 xc[4], xn[4]; float ssr[8];
        { const size_t xo_ = (size_t)row0 * DM + col0; ldx8(xo_, xc[0], xc[1]); ldx8(xo_ + 128, xc[2], xc[3]); }
#pragma unroll
        for (int r = 0; r < 8; ++r) {
            const int ai = r >> 2, m = r & 3; const int row = row0 + 128 * ai + 16 * m;
            if (r < 7) { const int rown = row0 + 128 * ((r + 1) >> 2) + 16 * ((r + 1) & 3); const size_t xo_ = (size_t)rown * DM + col0; ldx8(xo_, xn[0], xn[1]); ldx8(xo_ + 128, xn[2], xn[3]); }
            _Float16* xo = xout16 + (size_t)row * DM + col0; float ss = 0.f;
#pragma unroll
            for (int bj = 0; bj < 2; ++bj) {
                const f32x4 y0 = xc[2 * bj] + gv[2 * bj] * acc[ai][bj][m][0], y1 = xc[2 * bj + 1] + gv[2 * bj + 1] * acc[ai][bj][m][1];
                { h16x8 h; h[0] = (_Float16)y0[0]; h[1] = (_Float16)y0[1]; h[2] = (_Float16)y0[2]; h[3] = (_Float16)y0[3]; h[4] = (_Float16)y1[0]; h[5] = (_Float16)y1[1]; h[6] = (_Float16)y1[2]; h[7] = (_Float16)y1[3];
                  *(h16x8*)(xo + 128 * bj) = h; }
                if (xa) { const f32x4 z0 = y0 * av[2 * bj], z1 = y1 * av[2 * bj + 1];
                    ss += (y0[0] * y0[0] + y0[1] * y0[1]) + (y0[2] * y0[2] + y0[3] * y0[3]); ss += (y1[0] * y1[0] + y1[1] * y1[1]) + (y1[2] * y1[2] + y1[3] * y1[3]);
                    u32x4 o; o.x = cvtpk(z0[0], z0[1]); o.y = cvtpk(z0[2], z0[3]); o.z = cvtpk(z1[0], z1[1]); o.w = cvtpk(z1[2], z1[3]);
                    *(u32x4*)(xa + (size_t)row * DM + col0 + 128 * bj) = o; }
            }
            ssr[r] = ss;
#pragma unroll
            for (int c = 0; c < 4; ++c) xc[c] = xn[c];
        }
        if (xa) {
#pragma unroll
            for (int r = 0; r < 8; ++r) { float ss = ssr[r]; ss += shfl_xor_l(ss, 16, lane_e); ss += shfl_xor_l(ss, 32, lane_e); ssr[r] = ss; }
            if (fq == 0) {
#pragma unroll
                for (int r = 0; r < 8; ++r) unsafeAtomicAdd(ssqn + row0 + 128 * (r >> 2) + 16 * (r & 3), ssr[r]);
            }
        }
    }
};

struct EpiCtxPartial {
    static constexpr bool PERM = false;
    float* part; int kchunk;
    __device__ __forceinline__ void operator()(AccRef acc, const pg8::Unit& u, int wr, int wc, int fr_, int fq_) const {
        int lane_e = lane_id(); asm volatile("" : "+v"(lane_e)); const int fr = lane_e & 15, fq = lane_e >> 4; (void)fr_; (void)fq_;
        float* pb = part + (size_t)(u.koff / kchunk) * MC * DM;
#pragma unroll
        for (int ai = 0; ai < 2; ++ai)
#pragma unroll
            for (int m = 0; m < 4; ++m) {
                const int row = u.pm * 256 + ai * 128 + wr * 64 + m * 16 + fr - ML;
                float* xr = pb + (size_t)row * DM;
#pragma unroll
                for (int bj = 0; bj < 2; ++bj)
#pragma unroll
                    for (int n = 0; n < 2; ++n) {
                        const int col = u.pn * 256 + bj * 128 + wc * 32 + 16 * n + 4 * fq;
                        *(f32x4*)(xr + col) = acc[ai][bj][m][n];
                    }
            }
    }
};

struct EpiSqRelu {
    static constexpr bool PERM = true;
    bf16_t* O; int ldc; const float* ssqn; const float* nbias;
    __device__ __forceinline__ void operator()(AccRef acc, const pg8::Unit& u, int wr, int wc, int fr_, int fq_) const {
        int lane_e = lane_id(); asm volatile("" : "+v"(lane_e)); const int fr = lane_e & 15, fq = lane_e >> 4; (void)fr_; (void)fq_;
        const int row0 = u.pm * 256 + wr * 64 + fr, col0 = u.pn * 256 + wc * 32 + 8 * fq;
        const float* nb = nbias + (u.pm >= 256 ? 8 : (u.pm >> 5)) * 4096 + col0;
        f32x4 bv[2][2]; float rs[8];
#pragma unroll
        for (int bj = 0; bj < 2; ++bj) { bv[bj][0] = *(const f32x4*)(nb + bj * 128); bv[bj][1] = *(const f32x4*)(nb + bj * 128 + 4); }
#pragma unroll
        for (int r = 0; r < 8; ++r) rs[r] = ssqn[row0 + 128 * (r >> 2) + 16 * (r & 3)];
#pragma unroll
        for (int r = 0; r < 8; ++r) rs[r] = rsqrtf(rs[r] * (1.f / 1024.f) + EPS);
#pragma unroll
        for (int r = 0; r < 8; ++r) {
            const int ai = r >> 2, m = r & 3; const int row = row0 + 128 * ai + 16 * m;
#pragma unroll
            for (int bj = 0; bj < 2; ++bj) {
                float v[8];
#pragma unroll
                for (int j = 0; j < 4; ++j) { float a = fmaxf(acc[ai][bj][m][0][j] * rs[r] + bv[bj][0][j], 0.f), c = fmaxf(acc[ai][bj][m][1][j] * rs[r] + bv[bj][1][j], 0.f); v[j] = a * a; v[4 + j] = c * c; }
                *(u32x4*)(O + (size_t)row * ldc + col0 + bj * 128) = pack8(v);
            }
        }
    }
};

constexpr int KP = 208, VP = 144;
constexpr int KT_BYTES = 64 * KP, VT_BYTES = 64 * VP, ABUF = KT_BYTES + VT_BYTES;
constexpr int ATT_OSTAGE_OFF = 73728;
constexpr int ATT_BIAS_OFF = 2 * ABUF;
struct AttnP { const bf16_t* Q; const bf16_t* K; const bf16_t* KPE; const bf16_t* VT; bf16_t* O; const float* sink; const float* bias; int nunits; };

__device__ __forceinline__ float rowmax32(const f32x16& a, const f32x16& b) {
    float x = __builtin_fmaxf(__builtin_fmaxf(a[0], a[1]), b[0]), y = __builtin_fmaxf(__builtin_fmaxf(a[2], a[3]), b[1]); x = __builtin_fmaxf(__builtin_fmaxf(x, b[2]), b[3]);
#pragma unroll
    for (int r = 4; r < 16; r += 4) { x = __builtin_fmaxf(__builtin_fmaxf(x, a[r]), a[r + 1]); y = __builtin_fmaxf(__builtin_fmaxf(y, a[r + 2]), a[r + 3]); x = __builtin_fmaxf(__builtin_fmaxf(x, b[r]), b[r + 1]); y = __builtin_fmaxf(__builtin_fmaxf(y, b[r + 2]), b[r + 3]); }
    const float m = __builtin_fmaxf(x, y);
    auto rr = __builtin_amdgcn_permlane32_swap(__float_as_uint(m), __float_as_uint(m), false, false);
    return __builtin_fmaxf(__uint_as_float(rr[0]), __uint_as_float(rr[1]));
}

template <int VAR>
__device__ __forceinline__ void attn_phase(LAS unsigned char* lds, const AttnP P, int vcu, int G, int wave_s) {
    constexpr int ND0 = (VAR == 0) ? 6 : 4;
    constexpr int QPITCH = (VAR == 0) ? 1536 : 1024, QH = (VAR == 0) ? 96 : 64;
    constexpr int KPITCH = (VAR == 1) ? 256 : 1024, VCOLS = (VAR == 1) ? 256 : 1024;
    constexpr bool USE_NEGM = (VAR != 2);
    constexpr float THR = 8.f;
    int tid_l = wave_s * 64 + lane_id(); asm volatile("" : "+v"(tid_l));
    const int tid = tid_l, lane = tid & 63, r32 = lane & 31, hi = lane >> 5;
    const int w = __builtin_amdgcn_readfirstlane(tid >> 6);
    LAS float* bias_lds = (LAS float*)(lds + ATT_BIAS_OFF);
    for (int it = 0;; ++it) {
        int u;
        if (VAR == 0 && G == 256) { u = (it < 16) ? ((it * 8 + (vcu >> 5)) * 32 + (vcu & 31)) : (4096 + (it - 16) * 256 + vcu); }
        else u = it * G + vcu;
        if (u >= P.nunits) break;
        const bool isctx = u >= 4096;
        int b, hq, hk, qrow, nt; int p_a = 0, p_b = 0;
        if (VAR == 0) {
            if (!isctx) { const int bh = u >> 5, qb = u & 31; b = bh >> 4; hq = bh & 15; qrow = b * SEQ + qb * 256 + 32 * w; nt = 132; }
            else { const int cu = u - 4096; b = cu >> 4; hq = cu & 15; qrow = ML + b * 256 + 32 * w; nt = 4; }
            hk = hq;
        } else if (VAR == 1) {
            if (!isctx) { const int blk = u & 63, hp = (u >> 6) & 7; b = u >> 9; hq = 2 * hp + (w >> 2); hk = hp >> 1; qrow = b * SEQ + blk * 128 + 32 * (w & 3);
                          const int jlo = blk == 0 ? 2 : 0, jhi = blk == 63 ? 4 : 6; nt = 4 + jhi - jlo; p_a = blk * 128 - 128 + 64 * jlo; p_b = blk * 128 + 32 * (w & 3); }
            else { const int cu = u - 4096, half = cu & 1, hp = (cu >> 1) & 7; b = cu >> 4; hq = 2 * hp + (w >> 2); hk = hp >> 1; qrow = ML + b * 256 + half * 128 + 32 * (w & 3); nt = 4; }
        } else {
            if (!isctx) { const int rq = u & 31; hq = (u >> 5) & 15; b = u >> 9; const int r0 = 4 * rq; qrow = b * SEQ + (r0 + (w >> 1)) * 64 + 32 * (w & 1);
                          int lo = r0 - 4; lo = lo < 0 ? 0 : (lo > 120 ? 120 : lo); int h2 = r0 - 1; h2 = h2 < 0 ? 0 : (h2 > 120 ? 120 : h2); nt = 4 + (h2 + 8 - lo); p_a = lo; p_b = r0 + (w >> 1); }
            else { const int cu = u - 4096; b = cu >> 4; hq = cu & 15; qrow = ML + b * 256 + 32 * w; nt = 4; }
            hk = hq;
        }
        if (VAR == 2 && !isctx) { if (tid < 465) bias_lds[tid] = P.bias[hq * 465 + tid] * LOG2E; }
        bf16x8 qf[ND0];
        { const bf16_t* qp = P.Q + (size_t)(qrow + r32) * QPITCH + hq * QH + hi * 8;
#pragma unroll
          for (int d0 = 0; d0 < ND0; ++d0) qf[d0] = *(const bf16x8*)(qp + d0 * 16); }
        f32x16 o0 = {}, o1 = {};
        const unsigned koff = (unsigned)(((b * KVLEN + (tid >> 3)) * KPITCH + hk * 64 + (tid & 7) * 8) * 2);
        const unsigned peoff = (unsigned)(((b * KVLEN + (tid >> 2)) * 32 + (tid & 3) * 8) * 2);
        const unsigned voff = (unsigned)(((b * VCOLS + hk * 64 + (tid >> 3)) * KVLEN + (tid & 7) * 8) * 2);
        u32x4 kreg, pereg = {}, vreg;
#define TILE_KPOS(t) (VAR == 0 ? 64 * (((t) + rot >= nt) ? (t) + rot - nt : (t) + rot) : ((t) < 4 ? 64 * (t) : (VAR == 1 ? 256 + p_a + 64 * ((t) - 4) : 256 + 64 * (p_a + (t) - 4))))
#define LOADK(t) do { const int kp_ = TILE_KPOS(t); kreg = *(const u32x4*)((const char*)P.K + (size_t)(koff + (unsigned)(kp_ * KPITCH * 2))); if (VAR == 0 && tid < 256) pereg = *(const u32x4*)((const char*)P.KPE + (size_t)(peoff + (unsigned)(kp_ * 64))); } while (0)
#define LOADV(t) do { const int kp_ = TILE_KPOS(t); vreg = *(const u32x4*)((const char*)P.VT + (size_t)(voff + (unsigned)(kp_ * 2))); } while (0)
#define STOREK(buf) do { LAS unsigned char* kb_ = lds + (buf) * ABUF; *(LAS u32x4*)(kb_ + (tid >> 3) * KP + (tid & 7) * 16) = kreg; \
        if (VAR == 0 && tid < 256) *(LAS u32x4*)(kb_ + (tid >> 2) * KP + 128 + (tid & 3) * 16) = pereg; } while (0)
#define STOREV(buf) do { *(LAS u32x4*)(lds + (buf) * ABUF + KT_BYTES + (tid >> 3) * VP + (tid & 7) * 16) = vreg; } while (0)
#define NEED(t) (((t) < 4) ? true : (VAR == 1 ? ((p_a + 64 * ((t) - 4) + 63 >= p_b - 128) && (p_a + 64 * ((t) - 4) <= p_b + 31 + 128)) : (VAR == 2 ? ((p_a + (t) - 4 >= na_rs) && (p_a + (t) - 4 < na_rs + 8)) : true)))
#define QK_TILE(P0, P1, buf, CINIT) do { const LAS unsigned char* kt_ = lds + (buf) * ABUF; P0 = (CINIT); P1 = (CINIT); \
        _Pragma("unroll") for (int d0 = 0; d0 < ND0; ++d0) { \
            const bf16x8 k0_ = *(const LAS bf16x8*)(kt_ + r32 * KP + d0 * 32 + hi * 16); const bf16x8 k1_ = *(const LAS bf16x8*)(kt_ + (32 + r32) * KP + d0 * 32 + hi * 16); \
            P0 = __builtin_amdgcn_mfma_f32_32x32x16_bf16(k0_, qf[d0], P0, 0, 0, 0); P1 = __builtin_amdgcn_mfma_f32_32x32x16_bf16(k1_, qf[d0], P1, 0, 0, 0); } } while (0)
#define MASK_TILE(P0, P1, t) do { \
        if (VAR == 1 && (t) >= 4) { const int d0_ = p_a + 64 * ((t) - 4) - (p_b + r32) + 4 * hi + 128; \
            _Pragma("unroll") for (int r = 0; r < 16; ++r) { const int dd = d0_ + (r & 3) + 8 * (r >> 2); if ((unsigned)dd > 256u) P0[r] = -1e30f; if ((unsigned)(dd + 32) > 256u) P1[r] = -1e30f; } } \
        if (VAR == 2 && (t) >= 4) { int c = (qrow & 63) + r32; asm volatile("" : "+v"(c)); const int kr = p_a + (t) - 4; int cs = c - 8; cs = cs < 0 ? 0 : (cs > 48 ? 48 : cs); const LAS float* brow = bias_lds + (kr - p_b + 7) * 31; \
            _Pragma("unroll") for (int r = 0; r < 16; ++r) { const int kc = 4 * hi + (r & 3) + 8 * (r >> 2); \
                { int bi = kc - c + 15; bi = bi < 0 ? 0 : (bi > 30 ? 30 : bi); P0[r] = ((unsigned)(kc - cs) < 16u) ? P0[r] + brow[bi] : -1e30f; } \
                { int bi = kc + 32 - c + 15; bi = bi < 0 ? 0 : (bi > 30 ? 30 : bi); P1[r] = ((unsigned)(kc + 32 - cs) < 16u) ? P1[r] + brow[bi] : -1e30f; } } } } while (0)
        const int rot = (VAR == 0 && !isctx) ? ((vcu & 31) * 4 + (vcu >> 5)) % 132 : 0;
        int na_rs = 0; if (VAR == 2) { na_rs = p_b - 4; na_rs = na_rs < 0 ? 0 : (na_rs > 120 ? 120 : na_rs); }
        LOADK(0); LOADV(0); STOREK(0); STOREV(0);
        if (nt > 1) { LOADK(1); STOREK(1); }
        __syncthreads();
        f32x16 pc0, pc1; const f32x16 zero16 = {};
        QK_TILE(pc0, pc1, 0, zero16);
        float mref = rowmax32(pc0, pc1), lrun = 0.f;
        if (VAR == 1) { const float sk = P.sink[hq] * LOG2E; mref = __builtin_fmaxf(mref, sk); lrun = (hi == 0) ? __builtin_amdgcn_exp2f(sk - mref) : 0.f; }
        f32x16 negm = {};
        if (USE_NEGM) {
#pragma unroll
            for (int r = 0; r < 16; ++r) { pc0[r] -= mref; pc1[r] -= mref; negm[r] = -mref; }
        }
        float rmc = 0.f;
        bool need_c = true;
        __syncthreads();
        for (int t = 0; t < nt; ++t) {
            const bool hn = (t + 1 < nt);
            if (hn) { const int t2 = (t + 2 < nt) ? t + 2 : nt - 1; LOADK(t2); LOADV(t + 1); }
            const bool need_n = hn && NEED(t + 1);
            if (need_c && __any(rmc > THR)) {
                const float dl = __builtin_fmaxf(rmc, 0.f), f = __builtin_amdgcn_exp2f(-dl);
                mref += dl; lrun *= f;
#pragma unroll
                for (int r = 0; r < 16; ++r) { if (USE_NEGM) { pc0[r] -= dl; pc1[r] -= dl; negm[r] = -mref; } o0[r] *= f; o1[r] *= f; }
            }
            f32x16 pn0 = {}, pn1 = {};
            float rmn = -1e30f;
            if (VAR != 2 && need_c && need_n) {
                const LAS unsigned char* kt_ = lds + ((t + 1) & 1) * ABUF; const LAS unsigned char* vt_ = lds + (t & 1) * ABUF + KT_BYTES;
                bf16x8 kf[2 * ND0], vf[8]; u32x4 w0, w1, w2, w3; float sacc = 0.f;
#define KRD(d0) do { kf[2 * (d0)] = *(const LAS bf16x8*)(kt_ + r32 * KP + (d0) * 32 + hi * 16); kf[2 * (d0) + 1] = *(const LAS bf16x8*)(kt_ + (32 + r32) * KP + (d0) * 32 + hi * 16); } while (0)
#define VRD(kk) do { vf[2 * (kk)] = *(const LAS bf16x8*)(vt_ + r32 * VP + (kk) * 32 + hi * 16); vf[2 * (kk) + 1] = *(const LAS bf16x8*)(vt_ + (32 + r32) * VP + (kk) * 32 + hi * 16); } while (0)
#define EX4(Pv, a, W, lo) do { if (!USE_NEGM) { Pv[a] -= mref; Pv[a + 1] -= mref; Pv[a + 2] -= mref; Pv[a + 3] -= mref; } Pv[a] = __builtin_amdgcn_exp2f(Pv[a]); Pv[a + 1] = __builtin_amdgcn_exp2f(Pv[a + 1]); Pv[a + 2] = __builtin_amdgcn_exp2f(Pv[a + 2]); Pv[a + 3] = __builtin_amdgcn_exp2f(Pv[a + 3]); \
        sacc += Pv[a]; sacc += Pv[a + 1]; sacc += Pv[a + 2]; sacc += Pv[a + 3]; if (lo) { W.x = cvtpk(Pv[a], Pv[a + 1]); W.y = cvtpk(Pv[a + 2], Pv[a + 3]); } else { W.z = cvtpk(Pv[a], Pv[a + 1]); W.w = cvtpk(Pv[a + 2], Pv[a + 3]); } } while (0)
#define SB() __builtin_amdgcn_sched_barrier(0)
#define QKP(d0, C0, C1) do { pn0 = __builtin_amdgcn_mfma_f32_32x32x16_bf16(kf[2 * (d0)], qf[d0], C0, 0, 0, 0); pn1 = __builtin_amdgcn_mfma_f32_32x32x16_bf16(kf[2 * (d0) + 1], qf[d0], C1, 0, 0, 0); } while (0)
#define PVP(kk, W) do { const bf16x8 pb_ = __builtin_bit_cast(bf16x8, W); o0 = __builtin_amdgcn_mfma_f32_32x32x16_bf16(vf[2 * (kk)], pb_, o0, 0, 0, 0); o1 = __builtin_amdgcn_mfma_f32_32x32x16_bf16(vf[2 * (kk) + 1], pb_, o1, 0, 0, 0); } while (0)
#define KR1(j) (kf[j] = *(const LAS bf16x8*)(kt_ + (32 * ((j) & 1) + r32) * KP + ((j) >> 1) * 32 + hi * 16))
#define VR1(i) (vf[i] = *(const LAS bf16x8*)(vt_ + (32 * ((i) & 1) + r32) * VP + ((i) >> 1) * 32 + hi * 16))
#define EX2(Pv, a, Wd) do { Pv[a] = __builtin_amdgcn_exp2f(Pv[a]); Pv[a + 1] = __builtin_amdgcn_exp2f(Pv[a + 1]); sacc += Pv[a]; sacc += Pv[a + 1]; Wd = cvtpk(Pv[a], Pv[a + 1]); } while (0)
#define QK1(j, C) do { if ((j) & 1) pn1 = __builtin_amdgcn_mfma_f32_32x32x16_bf16(kf[j], qf[(j) >> 1], C, 0, 0, 0); else pn0 = __builtin_amdgcn_mfma_f32_32x32x16_bf16(kf[j], qf[(j) >> 1], C, 0, 0, 0); } while (0)
#define PV1(i, W) do { const bf16x8 pb_ = __builtin_bit_cast(bf16x8, W); if ((i) & 1) o1 = __builtin_amdgcn_mfma_f32_32x32x16_bf16(vf[i], pb_, o1, 0, 0, 0); else o0 = __builtin_amdgcn_mfma_f32_32x32x16_bf16(vf[i], pb_, o0, 0, 0, 0); } while (0)
                if (ND0 == 6) {
                    KR1(0); KR1(1); KR1(2); KR1(3); SB();
                    QK1(0, negm); EX2(pc0, 0, w0.x); KR1(4); SB();
                    QK1(1, negm); EX2(pc0, 2, w0.y); KR1(5); SB();
                    QK1(2, pn0); EX2(pc0, 4, w0.z); KR1(6); SB();
                    QK1(3, pn1); EX2(pc0, 6, w0.w); KR1(7); SB();
                    QK1(4, pn0); EX2(pc0, 8, w1.x); KR1(8); SB();
                    QK1(5, pn1); EX2(pc0, 10, w1.y); KR1(9); SB();
                    QK1(6, pn0); EX2(pc0, 12, w1.z); KR1(10); SB();
                    QK1(7, pn1); EX2(pc0, 14, w1.w); KR1(11); SB();
                    QK1(8, pn0); EX2(pc1, 0, w2.x); VR1(0); SB();
                    QK1(9, pn1); EX2(pc1, 2, w2.y); VR1(1); SB();
                    QK1(10, pn0); EX2(pc1, 4, w2.z); VR1(2); SB();
                    QK1(11, pn1); EX2(pc1, 6, w2.w); VR1(3); SB();
                } else {
                    KR1(0); KR1(1); KR1(2); KR1(3); SB();
                    QK1(0, negm); EX2(pc0, 0, w0.x); EX2(pc0, 2, w0.y); KR1(4); SB();
                    QK1(1, negm); EX2(pc0, 4, w0.z); EX2(pc0, 6, w0.w); KR1(5); SB();
                    QK1(2, pn0); EX2(pc0, 8, w1.x); EX2(pc0, 10, w1.y); KR1(6); SB();
                    QK1(3, pn1); EX2(pc0, 12, w1.z); EX2(pc0, 14, w1.w); KR1(7); SB();
                    QK1(4, pn0); EX2(pc1, 0, w2.x); VR1(0); SB();
                    QK1(5, pn1); EX2(pc1, 2, w2.y); VR1(1); SB();
                    QK1(6, pn0); EX2(pc1, 4, w2.z); VR1(2); SB();
                    QK1(7, pn1); EX2(pc1, 6, w2.w); VR1(3); SB();
                }
                PV1(0, w0); EX2(pc1, 8, w3.x); VR1(4); SB();
                PV1(1, w0); EX2(pc1, 10, w3.y); VR1(5); SB();
                PV1(2, w1); EX2(pc1, 12, w3.z); VR1(6); SB();
                PV1(3, w1); EX2(pc1, 14, w3.w); VR1(7); SB();
                lrun += sacc;
                PV1(4, w2); MASK_TILE(pn0, pn1, t + 1); SB();
                PV1(5, w2); SB();
                PV1(6, w3); SB();
                PV1(7, w3); rmn = rowmax32(pn0, pn1); if (!USE_NEGM) rmn -= mref; SB();
#undef KR1
#undef VR1
#undef EX2
#undef QK1
#undef PV1
#undef KRD
#undef VRD
#undef EX4
#undef SB
#undef QKP
#undef PVP
            } else {
            if (need_n) QK_TILE(pn0, pn1, (t + 1) & 1, negm);
            if (need_c) {
                float sum = 0.f;
#pragma unroll
                for (int r = 0; r < 16; ++r) { if (!USE_NEGM) { pc0[r] -= mref; pc1[r] -= mref; } pc0[r] = __builtin_amdgcn_exp2f(pc0[r]); pc1[r] = __builtin_amdgcn_exp2f(pc1[r]); sum += pc0[r]; sum += pc1[r]; }
                lrun += sum;
                bf16x8 pk[4];
                { u32x4 a; a.x = cvtpk(pc0[0], pc0[1]); a.y = cvtpk(pc0[2], pc0[3]); a.z = cvtpk(pc0[4], pc0[5]); a.w = cvtpk(pc0[6], pc0[7]); pk[0] = __builtin_bit_cast(bf16x8, a); }
                { u32x4 a; a.x = cvtpk(pc0[8], pc0[9]); a.y = cvtpk(pc0[10], pc0[11]); a.z = cvtpk(pc0[12], pc0[13]); a.w = cvtpk(pc0[14], pc0[15]); pk[1] = __builtin_bit_cast(bf16x8, a); }
                { u32x4 a; a.x = cvtpk(pc1[0], pc1[1]); a.y = cvtpk(pc1[2], pc1[3]); a.z = cvtpk(pc1[4], pc1[5]); a.w = cvtpk(pc1[6], pc1[7]); pk[2] = __builtin_bit_cast(bf16x8, a); }
                { u32x4 a; a.x = cvtpk(pc1[8], pc1[9]); a.y = cvtpk(pc1[10], pc1[11]); a.z = cvtpk(pc1[12], pc1[13]); a.w = cvtpk(pc1[14], pc1[15]); pk[3] = __builtin_bit_cast(bf16x8, a); }
                const LAS unsigned char* vt = lds + (t & 1) * ABUF + KT_BYTES;
#pragma unroll
                for (int kk = 0; kk < 4; ++kk) {
                    const bf16x8 v0 = *(const LAS bf16x8*)(vt + r32 * VP + kk * 32 + hi * 16);
                    const bf16x8 v1 = *(const LAS bf16x8*)(vt + (32 + r32) * VP + kk * 32 + hi * 16);
                    o0 = __builtin_amdgcn_mfma_f32_32x32x16_bf16(v0, pk[kk], o0, 0, 0, 0);
                    o1 = __builtin_amdgcn_mfma_f32_32x32x16_bf16(v1, pk[kk], o1, 0, 0, 0);
                }
            }
            if (need_n) { MASK_TILE(pn0, pn1, t + 1); rmn = rowmax32(pn0, pn1); if (!USE_NEGM) rmn -= mref; }
            }
            if (hn) { STOREK(t & 1); STOREV((t + 1) & 1); }
            __syncthreads();
            pc0 = pn0; pc1 = pn1; rmc = rmn; need_c = need_n;
        }
#undef TILE_KPOS
#undef LOADK
#undef LOADV
#undef STOREK
#undef STOREV
#undef NEED
#undef QK_TILE
#undef MASK_TILE
        const float lt = lrun + shfl_xor_l(lrun, 32, lane), inv = 1.f / lt;
        LAS unsigned char* stg = lds + ATT_OSTAGE_OFF + w * (32 * 144);
#pragma unroll
        for (int g = 0; g < 4; ++g) {
            u32x2 a; a.x = cvtpk(o0[4 * g] * inv, o0[4 * g + 1] * inv); a.y = cvtpk(o0[4 * g + 2] * inv, o0[4 * g + 3] * inv); *(LAS u32x2*)(stg + r32 * 144 + (8 * g + 4 * hi) * 2) = a;
            u32x2 c; c.x = cvtpk(o1[4 * g] * inv, o1[4 * g + 1] * inv); c.y = cvtpk(o1[4 * g + 2] * inv, o1[4 * g + 3] * inv); *(LAS u32x2*)(stg + r32 * 144 + (32 + 8 * g + 4 * hi) * 2) = c;
        }
        asm volatile("s_waitcnt lgkmcnt(0)" ::: "memory");
        { bf16_t* ob = P.O + (size_t)(qrow + (lane >> 3)) * DM + hq * 64 + (lane & 7) * 8;
#pragma unroll
          for (int i = 0; i < 4; ++i) { const u32x4 v = *(const LAS u32x4*)(stg + (i * 8 + (lane >> 3)) * 144 + (lane & 7) * 16); *(u32x4*)(ob + (size_t)i * 8 * DM) = v; } }
    }
}

constexpr size_t MiB = 1u << 20;
constexpr size_t WS_BAR = 983040  ;
constexpr size_t WS_MOD = 0, WS_SSQ = 1 * MiB, WS_ROPE16 = 3 * MiB, WS_ROPE32 = 4 * MiB, WS_KPE = 6 * MiB, WS_XC = 12 * MiB;
constexpr size_t WS_W1T = 20 * MiB, WS_W2T = 52 * MiB, WS_MLA = 84 * MiB  , WS_SWA = 94 * MiB  , WS_NA = 99 * MiB  ;
constexpr size_t WS_H = 108 * MiB, WS_Q = 240 * MiB, WS_K = 438 * MiB, WS_VT = 570 * MiB, WS_O = 702 * MiB, WS_LAT = 702 * MiB, WS_HID = 240 * MiB, WS_NBIAS = 834 * MiB  , WS_SSQN = 836 * MiB  , WS_PART_O = 240 * MiB  , WS_PART_M = 768 * MiB  ,
    WS_XH = 840 * MiB  , WS_END = 968 * MiB;

#define XB_TMO      128
#define XB_XCNT(j)  (256  + 64 * (j))
#define XB_XSUB(j)  (1280 + 64 * (j))
#define XB_XGEN(j)  (2304 + 64 * (j))
#define XB_TOP      3328
#define XB_TOPGEN   3392
#define XCD_BAR_WORDS 3456
#define XB_SPIN_CAP (1u << 18)
__device__ __forceinline__ unsigned xb_ld(unsigned* p)              { return __hip_atomic_load(p, __ATOMIC_RELAXED, __HIP_MEMORY_SCOPE_AGENT); }
__device__ __forceinline__ unsigned xb_add(unsigned* p, unsigned v) { return __hip_atomic_fetch_add(p, v, __ATOMIC_RELAXED, __HIP_MEMORY_SCOPE_AGENT); }
__device__ __forceinline__ unsigned xb_xcc_id() { return (unsigned)__builtin_amdgcn_s_getreg((3 << 11) | 20) & 0xFu; }
#define XB_SPIN(cond, bar) do { unsigned _sp = 0; while (cond) { __builtin_amdgcn_s_sleep(1); \
    if ((++_sp & 255u) == 0u) { if (xb_ld(&(bar)[XB_TMO])) break; if (_sp > XB_SPIN_CAP) { atomicAdd(&(bar)[XB_TMO], 1u); break; } } } } while (0)
struct XcdBarrier { unsigned* bar; unsigned x; volatile LAS unsigned* st; };
__device__ __forceinline__ XcdBarrier xcd_barrier_post(unsigned* bar, volatile LAS unsigned* st, bool t0) {
    XcdBarrier b; b.bar = bar; b.x = xb_xcc_id(); b.st = st;
    if (t0) (void)xb_add(&bar[XB_XCNT(b.x)], 1u);
    return b;
}
__device__ __forceinline__ void xcd_barrier_complete(unsigned* bar, unsigned x, unsigned& nloc, unsigned& nx) {
    const unsigned G = gridDim.x * gridDim.y * gridDim.z;
    unsigned sum, cnt, mine, sp = 0u;
    for (;;) {
        sum = 0u; cnt = 0u; mine = 0u;
#pragma unroll
        for (unsigned j = 0; j < 16; ++j) { const unsigned c = xb_ld(&bar[XB_XCNT(j)]); sum += c; cnt += (c > 0u) ? 1u : 0u; mine = (j == x) ? c : mine; }
        if (sum == G) break;
        __builtin_amdgcn_s_sleep(1);
        if ((++sp & 255u) == 0u) { if (xb_ld(&bar[XB_TMO])) break; if (sp > XB_SPIN_CAP) { atomicAdd(&bar[XB_TMO], 1u); break; } }
    }
    nloc = mine > 0u ? mine : 1u; nx = cnt > 0u ? cnt : 1u;
}
__device__ __forceinline__ void xcd_barrier(const XcdBarrier& b, bool t0) {
    asm volatile("s_waitcnt vmcnt(0)" ::: "memory");
    __syncthreads();
    if (t0) {
        unsigned* bar = b.bar; unsigned bx = b.x; asm volatile("" : "+s"(bar), "+s"(bx));
        __builtin_amdgcn_s_waitcnt(0);
        unsigned nloc = b.st[0], nx = b.st[1];
        if (nloc == 0u) { xcd_barrier_complete(bar, bx, nloc, nx); b.st[0] = nloc; b.st[1] = nx; }
        const unsigned old = xb_add(&bar[XB_XSUB(bx)], 1u);
        const unsigned gen = old / nloc;
        if (old + 1u == (gen + 1u) * nloc) {
            __builtin_amdgcn_fence(__ATOMIC_RELEASE, "agent");
            asm volatile("s_waitcnt vmcnt(0)" ::: "memory");
            const unsigned og = xb_add(&bar[XB_TOP], 1u);
            const unsigned tg = og / nx;
            if (og + 1u == (tg + 1u) * nx) xb_add(&bar[XB_TOPGEN], 1u);
            else XB_SPIN(xb_ld(&bar[XB_TOPGEN]) == tg, bar);
            __builtin_amdgcn_fence(__ATOMIC_ACQUIRE, "agent");
            xb_add(&bar[XB_XGEN(bx)], 1u);
            asm volatile("s_waitcnt vmcnt(0)" ::: "memory");
        } else {
            XB_SPIN(xb_ld(&bar[XB_XGEN(bx)]) == gen, bar);
            __builtin_amdgcn_fence(__ATOMIC_ACQUIRE, "agent");
            asm volatile("s_waitcnt vmcnt(0)" ::: "memory");
        }
    }
    __syncthreads();
}

__device__ __forceinline__ float wave_sum(float v, int lane) {
#pragma unroll
    for (int o = 1; o < 64; o <<= 1) v += shfl_xor_l(v, o, lane);
    return v;
}
__device__ __forceinline__ void sincos_red(float x, float& sn, float& cs) {
    const float n = rintf(x * 0.15915494309189535f);
    float r = fmaf(-n, 6.2831854820251465f, x); r = fmaf(-n, -1.7484555e-7f, r);
    const float rev = r * 0.15915494309189535f;
    sn = __builtin_amdgcn_sinf(rev); cs = __builtin_amdgcn_cosf(rev);
}
__device__ __forceinline__ void transpose_item(const float* W, int K, int N, bf16_t* WT, const float* g, LAS float* scr, int item, int lane) {
    const int nblk = N / 32, kb = item / nblk, nb = item % nblk, k0 = 64 * kb, n0 = 32 * nb;
#pragma unroll 8
    for (int i = 0; i < 32; ++i) { const int kk = 2 * i + (lane >> 5); float v = W[(size_t)(k0 + kk) * N + n0 + (lane & 31)]; if (g) v *= g[k0 + kk]; scr[kk * 33 + (lane & 31)] = v; }
    asm volatile("s_waitcnt lgkmcnt(0)" ::: "memory");
    const int c = lane & 7;
#pragma unroll
    for (int j = 0; j < 4; ++j) { const int n = (lane >> 3) + 8 * j; const LAS float* s = scr + (8 * c) * 33 + n;
        u32x4 o; o.x = cvtpk(s[0 * 33], s[1 * 33]); o.y = cvtpk(s[2 * 33], s[3 * 33]); o.z = cvtpk(s[4 * 33], s[5 * 33]); o.w = cvtpk(s[6 * 33], s[7 * 33]);
        *(u32x4*)(WT + (size_t)(n0 + n) * K + k0 + 8 * c) = o; }
    asm volatile("s_waitcnt lgkmcnt(0)" ::: "memory");
}

struct Args { const float* in[23]; float* out; unsigned char* ws; };

__device__ __forceinline__ void norm_pass0(const float* xl, const float* xc, const float* g, const float* mod, int sc_off, bf16_t* H, float* ssq, int gw, int NGW) {
    int lane = lane_id(); asm volatile("" : "+v"(lane));
    for (int row = gw; row < MT; row += NGW) {
        const bool isctx = row >= ML;
        const float* xr = isctx ? xc + (size_t)(row - ML) * DM : xl + (size_t)row * DM;
        const float* mp = mod + (isctx ? 8 : (row >> 13)) * 6144;
        f32x4 v[4]; float ss = 0.f;
#pragma unroll
        for (int j = 0; j < 4; ++j) { v[j] = *(const f32x4*)(xr + 8 * lane + 512 * (j >> 1) + 4 * (j & 1)); ss += (v[j][0] * v[j][0] + v[j][1] * v[j][1]) + (v[j][2] * v[j][2] + v[j][3] * v[j][3]); }
        ss = wave_sum(ss, lane);
        if (lane == 0) ssq[row] = ss;
#pragma unroll
        for (int h = 0; h < 2; ++h) { const int col = 8 * lane + 512 * h;
            const f32x4 g0 = *(const f32x4*)(g + col), g1 = *(const f32x4*)(g + col + 4), s0 = *(const f32x4*)(mp + sc_off + col), s1 = *(const f32x4*)(mp + sc_off + col + 4);
            const f32x4 y0 = v[2 * h] * g0 * (s0 + 1.f), y1 = v[2 * h + 1] * g1 * (s1 + 1.f);
            u32x4 o; o.x = cvtpk(y0[0], y0[1]); o.y = cvtpk(y0[2], y0[3]); o.z = cvtpk(y1[0], y1[1]); o.w = cvtpk(y1[2], y1[3]); *(u32x4*)(H + (size_t)row * DM + col) = o; }
    }
}
__device__ __forceinline__ void norm_ctx(float* xc, const float* part, const float* gate8, const float* g, const float* sc, bf16_t* Hc, float* ssqc, int gw, int NGW) {
    int lane = lane_id(); asm volatile("" : "+v"(lane));
    for (int row = gw; row < MC; row += NGW) {
        float* xr = xc + (size_t)row * DM;
        f32x4 v[4]; float ss = 0.f;
#pragma unroll
        for (int j = 0; j < 4; ++j) { const int col = 4 * lane + 256 * j;
            f32x4 p = *(const f32x4*)(part + (size_t)row * DM + col);
#pragma unroll
            for (int kc = 1; kc < 8; ++kc) p += *(const f32x4*)(part + ((size_t)kc * MC + row) * DM + col);
            v[j] = *(const f32x4*)(xr + col) + *(const f32x4*)(gate8 + col) * p;
            *(f32x4*)(xr + col) = v[j];
            ss += (v[j][0] * v[j][0] + v[j][1] * v[j][1]) + (v[j][2] * v[j][2] + v[j][3] * v[j][3]); }
        ss = wave_sum(ss, lane);
        if (lane == 0) ssqc[row] = ss;
#pragma unroll
        for (int j = 0; j < 4; ++j) { const int col = 4 * lane + 256 * j;
            const f32x4 gg = *(const f32x4*)(g + col), s4 = *(const f32x4*)(sc + col);
            const f32x4 y = v[j] * gg * (s4 + 1.f);
            u32x2 o; o.x = cvtpk(y[0], y[1]); o.y = cvtpk(y[2], y[3]); *(u32x2*)(Hc + (size_t)row * DM + col) = o; }
    }
}
__device__ __forceinline__ void nbias_item(LAS unsigned char* lds, const float* W, int N, int n0, const float* mod, int sh_off, float* out, int wave, int lane) {
    LAS float* shl = (LAS float*)(lds + 65536); LAS float* red = (LAS float*)(lds + 102400);
    const int tid = wave * 64 + lane;
    for (int i = tid; i < 9 * 1024; i += 512) shl[i] = mod[(i >> 10) * 6144 + sh_off + (i & 1023)];
    __syncthreads();
    const int n = n0 + lane; const bool ok = n < N;
    const float* Wp = W + (ok ? n : 0);
    float s0 = 0, s1 = 0, s2 = 0, s3 = 0, s4 = 0, s5 = 0, s6 = 0, s7 = 0, s8 = 0;
#pragma unroll 8
    for (int k = wave * 128; k < wave * 128 + 128; ++k) { const float wv = Wp[(size_t)k * N];
        s0 += shl[k] * wv; s1 += shl[1024 + k] * wv; s2 += shl[2048 + k] * wv; s3 += shl[3072 + k] * wv; s4 += shl[4096 + k] * wv;
        s5 += shl[5120 + k] * wv; s6 += shl[6144 + k] * wv; s7 += shl[7168 + k] * wv; s8 += shl[8192 + k] * wv; }
    LAS float* rp = red + wave * 576 + lane;
    rp[0] = s0; rp[64] = s1; rp[128] = s2; rp[192] = s3; rp[256] = s4; rp[320] = s5; rp[384] = s6; rp[448] = s7; rp[512] = s8;
    __syncthreads();
    for (int i = tid; i < 576; i += 512) { float sum = 0.f;
#pragma unroll
        for (int ww = 0; ww < 8; ++ww) sum += red[ww * 576 + i];
        const int b = i >> 6, l = i & 63; if (n0 + l < N) out[b * 4096 + n0 + l] = sum; else if (n0 + l < 4096) out[b * 4096 + n0 + l] = 0.f; }
    __syncthreads();
}

__global__ void __launch_bounds__(512, 2) fwd_megakernel(Args a) {
    extern __shared__ __attribute__((aligned(16))) unsigned char lds_raw[];
    LAS unsigned char* lds = (LAS unsigned char*)lds_raw;
    cg::grid_group grid = cg::this_grid();
    const int wave = __builtin_amdgcn_readfirstlane((int)threadIdx.x >> 6);
    const int G = gridDim.x, bid = blockIdx.x;
    const int vcu = (G % 8 == 0) ? (bid % 8) * (G / 8) + bid / 8 : bid;
    const int gw = vcu * 8 + wave, NGW = G * 8;
    unsigned char* ws = a.ws;
    volatile LAS unsigned* bar_st = (volatile LAS unsigned*)(lds + 131072 + 64);
    if (wave == 0 && lane_id() < 2) bar_st[lane_id()] = 0u;
    __syncthreads();
    XcdBarrier xbar = xcd_barrier_post((unsigned*)(ws + WS_BAR), bar_st, wave == 0 && lane_id() == 0);
#define GRID_BAR() xcd_barrier(xbar, wave == 0 && lane_id() == 0)
    const float* x_in = a.in[0]; const float* c_in = a.in[1]; const float* ctx_in = a.in[2]; const float* cctx_in = a.in[3];
    const float* ada_w = a.in[4]; const float* ada_b = a.in[5]; const float* norm_mix_g = a.in[6]; const float* norm_mlp_g = a.in[7]; const float* norm_out_g = a.in[8];
    float* MOD = (float*)(ws + WS_MOD); float* SSQ = (float*)(ws + WS_SSQ);
    float* ROPE16 = (float*)(ws + WS_ROPE16); float* ROPE32 = (float*)(ws + WS_ROPE32);
    bf16_t* KPE = (bf16_t*)(ws + WS_KPE); float* XC = (float*)(ws + WS_XC);
    bf16_t* H = (bf16_t*)(ws + WS_H); bf16_t* Qb = (bf16_t*)(ws + WS_Q); bf16_t* Kb = (bf16_t*)(ws + WS_K); bf16_t* VTb = (bf16_t*)(ws + WS_VT);
    bf16_t* Ob = (bf16_t*)(ws + WS_O); bf16_t* LAT = (bf16_t*)(ws + WS_LAT); bf16_t* HID = (bf16_t*)(ws + WS_HID);
    _Float16* Xh = (_Float16*)(ws + WS_XH);
    float* NBIAS = (float*)(ws + WS_NBIAS); float* SSQN = (float*)(ws + WS_SSQN); float* PART_O = (float*)(ws + WS_PART_O); float* PART_M = (float*)(ws + WS_PART_M);

    {
        const int lane = lane_id(), tid = wave * 64 + lane;
        LAS float* act = (LAS float*)(lds + 65536); LAS float* red = (LAS float*)(lds + 102400);
        for (int i = tid; i < 9 * 1024; i += 512) { const int b = i >> 10, k = i & 1023; const float v = b < 8 ? c_in[b * 1024 + k] : cctx_in[k]; act[i] = v / (1.f + __builtin_amdgcn_exp2f(-v * LOG2E)); }
        __syncthreads();
        for (int it = bid; it < 384; it += G) {
            const int layer = it / 96, n0 = (it % 96) * 64;
            const float* W = ada_w + (size_t)layer * 1024 * 6144 + n0 + lane;
            float s0 = 0, s1 = 0, s2 = 0, s3 = 0, s4 = 0, s5 = 0, s6 = 0, s7 = 0, s8 = 0;
#pragma unroll 8
            for (int k = wave * 128; k < wave * 128 + 128; ++k) { const float wv = W[(size_t)k * 6144];
                s0 += act[k] * wv; s1 += act[1024 + k] * wv; s2 += act[2048 + k] * wv; s3 += act[3072 + k] * wv; s4 += act[4096 + k] * wv;
                s5 += act[5120 + k] * wv; s6 += act[6144 + k] * wv; s7 += act[7168 + k] * wv; s8 += act[8192 + k] * wv; }
            LAS float* rp = red + wave * 576 + lane;
            rp[0] = s0; rp[64] = s1; rp[128] = s2; rp[192] = s3; rp[256] = s4; rp[320] = s5; rp[384] = s6; rp[448] = s7; rp[512] = s8;
            __syncthreads();
            for (int i = tid; i < 576; i += 512) { float s = 0.f;
#pragma unroll
                for (int ww = 0; ww < 8; ++ww) s += red[ww * 576 + i];
                const int b = i >> 6, l = i & 63; MOD[((size_t)layer * 9 + b) * 6144 + n0 + l] = s + ada_b[layer * 6144 + n0 + l]; }
            __syncthreads();
        }
        __syncthreads();
        LAS float* scr = (LAS float*)(lds + wave * 16384);
        int base = 0;
#define TR(Wsrc, K_, N_, dst, gsc) do { const int n_ = ((K_) / 64) * ((N_) / 32); \
            for (int it_ = (gw + NGW - (base % NGW)) % NGW; it_ < n_; it_ += NGW) transpose_item((Wsrc), (K_), (N_), (dst), (gsc), scr, it_, lane); base += n_; } while (0)
        for (int L = 0; L < 4; ++L) {
            TR(a.in[9] + (size_t)L * DM * FF, DM, FF, (bf16_t*)(ws + WS_W1T + (size_t)L * 8 * MiB), (const float*)nullptr);
            TR(a.in[10] + (size_t)L * FF * DM, FF, DM, (bf16_t*)(ws + WS_W2T + (size_t)L * 8 * MiB), (const float*)nullptr);
        }
        for (int j = 0; j < 2; ++j) {
            unsigned char* mb = ws + WS_MLA + (size_t)j * 5 * MiB;
            TR(a.in[11] + (size_t)j * DM * 416, DM, 416, (bf16_t*)mb, (const float*)nullptr);
            TR(a.in[13] + (size_t)j * 256 * 1536, 256, 1536, (bf16_t*)(mb + 1 * MiB), a.in[12] + j * 256);
            TR(a.in[15] + (size_t)j * 128 * 2048, 128, 2048, (bf16_t*)(mb + 1 * MiB + 768 * 1024), a.in[14] + j * 128);
            TR(a.in[16] + (size_t)j * DM * DM, DM, DM, (bf16_t*)(mb + 3 * MiB), (const float*)nullptr);
            u32x4* z = (u32x4*)(mb + (size_t)416 * 1024 * 2);
            for (int i = gw * 64 + lane; i < 96 * 1024 * 2 / 16; i += NGW * 64) z[i] = (u32x4){0u, 0u, 0u, 0u};
        }
        TR(a.in[17], DM, 1536, (bf16_t*)(ws + WS_SWA), (const float*)nullptr);
        TR(a.in[19], DM, DM, (bf16_t*)(ws + WS_SWA + 3 * MiB), (const float*)nullptr);
        TR(a.in[20], DM, 3072, (bf16_t*)(ws + WS_NA), (const float*)nullptr);
        TR(a.in[22], DM, DM, (bf16_t*)(ws + WS_NA + 6 * MiB), (const float*)nullptr);
#undef TR
        for (int i = gw * 64 + lane; i < 8192 * 16; i += NGW * 64) { const int t = i >> 4, p = i & 15; const int f = p & 7; const float pos = (float)(p < 8 ? (t >> 6) : (t & 63));
            const float ang = pos * __builtin_amdgcn_exp2f(-(float)f * (13.287712379549449f / 8.f)); float sn, cs; sincos_red(ang, sn, cs); ROPE16[2 * i] = cs; ROPE16[2 * i + 1] = sn; }
        for (int i = gw * 64 + lane; i < 8192 * 32; i += NGW * 64) { const int t = i >> 5, p = i & 31; const int f = p & 15; const float pos = (float)(p < 16 ? (t >> 6) : (t & 63));
            const float ang = pos * __builtin_amdgcn_exp2f(-(float)f * (13.287712379549449f / 16.f)); float sn, cs; sincos_red(ang, sn, cs); ROPE32[2 * i] = cs; ROPE32[2 * i + 1] = sn; }
        for (int i = gw * 64 + lane; i < 4 * MT; i += NGW * 64) SSQ[i] = 0.f;
        for (int i = gw * 64 + lane; i < 8 * MT; i += NGW * 64) SSQN[i] = 0.f;
    }
    grid.sync();
    {
        const int lane = lane_id();
        for (int it = bid; it < 8 + 24 + 48 + 8 + 256; it += G) {
            int r = it; const float* W; int N, L, which, blk;
            if (r < 8) { W = a.in[11]; N = 416; L = 0; which = 0; blk = r; }
            else if ((r -= 8) < 24) { W = a.in[17]; N = 1536; L = 1; which = 0; blk = r; }
            else if ((r -= 24) < 48) { W = a.in[20]; N = 3072; L = 2; which = 0; blk = r; }
            else if ((r -= 48) < 8) { W = a.in[11] + (size_t)DM * 416; N = 416; L = 3; which = 0; blk = r; }
            else { r -= 8; L = r >> 6; blk = r & 63; W = a.in[9] + (size_t)L * DM * FF; N = FF; which = 1; }
            nbias_item(lds, W, N, blk * 64, MOD + (size_t)L * 9 * 6144, which ? 3072 : 0, NBIAS + (size_t)(L * 2 + which) * 9 * 4096, wave, lane);
        }
        norm_pass0(x_in, ctx_in, norm_mix_g, MOD, 1024, H, SSQN, gw, NGW);
        for (int i = gw * 64 + lane; i < MC * DM / 4; i += NGW * 64) ((f32x4*)XC)[i] = ((const f32x4*)ctx_in)[i];
    }
    GRID_BAR();

    for (int L = 0; L < 4; ++L) {
        const int kind = L % 3, jl = L / 3; const bool last = (L == 3);
        const float* modL = MOD + (size_t)L * 9 * 6144;
        const float* ssqn1 = SSQN + (size_t)(2 * L) * MT; const float* nbias1 = NBIAS + (size_t)(L * 2) * 9 * 4096;
        if (kind == 0) {
            unsigned char* mb = ws + WS_MLA + (size_t)jl * 5 * MiB;
            float* ssq_q = SSQ + (size_t)jl * 2 * MT; float* ssq_kv = ssq_q + MT;
            {
                pg8::Gemm g{H, (const bf16_t*)mb, MT, 512, DM, DM, DM}; pg8::StaticOrder S; S.init(MT, 512, G, bid);
                EpiLat E{LAT, ssq_q, ssq_kv, KPE, ROPE16, ssqn1, nbias1};
                pg8::gemm_phase<EpiLat, pg8::StaticOrder, true>(lds, g, S, E, wave);
            }
            GRID_BAR();
            {
                pg8::Gemm g{LAT, (const bf16_t*)(mb + 1 * MiB), MT, 1536, 256, 512, 256}; pg8::StaticOrder S; S.init(MT, 1536, G, bid);
                EpiProj<0> E{Qb, nullptr, nullptr, ROPE16, ssq_q, 0.10206207261596577f * LOG2E, nullptr};
                pg8::gemm_phase<EpiProj<0>, pg8::StaticOrder, true>(lds, g, S, E, wave);
            }
            {
                pg8::Gemm g{LAT + 256, (const bf16_t*)(mb + 1 * MiB + 768 * 1024), MT, 2048, 128, 512, 128}; pg8::StaticOrder S; S.init(MT, 2048, G, bid);
                EpiProj<1> E{nullptr, Kb, VTb, nullptr, ssq_kv, 1.f, nullptr};
                pg8::gemm_phase<EpiProj<1>, pg8::StaticOrder, true>(lds, g, S, E, wave);
            }
        } else if (kind == 1) {
            pg8::Gemm g{H, (const bf16_t*)(ws + WS_SWA), MT, 1536, DM, DM, DM}; pg8::StaticOrder S; S.init(MT, 1536, G, bid);
            EpiProj<2> E{Qb, Kb, VTb, ROPE32, ssqn1, 0.125f * LOG2E, nbias1};
            pg8::gemm_phase<EpiProj<2>, pg8::StaticOrder, true>(lds, g, S, E, wave);
        } else {
            pg8::Gemm g{H, (const bf16_t*)(ws + WS_NA), MT, 3072, DM, DM, DM}; pg8::StaticOrder S; S.init(MT, 3072, G, bid);
            EpiProj<3> E{Qb, Kb, VTb, nullptr, ssqn1, 0.125f * LOG2E, nbias1};
            pg8::gemm_phase<EpiProj<3>, pg8::StaticOrder, true>(lds, g, S, E, wave);
        }
        GRID_BAR();
        {
            AttnP P{Qb, Kb, KPE, VTb, Ob, a.in[18], a.in[21], last ? 4096 : 4096 + 128};
            if (kind == 0) attn_phase<0>(lds, P, vcu, G, wave);
            else if (kind == 1) attn_phase<1>(lds, P, vcu, G, wave);
            else attn_phase<2>(lds, P, vcu, G, wave);
        }
        GRID_BAR();
        const int Mres = last ? ML : MT;
        {
            const bf16_t* wo = (const bf16_t*)(kind == 0 ? ws + WS_MLA + (size_t)jl * 5 * MiB + 3 * MiB : (kind == 1 ? ws + WS_SWA + 3 * MiB : ws + WS_NA + 6 * MiB));
            {
                pg8::Gemm g{Ob, wo, ML, DM, DM, DM, DM}; pg8::StaticOrder S; S.init(ML, DM, G, bid);
                EpiResid E{L == 0 ? x_in : nullptr, Xh, Xh, modL + 2048, H, norm_mlp_g + L * DM, modL + 4096, SSQN + (size_t)(2 * L + 1) * MT};
                pg8::gemm_phase<EpiResid, pg8::StaticOrder, true>(lds, g, S, E, wave);
            }
            if (!last) {
                pg8::Gemm g{Ob, wo, MT, DM, 128, DM, DM}; pg8::CtxSplitOrder S{bid, G, 128};
                EpiCtxPartial E{PART_O, 128};
                pg8::gemm_phase<EpiCtxPartial, pg8::CtxSplitOrder, true>(lds, g, S, E, wave);
            }
        }
        GRID_BAR();
        if (!last) { norm_ctx(XC, PART_O, modL + 2048 + 8 * 6144, norm_mlp_g + L * DM, modL + 8 * 6144 + 4096, H + (size_t)ML * DM, SSQN + (size_t)(2 * L + 1) * MT + ML, gw, NGW); GRID_BAR(); }
        {
            pg8::Gemm g{H, (const bf16_t*)(ws + WS_W1T + (size_t)L * 8 * MiB), Mres, FF, DM, DM, DM}; pg8::StaticOrder S; S.init(Mres, FF, G, bid);
            EpiSqRelu E{HID, FF, SSQN + (size_t)(2 * L + 1) * MT, NBIAS + (size_t)(L * 2 + 1) * 9 * 4096};
            pg8::gemm_phase<EpiSqRelu, pg8::StaticOrder, true>(lds, g, S, E, wave);
        }
        GRID_BAR();
        {
            const bf16_t* w2t = (const bf16_t*)(ws + WS_W2T + (size_t)L * 8 * MiB);
            {
                pg8::Gemm g{HID, w2t, ML, DM, FF, FF, FF}; pg8::StaticOrder S; S.init(ML, DM, G, bid);
                EpiResid E{nullptr, Xh, Xh, modL + 5120, last ? nullptr : H, norm_mix_g + (L + 1) * DM, MOD + (size_t)(L + 1) * 9 * 6144 + 1024, SSQN + (size_t)(2 * L + 2) * MT};
                pg8::gemm_phase<EpiResid, pg8::StaticOrder, true>(lds, g, S, E, wave);
            }
            if (!last) {
                pg8::Gemm g{HID, w2t, MT, DM, 512, FF, FF}; pg8::CtxSplitOrder S{bid, G, 512};
                EpiCtxPartial E{PART_M, 512};
                pg8::gemm_phase<EpiCtxPartial, pg8::CtxSplitOrder, true>(lds, g, S, E, wave);
            }
        }
        GRID_BAR();
        if (!last) { norm_ctx(XC, PART_M, modL + 5120 + 8 * 6144, norm_mix_g + (L + 1) * DM, MOD + (size_t)(L + 1) * 9 * 6144 + 8 * 6144 + 1024, H + (size_t)ML * DM, SSQN + (size_t)(2 * L + 2) * MT + ML, gw, NGW); GRID_BAR(); }
    }
    int lane = lane_id(); asm volatile("" : "+v"(lane));
    for (int row = gw; row < ML; row += NGW) {
        const _Float16* xh = Xh + (size_t)row * DM; float* xr = a.out + (size_t)row * DM;
        f32x4 v[4]; float ss = 0.f;
#pragma unroll
        for (int h = 0; h < 2; ++h) { const h16x8 hv = *(const h16x8*)(xh + 8 * lane + 512 * h);
            v[2 * h] = (f32x4){(float)hv[0], (float)hv[1], (float)hv[2], (float)hv[3]}; v[2 * h + 1] = (f32x4){(float)hv[4], (float)hv[5], (float)hv[6], (float)hv[7]}; }
#pragma unroll
        for (int j = 0; j < 4; ++j) ss += (v[j][0] * v[j][0] + v[j][1] * v[j][1]) + (v[j][2] * v[j][2] + v[j][3] * v[j][3]);
        const float rstd = rsqrtf(wave_sum(ss, lane) * (1.f / DM) + EPS);
#pragma unroll
        for (int j = 0; j < 4; ++j) { const int col = 8 * lane + 512 * (j >> 1) + 4 * (j & 1); const f32x4 gg = *(const f32x4*)(norm_out_g + col); *(f32x4*)(xr + col) = v[j] * rstd * gg; }
    }
}

constexpr int LDS_BYTES = 147456;
extern "C" void kernel_launch(void* const* d_in, const int* in_sizes, int n_in, void* d_out, int out_size, void* d_ws, size_t ws_size, hipStream_t stream) {
    static int grid = 0;
    if (grid == 0) {
        if (n_in != 23 || out_size != ML * DM || ws_size < WS_END) { fprintf(stderr, "kernel_launch: unexpected shapes (n_in %d out %d ws %zu)\n", n_in, out_size, ws_size); grid = -1; return; }
        int dev = 0, cus = 0, per_cu = 0;
        hipGetDevice(&dev); hipDeviceGetAttribute(&cus, hipDeviceAttributeMultiprocessorCount, dev);
        if (hipFuncSetAttribute((const void*)fwd_megakernel, hipFuncAttributeMaxDynamicSharedMemorySize, LDS_BYTES) != hipSuccess) { fprintf(stderr, "kernel_launch: hipFuncSetAttribute failed\n"); grid = -1; return; }
        if (hipOccupancyMaxActiveBlocksPerMultiprocessor(&per_cu, (const void*)fwd_megakernel, 512, LDS_BYTES) != hipSuccess || per_cu < 1) { fprintf(stderr, "kernel_launch: occupancy query gave %d\n", per_cu); per_cu = 1; }
        (void)hipGetLastError();
        grid = cus * per_cu;
    }
    if (grid < 0) return;
    if (hipMemsetAsync((char*)d_ws + WS_BAR, 0, XCD_BAR_WORDS * 4, stream) != hipSuccess) { fprintf(stderr, "kernel_launch: memset of the barrier words failed\n"); return; }
    Args a{};
    for (int i = 0; i < 23; ++i) a.in[i] = (const float*)d_in[i];
    a.out = (float*)d_out; a.ws = (unsigned char*)d_ws;
    void* args[] = {&a};
    hipError_t e = hipLaunchCooperativeKernel((const void*)fwd_megakernel, dim3(grid), dim3(512), args, LDS_BYTES, stream);
    if (e != hipSuccess) fprintf(stderr, "cooperative launch failed: %s (grid %d)\n", hipGetErrorString(e), grid);
}
```
